# Optimizing an MI355X kernel written in HIP

```python
import math
import jax
import jax.numpy as jnp
from jax import lax
import numpy as np


D_MODEL = 1024
BATCH = 8
SEQ = 4096
DEPTH = 2

CTX_LEN = 256
GRID_W = 64
N_EVEN = (DEPTH + 1) // 2
N_ODD = DEPTH // 2
EPS = 1e-6

MLA_HEADS = 8
QK_NOPE = 64
QK_ROPE = 32
QK_HEAD = QK_NOPE + QK_ROPE
V_HEAD = 64
Q_LORA = 256
KV_LORA = 128
MLA_WIDTH = MLA_HEADS * V_HEAD
ROPE_BASE = 10000.0
ATTN_BLOCK = 128

S5_WIDTH = 512
S5_GROUP = 16
S5_GROUPS = S5_WIDTH // S5_GROUP
S5_STATE = 64
S5_MIN_STEP = 1e-3
S5_MAX_STEP = 1e-1

EVEN_IN = Q_LORA + KV_LORA + QK_ROPE + S5_WIDTH
EVEN_OUT = MLA_WIDTH + S5_WIDTH

HY_WIDTH = D_MODEL
FILT_EMB = 33
FILT_BANDS = (FILT_EMB - 1) // 2
FILT_HIDDEN = 64
SHORT_CONV = 3
HY_MIN_DECAY = -math.log(1e-2) / 1.5
HY_MAX_DECAY = -math.log(1e-2) / 0.3

N_EXPERTS = 64
TOP_K = 6
EXPERT_FF = 256
SHARED_FF = 256
ROUTE_SCALE = 2.5
MOE_BLOCK = 256

kernel_name = 'hybrid_mla_s5_hyena_moe_prefix_dit'


def rmsnorm(x, g=None):
    xf = x.astype(jnp.float32)
    y = xf * lax.rsqrt(jnp.mean(xf * xf, axis=-1, keepdims=True) + EPS)
    if g is not None:
        y = y * g.astype(jnp.float32)
    return y.astype(x.dtype)


def modulate(h, shift, scale):
    return h * (1.0 + scale) + shift


def axial_rope_tables(rows):
    t = jnp.arange(rows * GRID_W)
    row = (t // GRID_W).astype(jnp.float32)
    col = (t % GRID_W).astype(jnp.float32)
    n_freq = QK_ROPE // 4
    inv = ROPE_BASE ** (-jnp.arange(n_freq, dtype=jnp.float32) / n_freq)
    ang = jnp.concatenate([row[:, None] * inv, col[:, None] * inv], axis=-1)
    return jnp.cos(ang), jnp.sin(ang)


def apply_rope(x, cos, sin):
    xf = x.astype(jnp.float32).reshape(x.shape[:-1] + (QK_ROPE // 2, 2))
    xr, xi = xf[..., 0], xf[..., 1]
    cs, sn = cos[:, None, :], sin[:, None, :]
    out = jnp.stack([xr * cs - xi * sn, xr * sn + xi * cs], axis=-1)
    return out.reshape(x.shape).astype(x.dtype)


def rope_tail(t, cos, sin):
    return jnp.concatenate([t[..., :QK_NOPE], apply_rope(t[..., QK_NOPE:], cos, sin)], axis=-1)


def mla_keys_values(part, kv_norm, w_ukv, k_qk, cos, sin):
    B, L, _ = part.shape
    c_kv = rmsnorm(part[..., :KV_LORA], kv_norm)
    kv = (c_kv @ w_ukv).reshape(B, L, MLA_HEADS, QK_NOPE + V_HEAD)
    k_r = jnp.broadcast_to(part[..., None, KV_LORA:KV_LORA + QK_ROPE], (B, L, MLA_HEADS, QK_ROPE))
    k = rmsnorm(jnp.concatenate([kv[..., :QK_NOPE], k_r], axis=-1), k_qk)
    if cos is not None:
        k = rope_tail(k, cos, sin)
    return k, kv[..., QK_NOPE:]


def attend_blocked(q, k, v):
    B, L, H, Dk = q.shape
    nb = L // ATTN_BLOCK
    qb = q.reshape(B, nb, ATTN_BLOCK, H, Dk).transpose(1, 0, 2, 3, 4)
    scale = QK_HEAD ** -0.5

    def one_block(q_blk):
        s = jnp.einsum('bqhd,bkhd->bhqk', q_blk, k, preferred_element_type=jnp.float32) * scale
        p = jax.nn.softmax(s, axis=-1)
        return jnp.einsum('bhqk,bkhd->bqhd', p.astype(v.dtype), v)

    o = lax.map(one_block, qb)
    return o.transpose(1, 0, 2, 3, 4).reshape(B, L, H * v.shape[-1])


def _ssm_combine(left, right):
    a_l, b_l = left
    a_r, b_r = right
    return a_r * a_l, a_r * b_l + b_r


def s5_scan(u, lam_bar, b_bar, s0=None):
    bu = jnp.einsum('blgh,gph->blgp', u.astype(jnp.complex64), b_bar)
    if s0 is not None:
        bu = bu.at[:, 0].add(lam_bar * s0)
    a = jnp.broadcast_to(lam_bar, bu.shape)
    _, states = lax.associative_scan(_ssm_combine, (a, bu), axis=1)
    return states


def s5_mixer(u, u_ctx, lam_re, lam_im, log_step, b_re, b_im, c_re, c_im, d_skip, glu_w, glu_b):
    B, L, _ = u.shape
    Lc = u_ctx.shape[1]
    ug = u.astype(jnp.float32).reshape(B, L, S5_GROUPS, S5_GROUP)
    ugc = u_ctx.astype(jnp.float32).reshape(B, Lc, S5_GROUPS, S5_GROUP)
    y = ug * d_skip.astype(jnp.float32).reshape(S5_GROUPS, S5_GROUP)
    for direction in range(2):
        lam = lax.complex(jnp.minimum(lam_re[direction].astype(jnp.float32), -1e-4),
                          lam_im[direction].astype(jnp.float32))
        step = jnp.exp(log_step[direction].astype(jnp.float32))[:, None]
        lam_bar = jnp.exp(lam * step)
        b_mat = lax.complex(b_re[direction].astype(jnp.float32), b_im[direction].astype(jnp.float32))
        b_bar = ((lam_bar - 1.0) / lam)[..., None] * b_mat
        c_mat = lax.complex(c_re[direction].astype(jnp.float32), c_im[direction].astype(jnp.float32))
        if direction == 0:
            uc, ul = ugc, ug
        else:
            uc, ul = ugc[:, ::-1], ug[:, ::-1]
        ctx_final = s5_scan(uc, lam_bar, b_bar)[:, -1]
        states = s5_scan(ul, lam_bar, b_bar, ctx_final)
        yd = jnp.einsum('blgp,ghp->blgh', states, c_mat).real
        y = y + (yd if direction == 0 else yd[:, ::-1])
    y = y.reshape(B, L, S5_WIDTH)
    z = jax.nn.gelu(y)
    out = z * jax.nn.sigmoid(z @ glu_w.astype(jnp.float32) + glu_b.astype(jnp.float32))
    return out.astype(u.dtype)


def even_mixer(h, h_ctx, cos, sin, w_in, q_norm, w_uq, kv_norm, w_ukv, q_qk, k_qk,
               lam_re, lam_im, log_step, b_re, b_im, c_re, c_im, d_skip, glu_w, glu_b, w_out):
    B, L, _ = h.shape
    proj = h @ w_in
    proj_ctx = h_ctx @ w_in[:, Q_LORA:]
    q = (rmsnorm(proj[..., :Q_LORA], q_norm) @ w_uq).reshape(B, L, MLA_HEADS, QK_HEAD)
    q = rope_tail(rmsnorm(q, q_qk), cos, sin)
    k_lat, v_lat = mla_keys_values(proj[..., Q_LORA:], kv_norm, w_ukv, k_qk, cos, sin)
    k_ctx, v_ctx = mla_keys_values(proj_ctx, kv_norm, w_ukv, k_qk, None, None)
    attn = attend_blocked(q, jnp.concatenate([k_lat, k_ctx], axis=1),
                          jnp.concatenate([v_lat, v_ctx], axis=1))
    s5 = s5_mixer(proj[..., Q_LORA + KV_LORA + QK_ROPE:], proj_ctx[..., KV_LORA + QK_ROPE:],
                  lam_re, lam_im, log_step, b_re, b_im, c_re, c_im, d_skip, glu_w, glu_b)
    return jnp.concatenate([attn, s5], axis=-1) @ w_out


def hyena_filter(L, w1, b1, w2, b2, w3, freq):
    f32 = jnp.float32
    t = jnp.linspace(0.0, 1.0, L, dtype=f32)[:, None]
    ang = 2.0 * math.pi * jnp.arange(L, dtype=f32)[:, None] / L
    bands = jnp.linspace(1e-4, FILT_BANDS - 1, FILT_BANDS, dtype=f32)
    z = jnp.concatenate([t, jnp.cos(bands * ang), -jnp.sin(bands * ang)], axis=-1)
    fr = freq.astype(f32)
    hid = jnp.sin(fr * (z @ w1.astype(f32) + b1.astype(f32)))
    hid = jnp.sin(fr * (hid @ w2.astype(f32) + b2.astype(f32)))
    hf = (hid @ w3.astype(f32)).reshape(L, 2, HY_WIDTH)
    deltas = jnp.linspace(HY_MIN_DECAY, HY_MAX_DECAY, HY_WIDTH, dtype=f32)
    hf = hf * jnp.exp(-t * deltas)[:, None, :]
    hf = hf * lax.rsqrt(jnp.sum(hf * hf, axis=(0, 1), keepdims=True) + EPS)
    return hf[:, 0], hf[:, 1]


def bidir_long_conv(z, h_fwd, h_bwd):
    B, L, Dh = z.shape
    zeros = jnp.zeros((L, Dh), jnp.float32)
    circ = (jnp.concatenate([h_fwd, zeros], axis=0)
            + jnp.concatenate([h_bwd[:1], zeros, h_bwd[:0:-1]], axis=0))
    zf = jnp.fft.rfft(z.astype(jnp.float32), n=2 * L, axis=1)
    cf = jnp.fft.rfft(circ, axis=0)
    return jnp.fft.irfft(zf * cf[None], n=2 * L, axis=1)[:, :L]


def hyena_mixer(h, w_in, conv_w, conv_b, f_w1, f_b1, f_w2, f_b2, f_w3, f_freq, bias, w_out):
    B, L, _ = h.shape
    p = h @ w_in
    pad = SHORT_CONV // 2
    pp = jnp.pad(p, ((0, 0), (pad, pad), (0, 0)))
    p = sum(pp[:, j:j + L] * conv_w[j] for j in range(SHORT_CONV)) + conv_b
    x0, x1, v = jnp.split(p, 3, axis=-1)
    h_fwd, h_bwd = hyena_filter(L, f_w1, f_b1, f_w2, f_b2, f_w3, f_freq)
    z = (v * x1).astype(jnp.float32)
    z = bidir_long_conv(z, h_fwd, h_bwd) + bias.astype(jnp.float32) * z
    y = x0 * z.astype(x0.dtype)
    return y @ w_out


def moe(h, router_w, router_b, w_gate, w_up, w_down, sh_gate, sh_up, sh_down):
    B, L, Dm = h.shape
    xf = h.reshape(B * L, Dm)
    T = B * L
    TK = T * TOP_K
    scores = jax.nn.sigmoid(jnp.einsum('td,de->te', xf, router_w, preferred_element_type=jnp.float32))
    _, idx = lax.top_k(scores + router_b.astype(jnp.float32), TOP_K)
    sel = jnp.take_along_axis(scores, idx, axis=-1)
    wts = sel / jnp.sum(sel, axis=-1, keepdims=True) * ROUTE_SCALE
    flat_e = idx.reshape(TK)
    order = jnp.argsort(flat_e)
    sorted_e = flat_e[order]
    counts = jnp.bincount(flat_e, length=N_EXPERTS)
    padded = (counts + MOE_BLOCK - 1) // MOE_BLOCK * MOE_BLOCK
    pad_end = jnp.cumsum(padded)
    pad_start = pad_end - padded
    start = jnp.cumsum(counts) - counts
    dest = pad_start[sorted_e] + jnp.arange(TK, dtype=jnp.int32) - start[sorted_e]
    n_blocks = -(-TK // MOE_BLOCK) + N_EXPERTS
    n_rows = n_blocks * MOE_BLOCK
    row_tok = jnp.zeros((n_rows,), jnp.int32).at[dest].set((order // TOP_K).astype(jnp.int32))
    row_w = jnp.zeros((n_rows,), jnp.float32).at[dest].set(wts.reshape(TK)[order])
    block_start = jnp.arange(n_blocks, dtype=jnp.int32) * MOE_BLOCK
    block_e = jnp.minimum(jnp.searchsorted(pad_end, block_start, side='right'), N_EXPERTS - 1)

    def expert_block(args):
        toks, w, e = args
        xb = xf[toks]
        hid = jax.nn.silu(xb @ w_gate[e]) * (xb @ w_up[e])
        return (hid @ w_down[e]) * w[:, None].astype(xb.dtype)

    ys = lax.map(expert_block, (row_tok.reshape(n_blocks, MOE_BLOCK),
                                row_w.reshape(n_blocks, MOE_BLOCK), block_e))
    routed = jnp.zeros_like(xf).at[row_tok].add(ys.reshape(n_rows, Dm))
    shared = (jax.nn.silu(xf @ sh_gate) * (xf @ sh_up)) @ sh_down
    return (routed + shared).reshape(B, L, Dm)


def setup_inputs(seed: int = 0) -> dict:
    key = jax.random.key(seed)
    ks = iter(jax.random.split(key, 64))
    f32 = jnp.float32
    D = D_MODEL

    def nrm(shape, s):
        return jax.random.normal(next(ks), shape, f32) * s

    n_idx = jnp.arange(S5_STATE, dtype=f32)
    s5_shape = (N_EVEN, 2, S5_GROUPS, S5_STATE)
    return {
        'x': nrm((BATCH, SEQ, D), 1.0),
        'c': nrm((BATCH, D), 1.0),
        'ctx': nrm((BATCH, CTX_LEN, D), 1.0),
        'c_ctx': nrm((D,), 1.0),
        'ada_w': nrm((DEPTH, D, 6 * D), 0.5 * D ** -0.5),
        'ada_b': nrm((DEPTH, 6 * D), 0.02),
        'ev_w_in': nrm((N_EVEN, D, EVEN_IN), D ** -0.5),
        'mla_q_norm': 1.0 + nrm((N_EVEN, Q_LORA), 0.05),
        'mla_w_uq': nrm((N_EVEN, Q_LORA, MLA_HEADS * QK_HEAD), Q_LORA ** -0.5),
        'mla_kv_norm': 1.0 + nrm((N_EVEN, KV_LORA), 0.05),
        'mla_w_ukv': nrm((N_EVEN, KV_LORA, MLA_HEADS * (QK_NOPE + V_HEAD)), KV_LORA ** -0.5),
        'mla_q_qknorm': 1.0 + nrm((N_EVEN, QK_HEAD), 0.05),
        'mla_k_qknorm': 1.0 + nrm((N_EVEN, QK_HEAD), 0.05),
        's5_lam_re': -0.5 * jnp.exp(nrm(s5_shape, 0.05)),
        's5_lam_im': math.pi * n_idx + nrm(s5_shape, 0.05),
        's5_log_step': jax.random.uniform(next(ks), (N_EVEN, 2, S5_GROUPS), f32,
                                          math.log(S5_MIN_STEP), math.log(S5_MAX_STEP)),
        's5_b_re': nrm((N_EVEN, 2, S5_GROUPS, S5_STATE, S5_GROUP), (2.0 * S5_GROUP) ** -0.5),
        's5_b_im': nrm((N_EVEN, 2, S5_GROUPS, S5_STATE, S5_GROUP), (2.0 * S5_GROUP) ** -0.5),
        's5_c_re': nrm((N_EVEN, 2, S5_GROUPS, S5_GROUP, S5_STATE), 0.5 ** 0.5),
        's5_c_im': nrm((N_EVEN, 2, S5_GROUPS, S5_GROUP, S5_STATE), 0.5 ** 0.5),
        's5_d': nrm((N_EVEN, S5_WIDTH), 1.0),
        's5_glu_w': nrm((N_EVEN, S5_WIDTH, S5_WIDTH), S5_WIDTH ** -0.5),
        's5_glu_b': nrm((N_EVEN, S5_WIDTH), 0.02),
        'ev_w_out': nrm((N_EVEN, EVEN_OUT, D), EVEN_OUT ** -0.5),
        'hy_w_in': nrm((N_ODD, D, 3 * HY_WIDTH), D ** -0.5),
        'hy_conv_w': nrm((N_ODD, SHORT_CONV, 3 * HY_WIDTH), SHORT_CONV ** -0.5),
        'hy_conv_b': nrm((N_ODD, 3 * HY_WIDTH), 0.02),
        'hy_f_w1': nrm((N_ODD, FILT_EMB, FILT_HIDDEN), FILT_EMB ** -0.5),
        'hy_f_b1': nrm((N_ODD, FILT_HIDDEN), 0.02),
        'hy_f_w2': nrm((N_ODD, FILT_HIDDEN, FILT_HIDDEN), FILT_HIDDEN ** -0.5),
        'hy_f_b2': nrm((N_ODD, FILT_HIDDEN), 0.02),
        'hy_f_w3': nrm((N_ODD, FILT_HIDDEN, 2 * HY_WIDTH), FILT_HIDDEN ** -0.5),
        'hy_f_freq': 1.0 + nrm((N_ODD, FILT_HIDDEN), 0.05),
        'hy_bias': nrm((N_ODD, HY_WIDTH), 1.0),
        'hy_w_out': nrm((N_ODD, HY_WIDTH, D), HY_WIDTH ** -0.5),
        'moe_router_w': nrm((DEPTH, D, N_EXPERTS), D ** -0.5),
        'moe_router_b': nrm((DEPTH, N_EXPERTS), 0.01),
        'moe_w_gate': nrm((DEPTH, N_EXPERTS, D, EXPERT_FF), D ** -0.5),
        'moe_w_up': nrm((DEPTH, N_EXPERTS, D, EXPERT_FF), D ** -0.5),
        'moe_w_down': nrm((DEPTH, N_EXPERTS, EXPERT_FF, D), EXPERT_FF ** -0.5),
        'moe_sh_gate': nrm((DEPTH, D, SHARED_FF), D ** -0.5),
        'moe_sh_up': nrm((DEPTH, D, SHARED_FF), D ** -0.5),
        'moe_sh_down': nrm((DEPTH, SHARED_FF, D), SHARED_FF ** -0.5),
    }


def reference(x, c, ctx, c_ctx, ada_w, ada_b,
              ev_w_in, mla_q_norm, mla_w_uq, mla_kv_norm, mla_w_ukv, mla_q_qknorm, mla_k_qknorm,
              s5_lam_re, s5_lam_im, s5_log_step, s5_b_re, s5_b_im, s5_c_re, s5_c_im, s5_d,
              s5_glu_w, s5_glu_b, ev_w_out,
              hy_w_in, hy_conv_w, hy_conv_b, hy_f_w1, hy_f_b1, hy_f_w2, hy_f_b2, hy_f_w3, hy_f_freq,
              hy_bias, hy_w_out,
              moe_router_w, moe_router_b, moe_w_gate, moe_w_up, moe_w_down,
              moe_sh_gate, moe_sh_up, moe_sh_down):
    B, L, D = x.shape
    rows = L // GRID_W
    cos, sin = axial_rope_tables(rows)
    sc = jax.nn.silu(c)
    sc_ctx = jax.nn.silu(c_ctx)
    for li in range(DEPTH):
        mod = sc @ ada_w[li] + ada_b[li]
        sh1, sc1, g1, sh2, sc2, g2 = jnp.split(mod[:, None, :], 6, axis=-1)
        h = modulate(rmsnorm(x), sh1, sc1)
        if li % 2 == 0:
            e = li // 2
            mod_ctx = sc_ctx @ ada_w[li][:, :2 * D] + ada_b[li][:2 * D]
            h_ctx = modulate(rmsnorm(ctx), mod_ctx[:D], mod_ctx[D:])
            mix = even_mixer(h, h_ctx, cos, sin, ev_w_in[e], mla_q_norm[e], mla_w_uq[e], mla_kv_norm[e],
                             mla_w_ukv[e], mla_q_qknorm[e], mla_k_qknorm[e],
                             s5_lam_re[e], s5_lam_im[e], s5_log_step[e], s5_b_re[e], s5_b_im[e],
                             s5_c_re[e], s5_c_im[e], s5_d[e], s5_glu_w[e], s5_glu_b[e], ev_w_out[e])
        else:
            o = li // 2
            mix = hyena_mixer(h, hy_w_in[o], hy_conv_w[o], hy_conv_b[o], hy_f_w1[o], hy_f_b1[o],
                              hy_f_w2[o], hy_f_b2[o], hy_f_w3[o], hy_f_freq[o], hy_bias[o], hy_w_out[o])
        x = x + g1 * mix
        h = modulate(rmsnorm(x), sh2, sc2)
        x = x + g2 * moe(h, moe_router_w[li], moe_router_b[li], moe_w_gate[li], moe_w_up[li],
                         moe_w_down[li], moe_sh_gate[li], moe_sh_up[li], moe_sh_down[li])
    return x
```

```cpp
#include <hip/hip_runtime.h>
#include <cstdio>
#include <cstdint>
#include <cmath>

#ifndef N_LAUNCH_MODE
#define N_LAUNCH_MODE 1
#endif

#define GAS __attribute__((address_space(1)))
#define LAS __attribute__((address_space(3)))
typedef unsigned short bf16;
typedef short bf16x8 __attribute__((ext_vector_type(8)));
typedef short s16x4 __attribute__((ext_vector_type(4)));
typedef float f32x4 __attribute__((ext_vector_type(4)));
typedef float f32x2 __attribute__((ext_vector_type(2)));
typedef float f32x16 __attribute__((ext_vector_type(16)));
typedef unsigned u32x4 __attribute__((ext_vector_type(4)));
typedef unsigned u32x2 __attribute__((ext_vector_type(2)));
typedef GAS unsigned gu32;
#define RLX_AGENT __ATOMIC_RELAXED, __HIP_MEMORY_SCOPE_AGENT
#define LDS_WAIT() asm volatile("s_waitcnt lgkmcnt(0)" ::: "memory")
#define VM_WAIT() asm volatile("s_waitcnt vmcnt(0)" ::: "memory")

constexpr int DM = 1024, NB = 8, SEQ = 4096, CTXL = 256, T = NB * SEQ  , TC = NB * CTXL  , TA = T + TC  ;
constexpr int NHEAD = 8, QKH = 96, VH = 64, QLORA = 256, KVLORA = 128, QKROPE = 32, QKNOPE = 64;
constexpr int S5W = 512, S5G = 32, S5H = 16, S5P = 64, S5TC = 32  , S5NCH = SEQ / S5TC  , S5NCC = CTXL / S5TC  ;
constexpr int S5ROWS = 1280  , S5K = 768  ;
constexpr int EVEN_IN = 928, UOFF = 416;
constexpr int NEXP = 64, TOPK = 6, EFF = 256;
constexpr float EPS = 1e-6f;
constexpr int HALF_T = T / 2;
constexpr int MOE_CAP = HALF_T;
constexpr int MAXBLK = 2 * ((HALF_T * TOPK) / 256 + NEXP);

__device__ __forceinline__ unsigned f2bf(float f) { unsigned u = __builtin_bit_cast(unsigned, f); return (u + 0x7fffu + ((u >> 16) & 1u)) >> 16; }
__device__ __forceinline__ unsigned pk2(float lo, float hi) { return f2bf(lo) | (f2bf(hi) << 16); }
__device__ __forceinline__ float bf2f(unsigned short b) { return __builtin_bit_cast(float, ((unsigned)b) << 16); }
__device__ __forceinline__ float bflo(unsigned w) { return __builtin_bit_cast(float, w << 16); }
__device__ __forceinline__ float bfhi(unsigned w) { return __builtin_bit_cast(float, w & 0xffff0000u); }
__device__ __forceinline__ float wave_sum(float v) {
#pragma unroll
    for (int o = 1; o < 64; o <<= 1) v += __shfl_xor(v, o);
    return v;
}
__device__ __forceinline__ float siluf(float x) { return x / (1.0f + __expf(-x)); }
__device__ __forceinline__ float sigmf(float x) { return 1.0f / (1.0f + __expf(-x)); }
__device__ __forceinline__ float gelu_tanh(float x) { const float u = 0.7978845608028654f * (x + 0.044715f * x * x * x); const float e = __expf(2.0f * u); return x * (1.0f - 1.0f / (e + 1.0f)); }

namespace pg8 {
constexpr int BM = 256, BK = 64, HALF = 128, HTB = HALF * BK * 2  , STAGE_BYTES = 8 * HTB;
__host__ __device__ __forceinline__ int lds_byte(int r, int c) { const int st = (r >> 4) * 2 + (c >> 5), rr = r & 15, cc = c & 31, ob = rr * 64 + cc * 2; return st * 1024 + (ob ^ (((ob >> 9) & 1) << 5)); }
__host__ __device__ __forceinline__ void stage_rc(int b, int& R, int& C) { const int st = b / 1024, sb = b % 1024, swz = sb ^ (((sb >> 9) & 1) << 5); R = (st >> 1) * 16 + swz / 64; C = (st & 1) * 32 + (swz % 64) / 2; }
__host__ __device__ __forceinline__ int perm32(int rho) { const int n = rho >> 4, i = rho & 15; return 8 * (i >> 2) + 4 * n + (i & 3); }

struct Unit { const char* A; const char* B; const int* rows; int pm, pn, z; };

__device__ __forceinline__ unsigned cvt_pk_bf16(float lo, float hi) { unsigned r; asm volatile("v_cvt_pk_bf16_f32 %0, %1, %2" : "=v"(r) : "v"(lo), "v"(hi)); return r; }

template <class Epi, class Sched>
__device__ __forceinline__ void gemm_phase(LAS unsigned char* lds, const int K, const unsigned lda, const unsigned ldb, const Sched& S, const Epi& E) {
    const int tid = threadIdx.x, wid = __builtin_amdgcn_readfirstlane(tid >> 6), lane = tid & 63, wr = wid >> 2, wc = wid & 3, fr = lane & 15, fq = lane >> 4;
    const int nt = K / BK;
    int Ri[2], Ci[2]; unsigned voffB[2][2];
#pragma unroll
    for (int i = 0; i < 2; ++i) { int R, C; stage_rc(tid * 16 + i * 8192, R, C); Ri[i] = R; Ci[i] = C; const int Rb = Epi::PERM ? ((R & ~31) + perm32(R & 31)) : R;
        voffB[0][i] = (unsigned)Rb * ldb + (unsigned)C * 2u; voffB[1][i] = (unsigned)(Rb + HALF) * ldb + (unsigned)C * 2u; }
    const size_t kstep = (size_t)(BK * 2);
    const unsigned ldsw = (unsigned)wid * 1024u;
    const int aoff = lds_byte(wr * 64 + fr, fq * 8), boff = lds_byte(wc * 32 + fr, fq * 8);
#define PG8_SA(b, h) (((b) * 2 + (h)) * HTB)
#define PG8_SB(b, h) ((4 + (b) * 2 + (h)) * HTB)
#define PG8_STAGE(bufoff, gbase, voff) do { _Pragma("unroll") for (int _i = 0; _i < 2; ++_i) \
        __builtin_amdgcn_global_load_lds((const unsigned*)((const char*)(gbase) + (voff)[_i]), (LAS unsigned*)(lds + (bufoff) + ldsw + _i * 8192), 16, 0, 0); } while (0)
#define PG8_LDA(dst, b, h) do { _Pragma("unroll") for (int m = 0; m < 4; ++m) _Pragma("unroll") for (int k = 0; k < 2; ++k) dst[m][k] = *(const LAS bf16x8*)(lds + PG8_SA(b, h) + aoff + m * 2048 + k * 1024); } while (0)
#define PG8_LDB(dst, b, h) do { _Pragma("unroll") for (int n = 0; n < 2; ++n) _Pragma("unroll") for (int k = 0; k < 2; ++k) dst[n][k] = *(const LAS bf16x8*)(lds + PG8_SB(b, h) + boff + n * 2048 + k * 1024); } while (0)
#define PG8_MMA(ai, bj, At, Bt) do { __builtin_amdgcn_s_setprio(1); _Pragma("unroll") for (int m = 0; m < 4; ++m) _Pragma("unroll") for (int n = 0; n < 2; ++n) _Pragma("unroll") for (int k = 0; k < 2; ++k) \
        acc[ai][bj][m][n] = __builtin_amdgcn_mfma_f32_16x16x32_bf16(Bt[n][k], At[m][k], acc[ai][bj][m][n], 0, 0, 0); __builtin_amdgcn_s_setprio(0); } while (0)
#define PG8_WAIT_V(n) asm volatile("s_waitcnt vmcnt(" #n ")" ::: "memory")
#define PG8_WAIT_L(n) asm volatile("s_waitcnt lgkmcnt(" #n ")" ::: "memory")
#define PG8_BAR __builtin_amdgcn_s_barrier()
#define PG8_SCHED __builtin_amdgcn_sched_barrier(0)
#define PG8_AOFF(dst, u) do { if ((u).rows) { _Pragma("unroll") for (int _h = 0; _h < 2; ++_h) _Pragma("unroll") for (int _i = 0; _i < 2; ++_i) \
            { unsigned _t = (unsigned)(u).rows[_h * HALF + Ri[_i]] >> 3; _t = _t < (unsigned)(T - 1) ? _t : (unsigned)(T - 1); dst[_h][_i] = _t * lda + (unsigned)Ci[_i] * 2u; } } \
        else { _Pragma("unroll") for (int _h = 0; _h < 2; ++_h) _Pragma("unroll") for (int _i = 0; _i < 2; ++_i) dst[_h][_i] = (unsigned)(_h * HALF + Ri[_i]) * lda + (unsigned)Ci[_i] * 2u; } } while (0)
    Unit cur, nxt; int ui = 0;
    if (!S.next(0, cur)) return;
    f32x4 acc[2][2][4][2];
#pragma unroll
    for (int a = 0; a < 2; ++a)
#pragma unroll
        for (int b = 0; b < 2; ++b)
#pragma unroll
            for (int m = 0; m < 4; ++m)
#pragma unroll
                for (int n = 0; n < 2; ++n) acc[a][b][m][n] = (f32x4){0.f, 0.f, 0.f, 0.f};
    bf16x8 At[4][2], B0[2][2], B1[2][2];
    unsigned vA[2][2], vN[2][2];
    PG8_AOFF(vA, cur);
    const char* cA = cur.A; const char* cB = cur.B;
    PG8_STAGE(PG8_SB(0, 0), cB, voffB[0]); PG8_STAGE(PG8_SB(0, 1), cB, voffB[1]); PG8_STAGE(PG8_SA(0, 0), cA, vA[0]); PG8_STAGE(PG8_SA(0, 1), cA, vA[1]);
    if (wr == 1) PG8_BAR;
    PG8_WAIT_V(2); PG8_BAR;
    PG8_STAGE(PG8_SB(1, 0), cB + kstep, voffB[0]); PG8_STAGE(PG8_SA(1, 0), cA + kstep, vA[0]); PG8_STAGE(PG8_SB(1, 1), cB + kstep, voffB[1]);
    PG8_WAIT_V(6); PG8_BAR;
    for (;;) {
        const bool has_next = S.next(ui + 1, nxt);
        if (has_next) { PG8_AOFF(vN, nxt); } else {
#pragma unroll
            for (int _h = 0; _h < 2; ++_h)
#pragma unroll
                for (int _i = 0; _i < 2; ++_i) vN[_h][_i] = vA[_h][_i]; }
        const char* nA = has_next ? nxt.A : cA; const char* nB = has_next ? nxt.B : cB;
#pragma nounroll
        for (int t = 0; t < nt; t += 2) {
            const bool last = (t == nt - 2);
            const char* a1 = cA + (size_t)(t + 1) * kstep;
            const char* a2 = last ? nA : cA + (size_t)(t + 2) * kstep; const char* b2 = last ? nB : cB + (size_t)(t + 2) * kstep;
            const char* a3 = a2 + kstep; const char* b3 = b2 + kstep;
            unsigned v2[2][2];
#pragma unroll
            for (int _h = 0; _h < 2; ++_h)
#pragma unroll
                for (int _i = 0; _i < 2; ++_i) v2[_h][_i] = last ? vN[_h][_i] : vA[_h][_i];
            PG8_LDB(B0, 0, 0); PG8_LDB(B1, 0, 1); PG8_SCHED; PG8_LDA(At, 0, 0); PG8_STAGE(PG8_SA(1, 1), a1, vA[1]);
            PG8_WAIT_V(8); PG8_WAIT_L(0); PG8_BAR; PG8_MMA(0, 0, At, B0); PG8_MMA(0, 1, At, B1); PG8_BAR; PG8_SCHED;
            PG8_LDA(At, 0, 1); PG8_STAGE(PG8_SB(0, 0), b2, voffB[0]); PG8_STAGE(PG8_SB(0, 1), b2, voffB[1]); PG8_STAGE(PG8_SA(0, 0), a2, v2[0]);
            PG8_WAIT_V(8); PG8_WAIT_L(0); PG8_BAR; PG8_MMA(1, 0, At, B0); PG8_MMA(1, 1, At, B1); PG8_BAR; PG8_SCHED;
            PG8_LDB(B0, 1, 0); PG8_LDB(B1, 1, 1); PG8_SCHED; PG8_LDA(At, 1, 0); PG8_STAGE(PG8_SA(0, 1), a2, v2[1]);
            PG8_WAIT_V(8); PG8_WAIT_L(0); PG8_BAR; PG8_MMA(0, 0, At, B0); PG8_MMA(0, 1, At, B1); PG8_BAR; PG8_SCHED;
            PG8_LDA(At, 1, 1); PG8_STAGE(PG8_SB(1, 0), b3, voffB[0]); PG8_STAGE(PG8_SB(1, 1), b3, voffB[1]); PG8_STAGE(PG8_SA(1, 0), a3, v2[0]);
            PG8_WAIT_V(8); PG8_WAIT_L(0); PG8_BAR; PG8_MMA(1, 0, At, B0); PG8_MMA(1, 1, At, B1); PG8_BAR; PG8_SCHED;
        }
        if (wr == 0) PG8_BAR;
        E(acc, cur, wr, wc, fr, fq);
        if (!has_next) break;
#pragma unroll
        for (int a = 0; a < 2; ++a)
#pragma unroll
            for (int b = 0; b < 2; ++b)
#pragma unroll
                for (int m = 0; m < 4; ++m)
#pragma unroll
                    for (int n = 0; n < 2; ++n) acc[a][b][m][n] = (f32x4){0.f, 0.f, 0.f, 0.f};
        cur = nxt; cA = nA; cB = nB; ++ui;
#pragma unroll
        for (int _h = 0; _h < 2; ++_h)
#pragma unroll
            for (int _i = 0; _i < 2; ++_i) vA[_h][_i] = vN[_h][_i];
        if (wr == 1) PG8_BAR;
    }
    PG8_WAIT_V(0);
    PG8_BAR;
#undef PG8_SA
#undef PG8_SB
#undef PG8_STAGE
#undef PG8_LDA
#undef PG8_LDB
#undef PG8_MMA
#undef PG8_WAIT_V
#undef PG8_WAIT_L
#undef PG8_BAR
#undef PG8_SCHED
#undef PG8_AOFF
}
}

constexpr size_t MiB = 1u << 20;
constexpr size_t WS_CTL = 0, CTL_ZERO_BYTES = 1 * MiB;
constexpr size_t WS_MOD = 1 * MiB;
constexpr size_t WS_MODCTX = WS_MOD + 512 * 1024;
constexpr size_t WS_TOPW = 2 * MiB;
constexpr size_t WS_LAMT = 3 * MiB;
constexpr size_t WS_TOK = 4 * MiB;
constexpr size_t WS_H = 16 * MiB;
constexpr size_t WS_WS = 84 * MiB;
constexpr size_t WS_AR = 128 * MiB;
constexpr size_t WS_WIN = WS_WS, WS_WUQ = WS_WS + 2 * MiB, WS_WUKV = WS_WS + 2 * MiB + 512 * 1024, WS_WGLU = WS_WS + 3 * MiB, WS_WOUT = WS_WS + 4 * MiB;
constexpr size_t WS_SOUT = WS_WS + 6 * MiB;
constexpr size_t WS_WG = WS_WS + 14 * MiB;
constexpr size_t WS_WHIN = WS_WS, WS_WHOUT = WS_WS + 6 * MiB, WS_HFT = WS_WS + 8 * MiB;
constexpr size_t AR_PROJ = WS_AR, AR_U = WS_AR + 34 * MiB, AR_QN = WS_AR + 94 * MiB, AR_CKV = WS_AR + 110 * MiB, AR_QRAW = WS_AR + 127 * MiB,
                 AR_KVRAW = WS_AR + 175 * MiB, AR_KF = WS_AR + 243 * MiB, AR_SRAW = WS_AR + 294 * MiB, AR_Z = WS_AR + 334 * MiB, AR_CAT = WS_AR + 366 * MiB;
constexpr size_t AR_W1 = WS_AR, AR_W2 = WS_AR + 65 * MiB, AR_HID = WS_AR + 98 * MiB, AR_HIDS = WS_AR + 210 * MiB, AR_YBUF = WS_AR + 226 * MiB;
constexpr size_t AR_P = WS_AR, AR_X0 = WS_AR + 192 * MiB, AR_ZT = WS_AR + 256 * MiB, AR_YT = WS_AR + 320 * MiB;
constexpr size_t AR_HSP = WS_AR + 384 * MiB;
constexpr size_t WS_END = WS_AR + 430 * MiB;
static_assert(AR_U + (size_t)S5G * S5ROWS * S5K * 2 <= AR_QN && AR_QRAW + (size_t)T * 768 * 2 <= AR_KVRAW && AR_KVRAW + (size_t)TA * 1024 * 2 <= AR_KF && AR_KF + (size_t)TA * 768 * 2 <= AR_SRAW &&
              AR_SRAW + (size_t)S5G * S5ROWS * 256 * 4 <= AR_Z && AR_CAT + (size_t)T * 1024 * 2 <= WS_END && AR_CKV + (size_t)TA * 256 * 2 <= AR_QRAW && AR_PROJ + (size_t)TA * 512 * 2 <= AR_U, "arena L0");
static_assert(AR_W2 + (size_t)65 * 1024 * 256 * 2 <= AR_HID && AR_HID + (size_t)MAXBLK * 256 * 256 * 2 <= AR_HIDS && AR_HIDS + (size_t)T * 256 * 2 <= AR_YBUF && AR_YBUF + (size_t)HALF_T * 6 * 1024 * 2 <= WS_END, "arena MoE");
static_assert(WS_END <= 600 * MiB, "workspace budget");
constexpr int CW_TMO = 0, CW_CODE = 1;
constexpr int CW_BAR = 4096;
constexpr int CW_CNT = 32768;
constexpr int LDS_CTL_BYTES = 4096, RING_OFF = LDS_CTL_BYTES, LDS_BYTES = 160 * 1024;
constexpr int NPHASE = 26;

struct Params {
    const float *x, *c, *ctx, *c_ctx, *ada_w, *ada_b, *ev_w_in, *q_norm, *w_uq, *kv_norm, *w_ukv, *q_qk, *k_qk,
        *lam_re, *lam_im, *log_step, *b_re, *b_im, *c_re, *c_im, *s5_d, *glu_w, *glu_b, *ev_w_out,
        *hy_w_in, *hy_conv_w, *hy_conv_b, *f_w1, *f_b1, *f_w2, *f_b2, *f_w3, *f_freq, *hy_bias, *hy_w_out,
        *router_w, *router_b, *w_gate, *w_up, *w_down, *sh_gate, *sh_up, *sh_down;
    float* out; unsigned char* ws; int ph_lo, ph_hi;
};

#define XB_TMO      128
#define XB_XCNT(j)  (256  + 64 * (j))
#define XB_XSUB(j)  (1280 + 64 * (j))
#define XB_XGEN(j)  (2304 + 64 * (j))
#define XB_TOP      3328
#define XB_TOPGEN   3392
#define XCD_BAR_WORDS 3456
#define XB_SPIN_CAP (1u << 18)

__device__ __forceinline__ unsigned xb_ld(unsigned* p)              { return __hip_atomic_load(p, __ATOMIC_RELAXED, __HIP_MEMORY_SCOPE_AGENT); }
__device__ __forceinline__ unsigned xb_add(unsigned* p, unsigned v) { return __hip_atomic_fetch_add(p, v, __ATOMIC_RELAXED, __HIP_MEMORY_SCOPE_AGENT); }
__device__ __forceinline__ unsigned xb_xcc_id() { return (unsigned)__builtin_amdgcn_s_getreg((3 << 11) | 20) & 0xFu; }
#define XB_SPIN(cond, bar) do { unsigned _sp = 0; while (cond) { __builtin_amdgcn_s_sleep(1); \
    if ((++_sp & 255u) == 0u) { if (xb_ld(&(bar)[XB_TMO])) break; if (_sp > XB_SPIN_CAP) { atomicAdd(&(bar)[XB_TMO], 1u); break; } } } } while (0)

struct XcdBarrier {
    unsigned* bar; unsigned x;
    volatile LAS unsigned* st;
};

__device__ __forceinline__ XcdBarrier xcd_barrier_post(unsigned* bar, volatile LAS unsigned* st) {
    XcdBarrier b; b.bar = bar; b.x = xb_xcc_id(); b.st = st;
    if (threadIdx.x == 0) (void)xb_add(&bar[XB_XCNT(b.x)], 1u);
    return b;
}
__device__ __forceinline__ void xcd_barrier_complete(unsigned* bar, unsigned x, unsigned& nloc, unsigned& nx) {
    const unsigned G = gridDim.x * gridDim.y * gridDim.z;
    unsigned sum, cnt, mine, sp = 0u;
    for (;;) {
        sum = 0u; cnt = 0u; mine = 0u;
#pragma unroll
        for (unsigned j = 0; j < 16; ++j) { const unsigned c = xb_ld(&bar[XB_XCNT(j)]); sum += c; cnt += (c > 0u) ? 1u : 0u; mine = (j == x) ? c : mine; }
        if (sum == G) break;
        __builtin_amdgcn_s_sleep(1);
        if ((++sp & 255u) == 0u) { if (xb_ld(&bar[XB_TMO])) break; if (sp > XB_SPIN_CAP) { atomicAdd(&bar[XB_TMO], 1u); break; } }
    }
    nloc = mine > 0u ? mine : 1u; nx = cnt > 0u ? cnt : 1u;
}

__device__ __forceinline__ void xcd_barrier(const XcdBarrier& b) {
    asm volatile("s_waitcnt vmcnt(0)" ::: "memory");
    __syncthreads();
    if (threadIdx.x == 0) {
        unsigned* bar = b.bar;
        __builtin_amdgcn_s_waitcnt(0);
        unsigned nloc = b.st[0], nx = b.st[1];
        if (nloc == 0u) { xcd_barrier_complete(bar, b.x, nloc, nx); b.st[0] = nloc; b.st[1] = nx; }
        const unsigned old = xb_add(&bar[XB_XSUB(b.x)], 1u);
        const unsigned gen = old / nloc;
        if (old + 1u == (gen + 1u) * nloc) {
            __builtin_amdgcn_fence(__ATOMIC_RELEASE, "agent");
            asm volatile("s_waitcnt vmcnt(0)" ::: "memory");
            const unsigned og = xb_add(&bar[XB_TOP], 1u);
            const unsigned tg = og / nx;
            if (og + 1u == (tg + 1u) * nx) xb_add(&bar[XB_TOPGEN], 1u);
            else XB_SPIN(xb_ld(&bar[XB_TOPGEN]) == tg, bar);
            __builtin_amdgcn_fence(__ATOMIC_ACQUIRE, "agent");
            xb_add(&bar[XB_XGEN(b.x)], 1u);
            asm volatile("s_waitcnt vmcnt(0)" ::: "memory");
        } else {
            XB_SPIN(xb_ld(&bar[XB_XGEN(b.x)]) == gen, bar);
            __builtin_amdgcn_fence(__ATOMIC_ACQUIRE, "agent");
            asm volatile("s_waitcnt vmcnt(0)" ::: "memory");
        }
    }
    __syncthreads();
}

struct Ctx { LAS unsigned char* lds; int tid, lane, wave, G, bid; };

__device__ __forceinline__ void ph_mod(const Ctx& C, const Params& P) {
    if (C.bid >= 96) return;
    LAS float* sc = (LAS float*)(C.lds + RING_OFF);
    LAS float* red = sc + 9 * 1024;
    float* mod = (float*)(P.ws + WS_MOD); float* modctx = (float*)(P.ws + WS_MODCTX);
    for (int i = C.tid; i < 9 * 1024; i += 512) { const float v = (i < 8192) ? P.c[i] : P.c_ctx[i - 8192]; sc[i] = siluf(v); }
    __syncthreads();
    for (int item = C.bid; item < 96; item += C.G) {
        const int li = item / 48, j0 = (item % 48) * 128, col = C.tid & 127, kq = C.tid >> 7;
        float a[9];
#pragma unroll
        for (int r = 0; r < 9; ++r) a[r] = 0.f;
        const float* w = P.ada_w + (size_t)li * 1024 * 6144 + j0 + col;
#pragma unroll 4
        for (int k = kq * 256; k < kq * 256 + 256; ++k) { const float wv = w[(size_t)k * 6144];
#pragma unroll
            for (int r = 0; r < 9; ++r) a[r] += sc[r * 1024 + k] * wv; }
#pragma unroll
        for (int r = 0; r < 9; ++r) red[(kq * 9 + r) * 128 + col] = a[r];
        __syncthreads();
        for (int o = C.tid; o < 9 * 128; o += 512) { const int r = o >> 7, cc = o & 127;
            const float s = red[(0 * 9 + r) * 128 + cc] + red[(1 * 9 + r) * 128 + cc] + red[(2 * 9 + r) * 128 + cc] + red[(3 * 9 + r) * 128 + cc] + P.ada_b[li * 6144 + j0 + cc];
            if (r < 8) mod[(size_t)(li * 8 + r) * 6144 + j0 + cc] = s; else if (li == 0 && j0 + cc < 2048) modctx[j0 + cc] = s; }
        __syncthreads();
    }
}

__device__ __forceinline__ void tr_item(const float* W, int ldw, bf16* WT, int ldt, int k0, int n0, int drow0, const float* gk, LAS float* scr, int lane) {
#pragma unroll 8
    for (int i = 0; i < 32; ++i) { const int kk = 2 * i + (lane >> 5); float v = W[(size_t)(k0 + kk) * ldw + n0 + (lane & 31)]; if (gk) v *= gk[k0 + kk]; scr[kk * 33 + (lane & 31)] = v; }
    LDS_WAIT(); asm volatile("" ::: "memory");
    const int c = lane & 7;
#pragma unroll
    for (int j = 0; j < 4; ++j) { const int n = (lane >> 3) + 8 * j; const LAS float* s = scr + (8 * c) * 33 + n;
        u32x4 o; o.x = pk2(s[0 * 33], s[1 * 33]); o.y = pk2(s[2 * 33], s[3 * 33]); o.z = pk2(s[4 * 33], s[5 * 33]); o.w = pk2(s[6 * 33], s[7 * 33]);
        *(u32x4*)(WT + (size_t)(drow0 + n) * ldt + k0 + 8 * c) = o; }
    LDS_WAIT(); asm volatile("" ::: "memory");
}
__device__ __forceinline__ void tr_matrix(const Ctx& C, const float* W, int K, int N, int ldw, bf16* WT, int ldt, int row_off, const float* gk, int gw, int NGW) {
    LAS float* scr = (LAS float*)(C.lds + RING_OFF + C.wave * 8448);
    const int nblk = N / 32, nit = (K / 64) * nblk;
    for (int it = gw; it < nit; it += NGW) { const int kb = it / nblk, nb = it % nblk; tr_item(W, ldw, WT, ldt, 64 * kb, 32 * nb, row_off + 32 * nb, gk, scr, C.lane); }
}
__device__ __forceinline__ void zero_bf16(bf16* p, size_t n, int gt, int NGT) { for (size_t i = (size_t)gt * 8; i < n; i += (size_t)NGT * 8) *(u32x4*)(p + i) = (u32x4){0u, 0u, 0u, 0u}; }

__device__ __forceinline__ void ph_conv_l0(const Ctx& C, const Params& P) {
    const int gw = C.bid * 8 + C.wave, NGW = C.G * 8, gt = C.bid * 512 + C.tid, NGT = C.G * 512;
    unsigned char* ws = P.ws;
    tr_matrix(C, P.ev_w_in, 1024, EVEN_IN, EVEN_IN, (bf16*)(ws + WS_WIN), 1024, 0, nullptr, gw, NGW);
    zero_bf16((bf16*)(ws + WS_WIN) + (size_t)EVEN_IN * 1024, (size_t)(1024 - EVEN_IN) * 1024, gt, NGT);
    tr_matrix(C, P.w_uq, 256, 768, 768, (bf16*)(ws + WS_WUQ), 256, 0, P.q_norm, gw, NGW);
    tr_matrix(C, P.w_ukv, 128, 1024, 1024, (bf16*)(ws + WS_WUKV), 256, 0, P.kv_norm, gw, NGW);
    { bf16* w = (bf16*)(ws + WS_WUKV); for (int i = gt; i < 1024 * 16; i += NGT) { const int r = i >> 4, cq = i & 15; *(u32x4*)(w + (size_t)r * 256 + 128 + cq * 8) = (u32x4){0u, 0u, 0u, 0u}; } }
    tr_matrix(C, P.glu_w, 512, 512, 512, (bf16*)(ws + WS_WGLU), 512, 0, nullptr, gw, NGW);
    tr_matrix(C, P.ev_w_out, 1024, 1024, 1024, (bf16*)(ws + WS_WOUT), 1024, 0, nullptr, gw, NGW);
}
__device__ __forceinline__ void ph_conv_l1(const Ctx& C, const Params& P) {
    const int gw = C.bid * 8 + C.wave, NGW = C.G * 8;
    tr_matrix(C, P.hy_w_in, 1024, 3072, 3072, (bf16*)(P.ws + WS_WHIN), 1024, 0, nullptr, gw, NGW);
    tr_matrix(C, P.hy_w_out, 1024, 1024, 1024, (bf16*)(P.ws + WS_WHOUT), 1024, 0, nullptr, gw, NGW);
}
__device__ __forceinline__ void ph_conv_moe(const Ctx& C, const Params& P, int li) {
    const int gw = C.bid * 8 + C.wave, NGW = C.G * 8;
    LAS float* scr = (LAS float*)(C.lds + RING_OFF + C.wave * 8448);
    bf16* W1 = (bf16*)(P.ws + AR_W1); bf16* W2 = (bf16*)(P.ws + AR_W2);
    for (int it = gw; it < 65 * 384; it += NGW) {
        const int e = it / 384, r = it % 384, kind = r >> 7, idx = r & 127;
        if (kind < 2) { const float* W = (e < 64) ? ((kind == 0 ? P.w_gate : P.w_up) + ((size_t)li * 64 + e) * 1024 * 256) : ((kind == 0 ? P.sh_gate : P.sh_up) + (size_t)li * 1024 * 256);
            const int kb = idx >> 3, nb = idx & 7, n0 = 32 * nb; const int drow0 = (n0 >> 7) * 256 + kind * 128 + (n0 & 127);
            tr_item(W, 256, W1 + (size_t)e * 512 * 1024, 1024, 64 * kb, n0, drow0, nullptr, scr, C.lane); }
        else { const float* W = (e < 64) ? (P.w_down + ((size_t)li * 64 + e) * 256 * 1024) : (P.sh_down + (size_t)li * 256 * 1024);
            const int kb = idx >> 5, nb = idx & 31;
            tr_item(W, 1024, W2 + (size_t)e * 1024 * 256, 256, 64 * kb, 32 * nb, 32 * nb, nullptr, scr, C.lane); }
    }
}

__device__ __forceinline__ void ph_s5_tables(const Ctx& C, const Params& P) {
    LAS float* LST = (LAS float*)(C.lds + RING_OFF);
    LAS float* BB = LST + 256;
    LAS float* CC = BB + 4096;
    LAS float* LP = CC + 4096;
    LAS float* KT = LP + 8448;
    bf16* SOUT = (bf16*)(P.ws + WS_SOUT); bf16* WG = (bf16*)(P.ws + WS_WG); float* LAMT = (float*)(P.ws + WS_LAMT);
    for (int g = C.G - 1 - C.bid; g < S5G; g += C.G) {
        __syncthreads();
        if (C.tid < 128) { const int dir = C.tid >> 6, p = C.tid & 63, gi = dir * 32 + g;
            const float lr = fminf(P.lam_re[gi * 64 + p], -1e-4f), li = P.lam_im[gi * 64 + p], step = expf(P.log_step[gi]);
            const float a = lr * step, b = li * step; LST[(dir * 64 + p) * 2] = a; LST[(dir * 64 + p) * 2 + 1] = b;
            const float ea = expf(a), lbr = ea * cosf(b), lbi = ea * sinf(b);
            const float nr = lbr - 1.0f, ni = lbi, den = lr * lr + li * li;
            const float qr = (nr * lr + ni * li) / den, qi = (ni * lr - nr * li) / den;
            for (int h = 0; h < 16; ++h) { const float br = P.b_re[((size_t)gi * 64 + p) * 16 + h], bi = P.b_im[((size_t)gi * 64 + p) * 16 + h];
                BB[((dir * 64 + p) * 16 + h) * 2] = qr * br - qi * bi; BB[((dir * 64 + p) * 16 + h) * 2 + 1] = qr * bi + qi * br; } }
        for (int i = C.tid; i < 2048; i += 512) { const int dir = i >> 10, r = i & 1023; const size_t gi = (size_t)(dir * 32 + g) * 1024 + r; CC[i * 2] = P.c_re[gi]; CC[i * 2 + 1] = P.c_im[gi]; }
        __syncthreads();
        for (int i = C.tid; i < 2 * 33 * 64; i += 512) { const int dir = i / (33 * 64), r = i % (33 * 64), tau = r >> 6, p = r & 63;
            const float a = LST[(dir * 64 + p) * 2] * (float)tau, b = LST[(dir * 64 + p) * 2 + 1] * (float)tau; const float ea = expf(a);
            LP[i * 2] = ea * cosf(b); LP[i * 2 + 1] = ea * sinf(b); }
        __syncthreads();
        for (int i = C.tid; i < 2 * 32 * 256; i += 512) { const int dir = i >> 13, tau = (i >> 8) & 31, hp = (i >> 4) & 15, h = i & 15;
            float s = 0.f;
            for (int p = 0; p < 64; ++p) { const float cr = CC[((dir * 16 + hp) * 64 + p) * 2], ci = CC[((dir * 16 + hp) * 64 + p) * 2 + 1];
                const float lr = LP[((dir * 33 + tau) * 64 + p) * 2], li = LP[((dir * 33 + tau) * 64 + p) * 2 + 1];
                const float xr = cr * lr - ci * li, xi = cr * li + ci * lr;
                s += xr * BB[((dir * 64 + p) * 16 + h) * 2] - xi * BB[((dir * 64 + p) * 16 + h) * 2 + 1]; }
            KT[i] = s; }
        __syncthreads();
        for (int i = C.tid; i < 512 * 96; i += 512) { const int n = i / 96, k0 = (i % 96) * 8, t = n >> 4, hp = n & 15; float v[8];
#pragma unroll
            for (int j = 0; j < 8; ++j) { const int k = k0 + j;
                if (k < 512) { const int s = k >> 4, h = k & 15;
                    if (t > s) v[j] = KT[((0 * 32 + (t - s)) * 16 + hp) * 16 + h];
                    else if (t < s) v[j] = KT[((1 * 32 + (s - t)) * 16 + hp) * 16 + h];
                    else v[j] = KT[((0 * 32) * 16 + hp) * 16 + h] + KT[((1 * 32) * 16 + hp) * 16 + h] + (hp == h ? P.s5_d[g * 16 + h] : 0.f); }
                else { const int q = k - 512, dir = q >> 7, ri = (q >> 6) & 1, p = q & 63, tau = dir == 0 ? t + 1 : 32 - t;
                    const float cr = CC[((dir * 16 + hp) * 64 + p) * 2], ci = CC[((dir * 16 + hp) * 64 + p) * 2 + 1];
                    const float lr = LP[((dir * 33 + tau) * 64 + p) * 2], li = LP[((dir * 33 + tau) * 64 + p) * 2 + 1];
                    v[j] = ri == 0 ? (cr * lr - ci * li) : -(cr * li + ci * lr); } }
            u32x4 o; o.x = pk2(v[0], v[1]); o.y = pk2(v[2], v[3]); o.z = pk2(v[4], v[5]); o.w = pk2(v[6], v[7]);
            *(u32x4*)(WG + ((size_t)g * 512 + n) * 768 + k0) = o; }
        for (int i = C.tid; i < 256 * 64; i += 512) { const int q = i >> 6, k0 = (i & 63) * 8, dir = q >> 7, ri = (q >> 6) & 1, p = q & 63; float v[8];
#pragma unroll
            for (int j = 0; j < 8; ++j) { const int k = k0 + j, s = k >> 4, h = k & 15, e = dir == 0 ? 31 - s : s;
                const float lr = LP[((dir * 33 + e) * 64 + p) * 2], li = LP[((dir * 33 + e) * 64 + p) * 2 + 1];
                const float br = BB[((dir * 64 + p) * 16 + h) * 2], bi = BB[((dir * 64 + p) * 16 + h) * 2 + 1];
                v[j] = ri == 0 ? (lr * br - li * bi) : (lr * bi + li * br); }
            u32x4 o; o.x = pk2(v[0], v[1]); o.y = pk2(v[2], v[3]); o.z = pk2(v[4], v[5]); o.w = pk2(v[6], v[7]);
            *(u32x4*)(SOUT + ((size_t)g * 256 + q) * 512 + k0) = o; }
        if (C.tid < 128) { const int dir = C.tid >> 6, p = C.tid & 63; LAMT[((g * 2 + dir) * 64 + p) * 2] = LP[((dir * 33 + 32) * 64 + p) * 2]; LAMT[((g * 2 + dir) * 64 + p) * 2 + 1] = LP[((dir * 33 + 32) * 64 + p) * 2 + 1]; }
    }
    __syncthreads();
}

__device__ __forceinline__ void ph_hy_filter(const Ctx& C, const Params& P) {
    LAS float* Z = (LAS float*)(C.lds + RING_OFF);
    LAS float* H1 = Z + 32 * 33 + 32;
    LAS float* H2T = H1 + 2048;
    float* HFT = (float*)(P.ws + WS_HFT);
    constexpr float PI2 = 6.283185307179586f;
    for (int item = C.bid; item < SEQ / 32; item += C.G) {
        const int n0 = item * 32;
        __syncthreads();
        for (int i = C.tid; i < 32 * 33; i += 512) { const int p = i / 33, j = i % 33, n = n0 + p; const float tn = (float)n / 4095.0f, ang = PI2 * (float)n / 4096.0f; float v;
            if (j == 0) v = tn; else { const int bi = (j - 1) & 15; const float band = 1e-4f + (float)bi * ((15.0f - 1e-4f) / 15.0f); v = (j <= 16) ? cosf(band * ang) : -sinf(band * ang); }
            Z[p * 33 + j] = v; }
        __syncthreads();
        for (int i = C.tid; i < 2048; i += 512) { const int p = i >> 6, u = i & 63; float s = P.f_b1[u];
            for (int j = 0; j < 33; ++j) s += Z[p * 33 + j] * P.f_w1[j * 64 + u];
            H1[p * 64 + u] = sinf(P.f_freq[u] * s); }
        __syncthreads();
        for (int i = C.tid; i < 2048; i += 512) { const int p = i >> 6, u = i & 63; float s = P.f_b2[u];
            for (int k = 0; k < 64; ++k) s += H1[p * 64 + k] * P.f_w2[k * 64 + u];
            H2T[u * 32 + p] = sinf(P.f_freq[u] * s); }
        __syncthreads();
        for (int j = 0; j < 4; ++j) { const int col = C.tid + 512 * j, dir = col >> 10, d = col & 1023;
            float acc[32];
#pragma unroll
            for (int p = 0; p < 32; ++p) acc[p] = 0.f;
            for (int k = 0; k < 64; ++k) { const float w = P.f_w3[(size_t)k * 2048 + col];
#pragma unroll
                for (int p4 = 0; p4 < 8; ++p4) { const f32x4 h = *(const LAS f32x4*)(H2T + k * 32 + p4 * 4); acc[p4 * 4] += h.x * w; acc[p4 * 4 + 1] += h.y * w; acc[p4 * 4 + 2] += h.z * w; acc[p4 * 4 + 3] += h.w * w; } }
            const float delta = 3.0701134573253945f + (float)d * ((15.350567286626972f - 3.0701134573253945f) / 1023.0f);
            float* o = HFT + ((size_t)d * 2 + dir) * 4096 + n0;
#pragma unroll
            for (int p4 = 0; p4 < 8; ++p4) { f32x4 v;
                v.x = acc[p4 * 4] * expf(-((float)(n0 + p4 * 4) / 4095.0f) * delta); v.y = acc[p4 * 4 + 1] * expf(-((float)(n0 + p4 * 4 + 1) / 4095.0f) * delta);
                v.z = acc[p4 * 4 + 2] * expf(-((float)(n0 + p4 * 4 + 2) / 4095.0f) * delta); v.w = acc[p4 * 4 + 3] * expf(-((float)(n0 + p4 * 4 + 3) / 4095.0f) * delta);
                *(f32x4*)(o + p4 * 4) = v; } }
    }
    __syncthreads();
}

__device__ __forceinline__ void ph_norm(const Ctx& C, const Params& P, const float* xin, int li, int sh_idx, bool with_ctx) {
    const int gw = C.bid * 8 + C.wave, NGW = C.G * 8; bf16* H = (bf16*)(P.ws + WS_H);
    const float* mod = (const float*)(P.ws + WS_MOD); const float* modctx = (const float*)(P.ws + WS_MODCTX);
    const int nrows = with_ctx ? TA : T;
    for (int row = gw; row < nrows; row += NGW) {
        const float* xr; const float *sh, *sc;
        if (row < T) { xr = xin + (size_t)row * 1024; const float* m = mod + (size_t)(li * 8 + (row >> 12)) * 6144; sh = m + sh_idx * 1024; sc = m + (sh_idx + 1) * 1024; }
        else { xr = P.ctx + (size_t)(row - T) * 1024; sh = modctx; sc = modctx + 1024; }
        f32x4 v[4]; float s = 0.f;
#pragma unroll
        for (int j = 0; j < 4; ++j) { v[j] = *(const f32x4*)(xr + 256 * j + 4 * C.lane); s += (v[j].x * v[j].x + v[j].y * v[j].y) + (v[j].z * v[j].z + v[j].w * v[j].w); }
        const float rstd = 1.0f / sqrtf(wave_sum(s) * (1.0f / 1024.0f) + EPS);
#pragma unroll
        for (int j = 0; j < 4; ++j) { const f32x4 a = *(const f32x4*)(sc + 256 * j + 4 * C.lane), b = *(const f32x4*)(sh + 256 * j + 4 * C.lane);
            const f32x4 y = v[j] * rstd * (a + 1.0f) + b; u32x2 o; o.x = pk2(y.x, y.y); o.y = pk2(y.z, y.w);
            *(u32x2*)(H + (size_t)row * 1024 + 256 * j + 4 * C.lane) = o; }
    }
}

__device__ __forceinline__ void ph_rownorm1(const Ctx& C, const Params& P) {
    const int gw = C.bid * 8 + C.wave, NGW = C.G * 8; const bf16* PROJ = (const bf16*)(P.ws + AR_PROJ); bf16* QN = (bf16*)(P.ws + AR_QN); bf16* CKV = (bf16*)(P.ws + AR_CKV);
    for (int row = gw; row < TA; row += NGW) {
        const u32x2 q = *(const u32x2*)(PROJ + (size_t)row * 512 + 4 * C.lane); const unsigned kv = *(const unsigned*)(PROJ + (size_t)row * 512 + 256 + 2 * C.lane);
        const float q0 = bflo(q.x), q1 = bfhi(q.x), q2 = bflo(q.y), q3 = bfhi(q.y), k0 = bflo(kv), k1 = bfhi(kv);
        const float sq = wave_sum((q0 * q0 + q1 * q1) + (q2 * q2 + q3 * q3)), sk = wave_sum(k0 * k0 + k1 * k1);
        const float rq = 1.0f / sqrtf(sq * (1.0f / 256.0f) + EPS), rk = 1.0f / sqrtf(sk * (1.0f / 128.0f) + EPS);
        if (row < T) { u32x2 o; o.x = pk2(q0 * rq, q1 * rq); o.y = pk2(q2 * rq, q3 * rq); *(u32x2*)(QN + (size_t)row * 256 + 4 * C.lane) = o; }
        *(unsigned*)(CKV + (size_t)row * 256 + 2 * C.lane) = pk2(k0 * rk, k1 * rk);
        *(unsigned*)(CKV + (size_t)row * 256 + 128 + 2 * C.lane) = 0u;
    }
}

__device__ __forceinline__ void ph_qkfinal(const Ctx& C, const Params& P) {
    const int gw = C.bid * 8 + C.wave, NGW = C.G * 8;
    const bf16* PROJ = (const bf16*)(P.ws + AR_PROJ); const bf16* KVRAW = (const bf16*)(P.ws + AR_KVRAW); bf16* KF = (bf16*)(P.ws + AR_KF); bf16* Q = (bf16*)(P.ws + AR_QRAW);
    const int hd = C.lane >> 3, sub = C.lane & 7, j0 = 12 * sub;
    constexpr float QSCALE = 0.10206207261596577f * 1.4426950408889634f;
    float gq[12], gk[12];
#pragma unroll
    for (int i = 0; i < 12; ++i) { gq[i] = P.q_qk[j0 + i]; gk[i] = P.k_qk[j0 + i]; }
    for (int row = gw; row < TA; row += NGW) {
        const bool lat = row < T; const int pos = row & 4095;
        float cs[6], sn[6];
#pragma unroll
        for (int i = 0; i < 6; ++i) { const int j = j0 + 2 * i; cs[i] = 1.f; sn[i] = 0.f;
            if (j >= 64 && lat) { const int pi = (j - 64) >> 1; const float inv = exp2f(-(float)(pi & 7) * (13.287712379549449f / 8.0f)); const float ang = (float)(pi < 8 ? (pos >> 6) : (pos & 63)) * inv; cs[i] = cosf(ang); sn[i] = sinf(ang); } }
        { float x[12];
#pragma unroll
          for (int i = 0; i < 3; ++i) { const int j = j0 + 4 * i; const bf16* src = (j < 64) ? (KVRAW + (size_t)row * 1024 + hd * 128 + j) : (PROJ + (size_t)row * 512 + 384 + (j - 64));
              const u32x2 w = *(const u32x2*)src; x[4 * i] = bflo(w.x); x[4 * i + 1] = bfhi(w.x); x[4 * i + 2] = bflo(w.y); x[4 * i + 3] = bfhi(w.y); }
          float s = 0.f;
#pragma unroll
          for (int i = 0; i < 12; ++i) s += x[i] * x[i];
          s += __shfl_xor(s, 1); s += __shfl_xor(s, 2); s += __shfl_xor(s, 4);
          const float r = 1.0f / sqrtf(s * (1.0f / 96.0f) + EPS);
#pragma unroll
          for (int i = 0; i < 12; ++i) x[i] = x[i] * r * gk[i];
#pragma unroll
          for (int i = 0; i < 6; ++i) { const float a = x[2 * i], b = x[2 * i + 1]; x[2 * i] = a * cs[i] - b * sn[i]; x[2 * i + 1] = a * sn[i] + b * cs[i]; }
#pragma unroll
          for (int i = 0; i < 3; ++i) { u32x2 o; o.x = pk2(x[4 * i], x[4 * i + 1]); o.y = pk2(x[4 * i + 2], x[4 * i + 3]); *(u32x2*)(KF + (size_t)row * 768 + hd * 96 + j0 + 4 * i) = o; } }
        if (lat) { float x[12];
#pragma unroll
          for (int i = 0; i < 3; ++i) { const u32x2 w = *(const u32x2*)(Q + (size_t)row * 768 + hd * 96 + j0 + 4 * i); x[4 * i] = bflo(w.x); x[4 * i + 1] = bfhi(w.x); x[4 * i + 2] = bflo(w.y); x[4 * i + 3] = bfhi(w.y); }
          float s = 0.f;
#pragma unroll
          for (int i = 0; i < 12; ++i) s += x[i] * x[i];
          s += __shfl_xor(s, 1); s += __shfl_xor(s, 2); s += __shfl_xor(s, 4);
          const float r = 1.0f / sqrtf(s * (1.0f / 96.0f) + EPS);
#pragma unroll
          for (int i = 0; i < 12; ++i) x[i] = x[i] * r * gq[i];
#pragma unroll
          for (int i = 0; i < 6; ++i) { const float a = x[2 * i], b = x[2 * i + 1]; x[2 * i] = (a * cs[i] - b * sn[i]) * QSCALE; x[2 * i + 1] = (a * sn[i] + b * cs[i]) * QSCALE; }
#pragma unroll
          for (int i = 0; i < 3; ++i) { u32x2 o; o.x = pk2(x[4 * i], x[4 * i + 1]); o.y = pk2(x[4 * i + 2], x[4 * i + 3]); *(u32x2*)(Q + (size_t)row * 768 + hd * 96 + j0 + 4 * i) = o; } }
    }
}

using pg8::Unit;
#define EPI_ARGS const f32x4 (&acc)[2][2][4][2], const Unit& u, int wr, int wc, int fr, int fq
__device__ __forceinline__ u32x4 pack8(const f32x4 a, const f32x4 b) { u32x4 w; w.x = pg8::cvt_pk_bf16(a[0], a[1]); w.y = pg8::cvt_pk_bf16(a[2], a[3]); w.z = pg8::cvt_pk_bf16(b[0], b[1]); w.w = pg8::cvt_pk_bf16(b[2], b[3]); return w; }

struct SchedDense {
    const char* A; const char* B; unsigned lda, ldb; int nM, nN, G, c;
    __device__ __forceinline__ bool next(int i, Unit& u) const { const int L = i * G + c; if (L >= nM * nN) return false; const int pm = L / nN, pn = L % nN;
        u.A = A + (size_t)pm * 256 * lda; u.B = B + (size_t)pn * 256 * ldb; u.rows = nullptr; u.pm = pm; u.pn = pn; u.z = 0; return true; }
};
struct SchedBatched {
    const char* A; const char* B; unsigned lda, ldb; size_t sA, sB; int nZ, nM, nN, G, c;
    __device__ __forceinline__ bool next(int i, Unit& u) const { const int L = i * G + c; if (L >= nZ * nM * nN) return false; const int z = L / (nM * nN), r = L % (nM * nN), pm = r / nN, pn = r % nN;
        u.A = A + (size_t)z * sA + (size_t)pm * 256 * lda; u.B = B + (size_t)z * sB + (size_t)pn * 256 * ldb; u.rows = nullptr; u.pm = pm; u.pn = pn; u.z = z; return true; }
};
struct SchedUp {
    const char *QN, *WUQ, *CKV, *WUKV; int G, c;
    __device__ __forceinline__ bool next(int i, Unit& u) const { int L = i * G + c; u.rows = nullptr;
        if (L < 384) { u.pm = L / 3; u.pn = L % 3; u.z = 0; u.A = QN + (size_t)u.pm * 256 * 512; u.B = WUQ + (size_t)u.pn * 256 * 512; return true; }
        L -= 384; if (L >= 544) return false; u.pm = L >> 2; u.pn = L & 3; u.z = 1; u.A = CKV + (size_t)u.pm * 256 * 512; u.B = WUKV + (size_t)u.pn * 256 * 512; return true; }
};

struct EpiInProj {
    static constexpr bool PERM = true; bf16* PROJ; bf16* U;
    __device__ __forceinline__ void operator()(EPI_ARGS) const {
#pragma unroll
        for (int ai = 0; ai < 2; ++ai)
#pragma unroll
            for (int m = 0; m < 4; ++m) { const int row = u.pm * 256 + ai * 128 + wr * 64 + m * 16 + fr; int urow, s;
                if (row < T) { const int b = row >> 12, pos = row & 4095; urow = (pos >> 5) * 8 + b; s = pos & 31; } else { const int rr = row - T, b = rr >> 8, pos = rr & 255; urow = 1024 + (pos >> 5) * 8 + b; s = pos & 31; }
#pragma unroll
                for (int bj = 0; bj < 2; ++bj) { const int col0 = u.pn * 256 + bj * 128 + wc * 32 + 8 * fq; const u32x4 w = pack8(acc[ai][bj][m][0], acc[ai][bj][m][1]);
                    if (col0 < UOFF) *(u32x4*)(PROJ + (size_t)row * 512 + col0) = w;
                    else if (col0 < EVEN_IN) { const int gc = col0 - UOFF, g = gc >> 4, h0 = gc & 15; *(u32x4*)(U + ((size_t)(g * S5ROWS + urow) * S5K + s * 16 + h0)) = w; } } }
    }
};
struct EpiUp {
    static constexpr bool PERM = true; bf16* QRAW; bf16* KVRAW;
    __device__ __forceinline__ void operator()(EPI_ARGS) const { bf16* O = u.z ? KVRAW : QRAW; const int ldc = u.z ? 1024 : 768;
#pragma unroll
        for (int ai = 0; ai < 2; ++ai)
#pragma unroll
            for (int m = 0; m < 4; ++m) { const int row = u.pm * 256 + ai * 128 + wr * 64 + m * 16 + fr;
#pragma unroll
                for (int bj = 0; bj < 2; ++bj) { const int col0 = u.pn * 256 + bj * 128 + wc * 32 + 8 * fq; *(u32x4*)(O + (size_t)row * ldc + col0) = pack8(acc[ai][bj][m][0], acc[ai][bj][m][1]); } }
    }
};
struct EpiF32Batched {
    static constexpr bool PERM = false; float* O; int rows_per_z, ldc;
    __device__ __forceinline__ void operator()(EPI_ARGS) const {
#pragma unroll
        for (int ai = 0; ai < 2; ++ai)
#pragma unroll
            for (int m = 0; m < 4; ++m) { const int row = u.pm * 256 + ai * 128 + wr * 64 + m * 16 + fr; float* rp = O + ((size_t)u.z * rows_per_z + row) * ldc + u.pn * 256 + wc * 32 + 4 * fq;
#pragma unroll
                for (int bj = 0; bj < 2; ++bj)
#pragma unroll
                    for (int n = 0; n < 2; ++n) *(f32x4*)(rp + bj * 128 + n * 16) = acc[ai][bj][m][n]; }
    }
};
struct EpiS5C {
    static constexpr bool PERM = true; bf16* Z;
    __device__ __forceinline__ void operator()(EPI_ARGS) const {
#pragma unroll
        for (int ai = 0; ai < 2; ++ai)
#pragma unroll
            for (int m = 0; m < 4; ++m) { const int rr = u.pm * 256 + ai * 128 + wr * 64 + m * 16 + fr, c = rr >> 3, b = rr & 7;
#pragma unroll
                for (int bj = 0; bj < 2; ++bj) { const int cc = u.pn * 256 + bj * 128 + wc * 32 + 8 * fq, t = cc >> 4, h0 = cc & 15; f32x4 v0 = acc[ai][bj][m][0], v1 = acc[ai][bj][m][1];
#pragma unroll
                    for (int j = 0; j < 4; ++j) { v0[j] = gelu_tanh(v0[j]); v1[j] = gelu_tanh(v1[j]); }
                    *(u32x4*)(Z + ((size_t)(b * 4096 + c * 32 + t) * 512 + u.z * 16 + h0)) = pack8(v0, v1); } }
    }
};
struct EpiGlu {
    static constexpr bool PERM = true; const bf16* Z; const float* gb; bf16* CAT;
    __device__ __forceinline__ void operator()(EPI_ARGS) const {
#pragma unroll
        for (int ai = 0; ai < 2; ++ai)
#pragma unroll
            for (int m = 0; m < 4; ++m) { const int row = u.pm * 256 + ai * 128 + wr * 64 + m * 16 + fr;
#pragma unroll
                for (int bj = 0; bj < 2; ++bj) { const int col0 = u.pn * 256 + bj * 128 + wc * 32 + 8 * fq; const u32x4 zw = *(const u32x4*)(Z + (size_t)row * 512 + col0);
                    const f32x4 b0 = *(const f32x4*)(gb + col0), b1 = *(const f32x4*)(gb + col0 + 4); f32x4 v0 = acc[ai][bj][m][0] + b0, v1 = acc[ai][bj][m][1] + b1;
                    v0[0] = bflo(zw.x) * sigmf(v0[0]); v0[1] = bfhi(zw.x) * sigmf(v0[1]); v0[2] = bflo(zw.y) * sigmf(v0[2]); v0[3] = bfhi(zw.y) * sigmf(v0[3]);
                    v1[0] = bflo(zw.z) * sigmf(v1[0]); v1[1] = bfhi(zw.z) * sigmf(v1[1]); v1[2] = bflo(zw.w) * sigmf(v1[2]); v1[3] = bfhi(zw.w) * sigmf(v1[3]);
                    *(u32x4*)(CAT + (size_t)row * 1024 + 512 + col0) = pack8(v0, v1); } }
    }
};
struct EpiResid {
    static constexpr bool PERM = false; const float* xin; float* xout; const float* gate;
    __device__ __forceinline__ void operator()(EPI_ARGS) const {
#pragma unroll
        for (int ai = 0; ai < 2; ++ai)
#pragma unroll
            for (int m = 0; m < 4; ++m) { const int row = u.pm * 256 + ai * 128 + wr * 64 + m * 16 + fr; const int col0 = u.pn * 256 + wc * 32 + 4 * fq; const float* gp = gate + (size_t)(row >> 12) * 6144 + col0;
#pragma unroll
                for (int bj = 0; bj < 2; ++bj)
#pragma unroll
                    for (int n = 0; n < 2; ++n) { const size_t o = (size_t)row * 1024 + col0 + bj * 128 + n * 16; const f32x4 xv = *(const f32x4*)(xin + o), gv = *(const f32x4*)(gp + bj * 128 + n * 16);
                        *(f32x4*)(xout + o) = xv + gv * acc[ai][bj][m][n]; } }
    }
};

__device__ __forceinline__ void ph_s5_scan(const Ctx& C, const Params& P) {
    const int gt = C.bid * 512 + C.tid; if (gt >= S5G * NB * 128) return;
    const int p = gt & 63, dir = (gt >> 6) & 1, b = (gt >> 7) & 7, g = gt >> 10;
    const float* LAMT = (const float*)(P.ws + WS_LAMT); const float lr = LAMT[((g * 2 + dir) * 64 + p) * 2], li = LAMT[((g * 2 + dir) * 64 + p) * 2 + 1];
    const float* S = (const float*)(P.ws + AR_SRAW) + (size_t)g * S5ROWS * 256 + dir * 128 + p;
    bf16* Ug = (bf16*)(P.ws + AR_U) + (size_t)g * S5ROWS * S5K + 512 + dir * 128 + p;
    float sr = 0.f, si = 0.f;
    if (dir == 0) {
#pragma unroll
        for (int j = 0; j < S5NCC; ++j) { const int row = 1024 + j * 8 + b; const float ar = S[(size_t)row * 256], ai = S[(size_t)row * 256 + 64]; const float nr = lr * sr - li * si + ar, ni = lr * si + li * sr + ai; sr = nr; si = ni; }
#pragma unroll 8
        for (int c = 0; c < S5NCH; ++c) { const int row = c * 8 + b; const float ar = S[(size_t)row * 256], ai = S[(size_t)row * 256 + 64];
            Ug[(size_t)row * S5K] = (bf16)f2bf(sr); Ug[(size_t)row * S5K + 64] = (bf16)f2bf(si);
            const float nr = lr * sr - li * si + ar, ni = lr * si + li * sr + ai; sr = nr; si = ni; }
    } else {
#pragma unroll
        for (int j = S5NCC - 1; j >= 0; --j) { const int row = 1024 + j * 8 + b; const float ar = S[(size_t)row * 256], ai = S[(size_t)row * 256 + 64]; const float nr = lr * sr - li * si + ar, ni = lr * si + li * sr + ai; sr = nr; si = ni; }
#pragma unroll 8
        for (int c = S5NCH - 1; c >= 0; --c) { const int row = c * 8 + b; const float ar = S[(size_t)row * 256], ai = S[(size_t)row * 256 + 64];
            Ug[(size_t)row * S5K] = (bf16)f2bf(sr); Ug[(size_t)row * S5K + 64] = (bf16)f2bf(si);
            const float nr = lr * sr - li * si + ar, ni = lr * si + li * sr + ai; sr = nr; si = ni; }
    }
}

constexpr int AT_KROW = 208, AT_KB = 64 * AT_KROW  , AT_VB = 8192;
constexpr int AT_K = RING_OFF, AT_V = AT_K + 2 * AT_KB, AT_WS = AT_V + 2 * AT_VB, AT_OST = AT_WS + 8 * 256, AT_END = AT_OST + 8 * 4096;
__device__ __forceinline__ int crow(int r, int hi) { return (r & 3) + 8 * (r >> 2) + 4 * hi; }
typedef short v4i16_t __attribute__((ext_vector_type(4)));
__device__ __forceinline__ s16x4 vtr(const LAS unsigned char* p) { return __builtin_bit_cast(s16x4, __builtin_amdgcn_ds_read_tr16_b64_v4i16((LAS v4i16_t*)p)); }
__device__ __forceinline__ float xhalf_max(float m) { auto rr = __builtin_amdgcn_permlane32_swap(__float_as_uint(m), __float_as_uint(m), false, false); return fmaxf(__uint_as_float(rr[0]), __uint_as_float(rr[1])); }
__device__ __forceinline__ float xhalf_sum(float m) { auto rr = __builtin_amdgcn_permlane32_swap(__float_as_uint(m), __float_as_uint(m), false, false); return __uint_as_float(rr[0]) + __uint_as_float(rr[1]); }

__device__ __forceinline__ void ph_attention(const Ctx& C, const Params& P, int vcu) {
    const bf16* Q = (const bf16*)(P.ws + AR_QRAW); const bf16* KF = (const bf16*)(P.ws + AR_KF); const bf16* KV = (const bf16*)(P.ws + AR_KVRAW); bf16* CAT = (bf16*)(P.ws + AR_CAT);
    const int tid = C.tid, lane = C.lane, wid = C.wave, r32 = lane & 31, hi = lane >> 5;
    LAS unsigned char* lds = C.lds;
    LAS float* wsf = (LAS float*)(lds + AT_WS) + wid * 64;
    const int kr0 = tid / 12, kc0 = tid % 12, kr1 = (tid + 512) / 12, kc1 = (tid + 512) % 12; const bool k2 = tid < 256;
    const int vr = tid >> 3, vc = tid & 7;
    const unsigned kd0 = kr0 * AT_KROW + kc0 * 16, kd1 = kr1 * AT_KROW + kc1 * 16, vd = (vc >> 2) * 4096 + vr * 64 + (vc & 3) * 16;
    const int vrd = ((lane >> 4) & 1) * 32 + (lane & 3) * 8 + (4 * hi + ((lane & 15) >> 2)) * 64;
    constexpr int NTILE = (SEQ + CTXL) / 64;
    constexpr float THR = 8.0f;
    for (int i = 0;; ++i) {
        const int un = i * C.G + vcu; if (un >= NB * NHEAD * 16) break;
        const int bh = un >> 4, qb = un & 15, b = bh >> 3, hd = bh & 7;
        const size_t qrow = (size_t)b * SEQ + qb * 256 + wid * 32 + r32;
        bf16x8 qr[6];
#pragma unroll
        for (int d0 = 0; d0 < 6; ++d0) qr[d0] = *(const bf16x8*)(Q + qrow * 768 + hd * 96 + d0 * 16 + hi * 8);
        f32x16 o0 = {}, o1 = {}; float m = -1e30f, l = 0.f;
        u32x4 gk0, gk1 = {}, gv;
#define AT_LOAD(j) do { const size_t r0 = ((j) < 64) ? ((size_t)b * SEQ + (size_t)(j) * 64) : ((size_t)T + (size_t)b * CTXL + (size_t)((j) - 64) * 64); \
            gk0 = *(const u32x4*)(KF + (r0 + kr0) * 768 + hd * 96 + kc0 * 8); if (k2) gk1 = *(const u32x4*)(KF + (r0 + kr1) * 768 + hd * 96 + kc1 * 8); \
            gv = *(const u32x4*)(KV + (r0 + vr) * 1024 + hd * 128 + 64 + vc * 8); } while (0)
#define AT_STORE(buf) do { *(LAS u32x4*)(lds + AT_K + (buf) * AT_KB + kd0) = gk0; if (k2) *(LAS u32x4*)(lds + AT_K + (buf) * AT_KB + kd1) = gk1; *(LAS u32x4*)(lds + AT_V + (buf) * AT_VB + vd) = gv; } while (0)
        AT_LOAD(0); AT_STORE(0);
        __syncthreads();
        for (int j = 0; j < NTILE; ++j) {
            const int buf = j & 1;
            if (j + 1 < NTILE) AT_LOAD(j + 1);
            const LAS unsigned char* Kb = lds + AT_K + buf * AT_KB + r32 * AT_KROW + hi * 16;
            f32x16 p0 = {}, p1 = {};
#pragma unroll
            for (int d0 = 0; d0 < 6; ++d0) { const bf16x8 a0 = *(const LAS bf16x8*)(Kb + d0 * 32), a1 = *(const LAS bf16x8*)(Kb + 32 * AT_KROW + d0 * 32);
                p0 = __builtin_amdgcn_mfma_f32_32x32x16_bf16(a0, qr[d0], p0, 0, 0, 0); p1 = __builtin_amdgcn_mfma_f32_32x32x16_bf16(a1, qr[d0], p1, 0, 0, 0); }
            float mt = fmaxf(p0[0], p1[0]);
#pragma unroll
            for (int r = 1; r < 16; ++r) mt = fmaxf(mt, fmaxf(p0[r], p1[r]));
            mt = xhalf_max(mt);
            if (__any(mt > m + THR)) {
                const float mn = fmaxf(m, mt), alpha = __builtin_amdgcn_exp2f(m - mn); m = mn; l *= alpha;
                if (hi == 0) wsf[r32] = alpha;
                LDS_WAIT();
#pragma unroll
                for (int r = 0; r < 16; ++r) { const float a = wsf[crow(r, hi)]; o0[r] *= a; o1[r] *= a; }
            }
            float ls = 0.f;
#pragma unroll
            for (int r = 0; r < 16; ++r) { p0[r] = __builtin_amdgcn_exp2f(p0[r] - m); p1[r] = __builtin_amdgcn_exp2f(p1[r] - m); ls += p0[r] + p1[r]; }
            l += ls;
            bf16x8 pw[4];
#pragma unroll
            for (int ks = 0; ks < 4; ++ks) { u32x4 w;
#pragma unroll
                for (int q = 0; q < 4; ++q) { const int r = (ks & 1) * 8 + 2 * q; w[q] = (ks < 2) ? pg8::cvt_pk_bf16(p0[r], p0[r + 1]) : pg8::cvt_pk_bf16(p1[r], p1[r + 1]); }
                pw[ks] = __builtin_bit_cast(bf16x8, w); }
            const LAS unsigned char* Vb = lds + AT_V + buf * AT_VB + vrd;
#pragma unroll
            for (int ks = 0; ks < 4; ++ks) {
                const s16x4 l0 = vtr(Vb + ks * 1024), h0 = vtr(Vb + ks * 1024 + 512), l1 = vtr(Vb + 4096 + ks * 1024), h1 = vtr(Vb + 4096 + ks * 1024 + 512);
                const bf16x8 v0 = (bf16x8){l0[0], l0[1], l0[2], l0[3], h0[0], h0[1], h0[2], h0[3]}, v1 = (bf16x8){l1[0], l1[1], l1[2], l1[3], h1[0], h1[1], h1[2], h1[3]};
                o0 = __builtin_amdgcn_mfma_f32_32x32x16_bf16(pw[ks], v0, o0, 0, 0, 0); o1 = __builtin_amdgcn_mfma_f32_32x32x16_bf16(pw[ks], v1, o1, 0, 0, 0); }
            if (j + 1 < NTILE) AT_STORE(buf ^ 1);
            __syncthreads();
        }
        l = xhalf_sum(l);
        if (hi == 0) wsf[32 + r32] = l;
        LDS_WAIT();
        bf16* stg = (bf16*)0; LAS bf16* stl = (LAS bf16*)(lds + AT_OST + wid * 4096); (void)stg;
#pragma unroll
        for (int r = 0; r < 16; ++r) { const int orow = crow(r, hi); const float rl = 1.0f / wsf[32 + orow];
            stl[orow * 64 + r32] = (bf16)f2bf(o0[r] * rl); stl[orow * 64 + 32 + r32] = (bf16)f2bf(o1[r] * rl); }
        LDS_WAIT();
        const size_t orow0 = (size_t)b * SEQ + qb * 256 + wid * 32;
#pragma unroll
        for (int q = 0; q < 4; ++q) { const int row = q * 8 + (lane >> 3), ch = lane & 7; const u32x4 v = *(const LAS u32x4*)(stl + row * 64 + ch * 8); *(u32x4*)(CAT + (orow0 + row) * 1024 + hd * 64 + ch * 8) = v; }
        __syncthreads();
#undef AT_LOAD
#undef AT_STORE
    }
}

constexpr int LC_BLKSTART = 128, LC_CNT = 704, LC_BLK2HE = 1216;
constexpr int RT_XT = RING_OFF, RT_LG = RT_XT + 16 * 1028 * 4, RT_SEL = RT_LG + 2 * 16 * 64 * 4, RT_LCNT = RT_SEL + 16 * 8 * 4, RT_LRANK = RT_LCNT + 64 * 4, RT_GBASE = RT_LRANK + 96 * 4;

__device__ __forceinline__ void ph_router(const Ctx& C, const Params& P, const float* xin, int li) {
    LAS float* XT = (LAS float*)(C.lds + RT_XT); LAS float* LG = (LAS float*)(C.lds + RT_LG); LAS int* SEL = (LAS int*)(C.lds + RT_SEL);
    LAS int* lcnt = (LAS int*)(C.lds + RT_LCNT); LAS int* lrank = (LAS int*)(C.lds + RT_LRANK); LAS int* gbase = (LAS int*)(C.lds + RT_GBASE);
    bf16* H = (bf16*)(P.ws + WS_H); const float* mod = (const float*)(P.ws + WS_MOD); float* TOPW = (float*)(P.ws + WS_TOPW); int* TOK = (int*)(P.ws + WS_TOK);
    unsigned* gcnt = (unsigned*)(P.ws + WS_CTL) + CW_CNT + (li * 2) * 64 * 16;
    const float* RW = P.router_w + (size_t)li * 1024 * 64; const float* RB = P.router_b + li * 64;
    const int lane = C.lane, w = C.wave;
    for (int tile = C.bid; tile < T / 16; tile += C.G) {
        const int t0 = tile * 16, hf = t0 >= HALF_T ? 1 : 0;
#pragma unroll
        for (int rr = 0; rr < 2; ++rr) { const int i = 2 * w + rr, row = t0 + i; const float* xr = xin + (size_t)row * 1024; const float* m = mod + (size_t)(li * 8 + (row >> 12)) * 6144;
            f32x4 v[4]; float s = 0.f;
#pragma unroll
            for (int j = 0; j < 4; ++j) { v[j] = *(const f32x4*)(xr + 256 * j + 4 * lane); s += (v[j].x * v[j].x + v[j].y * v[j].y) + (v[j].z * v[j].z + v[j].w * v[j].w); }
            const float rstd = 1.0f / sqrtf(wave_sum(s) * (1.0f / 1024.0f) + EPS);
#pragma unroll
            for (int j = 0; j < 4; ++j) { const f32x4 a = *(const f32x4*)(m + 4096 + 256 * j + 4 * lane), b = *(const f32x4*)(m + 3072 + 256 * j + 4 * lane);
                const f32x4 y = v[j] * rstd * (a + 1.0f) + b; u32x2 o; o.x = pk2(y.x, y.y); o.y = pk2(y.z, y.w);
                *(u32x2*)(H + (size_t)row * 1024 + 256 * j + 4 * lane) = o; *(LAS f32x4*)(XT + i * 1028 + 256 * j + 4 * lane) = y; } }
        if (C.tid < 64) lcnt[C.tid] = 0;
        __syncthreads();
        { const int eq = w & 3, kh = w >> 2, fi = lane & 15, fk = lane >> 4; f32x4 acc = {0.f, 0.f, 0.f, 0.f};
#pragma unroll 2
          for (int ms = 0; ms < 32; ++ms) { const int k0 = kh * 512 + ms * 16 + 4 * fk; const f32x4 a4 = *(const LAS f32x4*)(XT + fi * 1028 + k0);
              const float b0 = RW[(size_t)(k0 + 0) * 64 + eq * 16 + fi], b1 = RW[(size_t)(k0 + 1) * 64 + eq * 16 + fi], b2 = RW[(size_t)(k0 + 2) * 64 + eq * 16 + fi], b3 = RW[(size_t)(k0 + 3) * 64 + eq * 16 + fi];
              acc = __builtin_amdgcn_mfma_f32_16x16x4f32(a4.x, b0, acc, 0, 0, 0); acc = __builtin_amdgcn_mfma_f32_16x16x4f32(a4.y, b1, acc, 0, 0, 0);
              acc = __builtin_amdgcn_mfma_f32_16x16x4f32(a4.z, b2, acc, 0, 0, 0); acc = __builtin_amdgcn_mfma_f32_16x16x4f32(a4.w, b3, acc, 0, 0, 0); }
#pragma unroll
          for (int r = 0; r < 4; ++r) LG[(kh * 16 + 4 * fk + r) * 64 + eq * 16 + fi] = acc[r]; }
        __syncthreads();
#pragma unroll
        for (int rr = 0; rr < 2; ++rr) { const int i = 2 * w + rr; const float logit = LG[i * 64 + lane] + LG[(16 + i) * 64 + lane]; const float sc = sigmf(logit); float v = sc + RB[lane];
            float wk = 0.f, wsum = 0.f; int ek = 0;
#pragma unroll
            for (int k = 0; k < TOPK; ++k) { float bv = v; int be = lane;
#pragma unroll
                for (int off = 32; off >= 1; off >>= 1) { const float ov = __shfl_xor(bv, off); const int oe = __shfl_xor(be, off); if (ov > bv || (ov == bv && oe < be)) { bv = ov; be = oe; } }
                const float sk = __shfl(sc, be); wsum += sk; if (lane == k) { wk = sk; ek = be; } if (lane == be) v = -INFINITY; }
            if (lane < TOPK) { TOPW[(size_t)(t0 + i) * 8 + lane] = wk / wsum * 2.5f; SEL[i * 8 + lane] = ek; } }
        __syncthreads();
        int e = 0, a_i = 0, a_k = 0;
        if (C.tid < 96) { a_i = C.tid / 6; a_k = C.tid % 6; e = SEL[a_i * 8 + a_k]; lrank[C.tid] = __hip_atomic_fetch_add(&lcnt[e], 1, __ATOMIC_RELAXED, __HIP_MEMORY_SCOPE_WORKGROUP); }
        __syncthreads();
        if (C.tid < 64) { const int n = lcnt[C.tid]; if (n > 0) gbase[C.tid] = (int)__hip_atomic_fetch_add(gcnt + (hf * 64 + C.tid) * 16, (unsigned)n, RLX_AGENT); }
        __syncthreads();
        if (C.tid < 96) { const int pos = gbase[e] + lrank[C.tid]; TOK[(size_t)(hf * 64 + e) * MOE_CAP + pos] = (t0 + a_i) * 8 + a_k; }
        __syncthreads();
    }
}

__device__ __forceinline__ int moe_tables(const Ctx& C, const Params& P, int li) {
    LAS int* blkstart = (LAS int*)(C.lds + LC_BLKSTART); LAS int* cnt = (LAS int*)(C.lds + LC_CNT); LAS unsigned short* blk2he = (LAS unsigned short*)(C.lds + LC_BLK2HE);
    const unsigned* gcnt = (const unsigned*)(P.ws + WS_CTL) + CW_CNT + (li * 2) * 64 * 16;
    __syncthreads();
    if (C.tid < 128) { int n = (int)__hip_atomic_load(gcnt + C.tid * 16, RLX_AGENT); n = n < 0 ? 0 : (n > MOE_CAP ? MOE_CAP : n); cnt[C.tid] = n; }
    __syncthreads();
    if (C.tid == 0) { int s = 0; for (int i = 0; i < 128; ++i) { blkstart[i] = s; s += (cnt[i] + 255) >> 8; } blkstart[128] = s; }
    __syncthreads();
    const int nblk = blkstart[128];
    if (C.tid < 128) { const int b0 = blkstart[C.tid], b1 = blkstart[C.tid + 1]; for (int b = b0; b < b1 && b < MAXBLK; ++b) blk2he[b] = (unsigned short)C.tid; }
    __syncthreads();
    return nblk < MAXBLK ? nblk : MAXBLK;
}
struct SchedMoE1 {
    const char* H; const char* W1; const int* TOK; const LAS int* blkstart; const LAS unsigned short* blk2he; int nblk, G, c;
    __device__ __forceinline__ bool next(int i, Unit& u) const { int L = i * G + c;
        if (L < 2 * nblk) { const int blk = L >> 1, pn = L & 1, he = blk2he[blk], bi = blk - blkstart[he], e = he & 63; u.A = H; u.rows = TOK + (size_t)he * MOE_CAP + bi * 256;
            u.B = W1 + ((size_t)e * 512 + pn * 256) * 2048; u.pm = blk; u.pn = pn; u.z = 0; return true; }
        L -= 2 * nblk; if (L >= 256) return false; u.pm = L >> 1; u.pn = L & 1; u.z = 1; u.A = H + (size_t)u.pm * 256 * 2048; u.rows = nullptr; u.B = W1 + ((size_t)64 * 512 + u.pn * 256) * 2048; return true; }
};
struct EpiMoE1 {
    static constexpr bool PERM = true; bf16* HID; bf16* HIDS;
    __device__ __forceinline__ void operator()(EPI_ARGS) const { bf16* O = u.z ? HIDS : HID;
#pragma unroll
        for (int ai = 0; ai < 2; ++ai)
#pragma unroll
            for (int m = 0; m < 4; ++m) { const size_t row = (size_t)u.pm * 256 + ai * 128 + wr * 64 + m * 16 + fr; f32x4 v0, v1;
#pragma unroll
                for (int j = 0; j < 4; ++j) { v0[j] = siluf(acc[ai][0][m][0][j]) * acc[ai][1][m][0][j]; v1[j] = siluf(acc[ai][0][m][1][j]) * acc[ai][1][m][1][j]; }
                *(u32x4*)(O + row * 256 + u.pn * 128 + wc * 32 + 8 * fq) = pack8(v0, v1); }
    }
};
struct SchedMoE2 {
    const char* HID; const char* W2; const LAS unsigned short* blk2he; int b0, b1, G, c;
    __device__ __forceinline__ bool next(int i, Unit& u) const { const int L = i * G + c; if (L >= (b1 - b0) * 4) return false; const int blk = b0 + (L >> 2), pn = L & 3, he = blk2he[blk], e = he & 63;
        u.A = HID + (size_t)blk * 256 * 512; u.rows = nullptr; u.B = W2 + ((size_t)e * 1024 + pn * 256) * 512; u.pm = blk; u.pn = pn; u.z = he; return true; }
};
struct EpiMoE2 {
    static constexpr bool PERM = true; bf16* YBUF; const int* TOK; const LAS int* blkstart; const LAS int* cnt; int hf;
    __device__ __forceinline__ void operator()(EPI_ARGS) const { const int he = u.z, bi = u.pm - blkstart[he], n = cnt[he];
#pragma unroll
        for (int ai = 0; ai < 2; ++ai)
#pragma unroll
            for (int m = 0; m < 4; ++m) { const int ridx = bi * 256 + ai * 128 + wr * 64 + m * 16 + fr;
                if (ridx < n) { const int v = TOK[(size_t)he * MOE_CAP + ridx]; const int tok = (v >> 3) - hf * HALF_T, k = v & 7; bf16* yp = YBUF + ((size_t)tok * 6 + k) * 1024 + u.pn * 256 + wc * 32 + 8 * fq;
#pragma unroll
                    for (int bj = 0; bj < 2; ++bj) *(u32x4*)(yp + bj * 128) = pack8(acc[ai][bj][m][0], acc[ai][bj][m][1]); } }
    }
};
struct EpiCombine {
    static constexpr bool PERM = true; const bf16* YBUF; const float* TOPW; float* X; const float* gate; int hf;
    __device__ __forceinline__ void operator()(EPI_ARGS) const {
#pragma unroll
        for (int ai = 0; ai < 2; ++ai)
#pragma unroll
            for (int m = 0; m < 4; ++m) { const int th = u.pm * 256 + ai * 128 + wr * 64 + m * 16 + fr, token = hf * HALF_T + th;
                const f32x4 w03 = *(const f32x4*)(TOPW + (size_t)token * 8), w47 = *(const f32x4*)(TOPW + (size_t)token * 8 + 4); const float wk[6] = {w03.x, w03.y, w03.z, w03.w, w47.x, w47.y};
#pragma unroll
                for (int bj = 0; bj < 2; ++bj) { const int col0 = u.pn * 256 + bj * 128 + wc * 32 + 8 * fq; f32x4 v0 = acc[ai][bj][m][0], v1 = acc[ai][bj][m][1];
#pragma unroll
                    for (int k = 0; k < 6; ++k) { const u32x4 y = *(const u32x4*)(YBUF + ((size_t)th * 6 + k) * 1024 + col0);
                        v0[0] += wk[k] * bflo(y.x); v0[1] += wk[k] * bfhi(y.x); v0[2] += wk[k] * bflo(y.y); v0[3] += wk[k] * bfhi(y.y);
                        v1[0] += wk[k] * bflo(y.z); v1[1] += wk[k] * bfhi(y.z); v1[2] += wk[k] * bflo(y.w); v1[3] += wk[k] * bfhi(y.w); }
                    const float* gp = gate + (size_t)(token >> 12) * 6144 + col0; float* xp = X + (size_t)token * 1024 + col0;
                    const f32x4 g0 = *(const f32x4*)gp, g1 = *(const f32x4*)(gp + 4), x0 = *(const f32x4*)xp, x1 = *(const f32x4*)(xp + 4);
                    *(f32x4*)xp = x0 + g0 * v0; *(f32x4*)(xp + 4) = x1 + g1 * v1; } }
    }
};

__device__ __forceinline__ void ph_hy_prep(const Ctx& C, const Params& P) {
    const bf16* PP = (const bf16*)(P.ws + AR_P); bf16* X0 = (bf16*)(P.ws + AR_X0); bf16* ZT = (bf16*)(P.ws + AR_ZT);
    LAS bf16* ZS = (LAS bf16*)(C.lds + RING_OFF);
    const int tl = C.tid >> 3, d8 = (C.tid & 7) * 8;
    for (int dt = 0; dt < 16; ++dt) {
        const int d0 = dt * 64;
        float cw[3][3][8], cb[3][8];
#pragma unroll
        for (int sec = 0; sec < 3; ++sec) {
#pragma unroll
            for (int e = 0; e < 8; ++e) { cb[sec][e] = P.hy_conv_b[sec * 1024 + d0 + d8 + e];
#pragma unroll
                for (int j = 0; j < 3; ++j) cw[sec][j][e] = P.hy_conv_w[j * 3072 + sec * 1024 + d0 + d8 + e]; } }
        for (int bt = C.bid; bt < NB * 64; bt += C.G) {
            const int b = bt >> 6, t0 = (bt & 63) * 64, t = t0 + tl; const size_t row = (size_t)b * SEQ + t;
            float o[3][8];
#pragma unroll
            for (int sec = 0; sec < 3; ++sec) {
#pragma unroll
                for (int e = 0; e < 8; ++e) o[sec][e] = cb[sec][e];
#pragma unroll
                for (int j = 0; j < 3; ++j) { const int tt = t - 1 + j; if (tt >= 0 && tt < SEQ) { const u32x4 w = *(const u32x4*)(PP + ((size_t)b * SEQ + tt) * 3072 + sec * 1024 + d0 + d8);
                        o[sec][0] += bflo(w.x) * cw[sec][j][0]; o[sec][1] += bfhi(w.x) * cw[sec][j][1]; o[sec][2] += bflo(w.y) * cw[sec][j][2]; o[sec][3] += bfhi(w.y) * cw[sec][j][3];
                        o[sec][4] += bflo(w.z) * cw[sec][j][4]; o[sec][5] += bfhi(w.z) * cw[sec][j][5]; o[sec][6] += bflo(w.w) * cw[sec][j][6]; o[sec][7] += bfhi(w.w) * cw[sec][j][7]; } } }
            { u32x4 w; w.x = pk2(o[0][0], o[0][1]); w.y = pk2(o[0][2], o[0][3]); w.z = pk2(o[0][4], o[0][5]); w.w = pk2(o[0][6], o[0][7]); *(u32x4*)(X0 + row * 1024 + d0 + d8) = w; }
            __syncthreads();
#pragma unroll
            for (int e = 0; e < 8; ++e) ZS[(d8 + e) * 72 + tl] = (bf16)f2bf(o[2][e] * o[1][e]);
            __syncthreads();
            { const int dl = C.tid >> 3, tp = (C.tid & 7) * 8; const u32x4 w = *(const LAS u32x4*)(ZS + dl * 72 + tp); *(u32x4*)(ZT + ((size_t)(d0 + dl) * NB + b) * SEQ + t0 + tp) = w; }
        }
    }
    __syncthreads();
}

__device__ __forceinline__ f32x2 cmul(f32x2 a, f32x2 b) { return (f32x2){a.x * b.x - a.y * b.y, a.x * b.y + a.y * b.x}; }
__device__ __forceinline__ f32x2 cmulc(f32x2 a, f32x2 b) { return (f32x2){a.x * b.x + a.y * b.y, a.y * b.x - a.x * b.y}; }
template <bool INV> __device__ __forceinline__ void dft16(f32x2 (&v)[16]) {
    constexpr float WC[10] = {1.f, 0.9238795325112867f, 0.7071067811865476f, 0.3826834323650898f, 0.f, 0.f, -0.7071067811865476f, 0.f, 0.f, -0.9238795325112867f};
    constexpr float WS_[10] = {0.f, 0.3826834323650898f, 0.7071067811865476f, 0.9238795325112867f, 1.f, 0.f, 0.7071067811865476f, 0.f, 0.f, -0.3826834323650898f};
    f32x2 t[16];
#pragma unroll
    for (int b = 0; b < 4; ++b) { const f32x2 x0 = v[b], x1 = v[4 + b], x2 = v[8 + b], x3 = v[12 + b];
        const f32x2 s0 = x0 + x2, s1 = x0 - x2, s2 = x1 + x3, s3 = x1 - x3; const f32x2 is3 = (f32x2){-s3.y, s3.x};
        t[0 * 4 + b] = s0 + s2; t[2 * 4 + b] = s0 - s2; t[1 * 4 + b] = INV ? s1 + is3 : s1 - is3; t[3 * 4 + b] = INV ? s1 - is3 : s1 + is3; }
#pragma unroll
    for (int c = 1; c < 4; ++c)
#pragma unroll
        for (int b = 1; b < 4; ++b) { const int mm = b * c; const f32x2 w = (f32x2){WC[mm], WS_[mm]}; t[c * 4 + b] = INV ? cmul(t[c * 4 + b], w) : cmulc(t[c * 4 + b], w); }
#pragma unroll
    for (int c = 0; c < 4; ++c) { const f32x2 x0 = t[c * 4], x1 = t[c * 4 + 1], x2 = t[c * 4 + 2], x3 = t[c * 4 + 3];
        const f32x2 s0 = x0 + x2, s1 = x0 - x2, s2 = x1 + x3, s3 = x1 - x3; const f32x2 is3 = (f32x2){-s3.y, s3.x};
        v[c] = s0 + s2; v[c + 8] = s0 - s2; v[c + 4] = INV ? s1 + is3 : s1 - is3; v[c + 12] = INV ? s1 - is3 : s1 + is3; }
}
constexpr int FF_TW = RING_OFF, FF_TW2 = FF_TW + 32768, FF_DE = FF_TW2 + 32768, FF_DO = FF_DE + 4352 * 8, FF_RED = FF_DO + 4352 * 8, FF_END = FF_RED + 64;
static_assert(FF_END <= LDS_BYTES, "FFT LDS");
__device__ __forceinline__ int pidx(int i) { return i + (i >> 4); }
__device__ __forceinline__ void fft_fwd(LAS f32x2* D, const LAS f32x2* TW, int t8, f32x2 (&v)[16]) {
#pragma unroll
    for (int a = 0; a < 16; ++a) v[a] = D[pidx(256 * a + t8)];
    dft16<false>(v);
    { const int n1 = t8 >> 4;
#pragma unroll
      for (int k0 = 0; k0 < 16; ++k0) D[pidx(256 * k0 + t8)] = cmul(v[k0], TW[(16 * n1 * k0) & 4095]); }
    __syncthreads();
    { const int k0 = t8 >> 4, n0 = t8 & 15;
#pragma unroll
      for (int a = 0; a < 16; ++a) v[a] = D[pidx(256 * k0 + 16 * a + n0)];
      dft16<false>(v);
#pragma unroll
      for (int k1 = 0; k1 < 16; ++k1) D[pidx(256 * k0 + 16 * k1 + n0)] = cmul(v[k1], TW[(n0 * (k0 + 16 * k1)) & 4095]); }
    __syncthreads();
#pragma unroll
    for (int a = 0; a < 16; ++a) v[a] = D[pidx(16 * t8 + a)];
    dft16<false>(v);
}
__device__ __forceinline__ void fft_inv(LAS f32x2* D, const LAS f32x2* TW, int t8, f32x2 (&v)[16]) {
    dft16<true>(v);
    { const int kk = t8;
      const int kq = (kk >> 4) + 16 * (kk & 15);
#pragma unroll
      for (int n0 = 0; n0 < 16; ++n0) D[pidx(16 * t8 + n0)] = cmulc(v[n0], TW[(n0 * kq) & 4095]); }
    __syncthreads();
    { const int k0 = t8 >> 4, n0 = t8 & 15;
#pragma unroll
      for (int a = 0; a < 16; ++a) v[a] = D[pidx(256 * k0 + 16 * a + n0)];
      dft16<true>(v);
#pragma unroll
      for (int n1 = 0; n1 < 16; ++n1) D[pidx(256 * k0 + 16 * n1 + n0)] = cmulc(v[n1], TW[(16 * n1 * k0) & 4095]); }
    __syncthreads();
#pragma unroll
    for (int a = 0; a < 16; ++a) v[a] = D[pidx(256 * a + t8)];
    dft16<true>(v);
#pragma unroll
    for (int a = 0; a < 16; ++a) D[pidx(256 * a + t8)] = v[a];
    __syncthreads();
}
__device__ __forceinline__ void ph_hy_fft(const Ctx& C, const Params& P) {
    LAS f32x2* TW = (LAS f32x2*)(C.lds + FF_TW); LAS f32x2* TW2 = (LAS f32x2*)(C.lds + FF_TW2); LAS f32x2* DE = (LAS f32x2*)(C.lds + FF_DE); LAS f32x2* DO = (LAS f32x2*)(C.lds + FF_DO); LAS float* RED = (LAS float*)(C.lds + FF_RED);
    const float* HFT = (const float*)(P.ws + WS_HFT); const bf16* ZT = (const bf16*)(P.ws + AR_ZT); bf16* YT = (bf16*)(P.ws + AR_YT);
    const int br = C.tid >> 8, t8 = C.tid & 255; LAS f32x2* D = br ? DO : DE;
    for (int i = C.tid; i < 4096; i += 512) { float s, c; sincosf(6.283185307179586f * (float)i / 4096.0f, &s, &c); TW[i] = (f32x2){c, -s}; sincosf(6.283185307179586f * (float)i / 8192.0f, &s, &c); TW2[i] = (f32x2){c, -s}; }
    __syncthreads();
    for (int d = C.bid; d < 1024; d += C.G) {
        const float* hf = HFT + (size_t)d * 2 * 4096; const float* hb = hf + 4096;
        float ss = 0.f;
#pragma unroll
        for (int a = 0; a < 16; ++a) { const int n = 256 * a + t8; const float f = hf[n], g = hb[n == 0 ? 0 : 4096 - n]; ss += f * f + g * g;
            D[pidx(n)] = br == 0 ? (f32x2){f + g, 0.f} : (n == 0 ? (f32x2){f + g, 0.f} : (f32x2){(f - g) * TW2[n].x, (f - g) * TW2[n].y}); }
        ss = wave_sum(ss); if (C.lane == 0) RED[C.wave] = ss;
        __syncthreads();
        const float scale = 1.0f / sqrtf(RED[0] + RED[1] + RED[2] + RED[3] + EPS);
        f32x2 v[16];
        fft_fwd(D, TW, t8, v);
        f32x2* HSP = (f32x2*)(P.ws + AR_HSP) + (size_t)C.bid * 8192 + br * 4096 + t8;
#pragma unroll
        for (int a = 0; a < 16; ++a) HSP[a * 256] = v[a] * scale;
        const float bias = P.hy_bias[d];
        for (int bp = 0; bp < 4; ++bp) {
            const bf16* z0 = ZT + ((size_t)d * NB + 2 * bp) * SEQ; const bf16* z1 = z0 + SEQ;
            __syncthreads();
#pragma unroll
            for (int a = 0; a < 16; ++a) { const int n = 256 * a + t8; const f32x2 zc = (f32x2){bf2f(z0[n]), bf2f(z1[n])}; D[pidx(n)] = br == 0 ? zc : cmul(zc, TW2[n]); }
            __syncthreads();
            fft_fwd(D, TW, t8, v);
#pragma unroll
            for (int a = 0; a < 16; ++a) v[a] = cmul(v[a], HSP[a * 256]);
            fft_inv(D, TW, t8, v);
            bf16* y0 = YT + ((size_t)d * NB + 2 * bp) * SEQ; bf16* y1 = y0 + SEQ;
#pragma unroll
            for (int j = 0; j < 8; ++j) { const int n = C.tid + 512 * j; const f32x2 ye = DE[pidx(n)], yo = DO[pidx(n)]; const f32x2 y = (ye + cmulc(yo, TW2[n])) * (1.0f / 8192.0f);
                y0[n] = (bf16)f2bf(y.x + bias * bf2f(z0[n])); y1[n] = (bf16)f2bf(y.y + bias * bf2f(z1[n])); }
        }
        __syncthreads();
    }
}
__device__ __forceinline__ void ph_hy_gate(const Ctx& C, const Params& P) {
    const bf16* X0 = (const bf16*)(P.ws + AR_X0); const bf16* YT = (const bf16*)(P.ws + AR_YT); bf16* AO = (bf16*)(P.ws + WS_H);
    LAS bf16* TS = (LAS bf16*)(C.lds + RING_OFF);
    for (int item = C.bid; item < NB * 64 * 16; item += C.G) {
        const int dt = item & 15, bt = item >> 4, b = bt >> 6, t0 = (bt & 63) * 64, d0 = dt * 64;
        { const int dl = C.tid >> 3, tp = (C.tid & 7) * 8; const u32x4 w = *(const u32x4*)(YT + ((size_t)(d0 + dl) * NB + b) * SEQ + t0 + tp);
          TS[(tp + 0) * 72 + dl] = (bf16)(w.x & 0xffff); TS[(tp + 1) * 72 + dl] = (bf16)(w.x >> 16); TS[(tp + 2) * 72 + dl] = (bf16)(w.y & 0xffff); TS[(tp + 3) * 72 + dl] = (bf16)(w.y >> 16);
          TS[(tp + 4) * 72 + dl] = (bf16)(w.z & 0xffff); TS[(tp + 5) * 72 + dl] = (bf16)(w.z >> 16); TS[(tp + 6) * 72 + dl] = (bf16)(w.w & 0xffff); TS[(tp + 7) * 72 + dl] = (bf16)(w.w >> 16); }
        __syncthreads();
        { const int tl = C.tid >> 3, d8 = (C.tid & 7) * 8; const size_t o = ((size_t)b * SEQ + t0 + tl) * 1024 + d0 + d8; const u32x4 y = *(const LAS u32x4*)(TS + tl * 72 + d8), x = *(const u32x4*)(X0 + o);
          u32x4 w; w.x = pk2(bflo(x.x) * bflo(y.x), bfhi(x.x) * bfhi(y.x)); w.y = pk2(bflo(x.y) * bflo(y.y), bfhi(x.y) * bfhi(y.y)); w.z = pk2(bflo(x.z) * bflo(y.z), bfhi(x.z) * bfhi(y.z)); w.w = pk2(bflo(x.w) * bflo(y.w), bfhi(x.w) * bfhi(y.w));
          *(u32x4*)(AO + o) = w; }
        __syncthreads();
    }
}

struct EpiStoreBf16 {
    static constexpr bool PERM = true; bf16* O; int ldc;
    __device__ __forceinline__ void operator()(EPI_ARGS) const {
#pragma unroll
        for (int ai = 0; ai < 2; ++ai)
#pragma unroll
            for (int m = 0; m < 4; ++m) { const size_t row = (size_t)u.pm * 256 + ai * 128 + wr * 64 + m * 16 + fr;
#pragma unroll
                for (int bj = 0; bj < 2; ++bj) *(u32x4*)(O + row * ldc + u.pn * 256 + bj * 128 + wc * 32 + 8 * fq) = pack8(acc[ai][bj][m][0], acc[ai][bj][m][1]); }
    }
};

__global__ void __launch_bounds__(512, 2) fwd_kernel(Params P) {
    extern __shared__ __attribute__((aligned(16))) unsigned char lds_raw[];
    Ctx C; C.lds = (LAS unsigned char*)lds_raw; C.tid = threadIdx.x; C.lane = C.tid & 63; C.wave = __builtin_amdgcn_readfirstlane(C.tid >> 6); C.G = gridDim.x; C.bid = blockIdx.x;
    const int vcu = (C.G % 8 == 0) ? (C.bid % 8) * (C.G / 8) + C.bid / 8 : C.bid;
    for (int i = C.tid; i < LDS_CTL_BYTES / 4; i += 512) ((LAS unsigned*)C.lds)[i] = 0u;
    __syncthreads();
    unsigned char* ws = P.ws;
#if N_LAUNCH_MODE == 1
    XcdBarrier bar = xcd_barrier_post((unsigned*)(ws + WS_CTL) + CW_BAR, (volatile LAS unsigned*)(C.lds + 32));
#define SEAM(k) do { if (IN(k) && IN((k) + 1)) xcd_barrier(bar); } while (0)
#else
#define SEAM(k) do { } while (0)
#endif
    const int lo = P.ph_lo, hi = P.ph_hi;
#ifndef PH_MASK
#define PH_MASK 0xffffffffu
#endif
#define IN(k) (((PH_MASK >> (k)) & 1u) && lo <= (k) && (k) < hi)
    LAS unsigned char* ring = C.lds + RING_OFF;
    const float* mod = (const float*)(ws + WS_MOD);

    if (IN(0)) { ph_mod(C, P); __syncthreads(); ph_s5_tables(C, P); ph_conv_l0(C, P); } SEAM(0);
    if (IN(1)) { ph_norm(C, P, P.x, 0, 0, true); } SEAM(1);
    if (IN(2)) { SchedDense S{(const char*)(ws + WS_H), (const char*)(ws + WS_WIN), 2048u, 2048u, TA / 256, 4, C.G, vcu}; EpiInProj E{(bf16*)(ws + AR_PROJ), (bf16*)(ws + AR_U)};
        pg8::gemm_phase(ring, 1024, 2048u, 2048u, S, E); } SEAM(2);
    if (IN(3)) { ph_rownorm1(C, P);
        SchedBatched S{(const char*)(ws + AR_U), (const char*)(ws + WS_SOUT), 1536u, 1024u, (size_t)S5ROWS * 1536, (size_t)256 * 1024, S5G, 5, 1, C.G, vcu}; EpiF32Batched E{(float*)(ws + AR_SRAW), S5ROWS, 256};
        pg8::gemm_phase(ring, 512, 1536u, 1024u, S, E); } SEAM(3);
    if (IN(4)) { SchedUp S{(const char*)(ws + AR_QN), (const char*)(ws + WS_WUQ), (const char*)(ws + AR_CKV), (const char*)(ws + WS_WUKV), C.G, vcu}; EpiUp E{(bf16*)(ws + AR_QRAW), (bf16*)(ws + AR_KVRAW)};
        pg8::gemm_phase(ring, 256, 512u, 512u, S, E); ph_s5_scan(C, P); } SEAM(4);
    if (IN(5)) { ph_qkfinal(C, P);
        SchedBatched S{(const char*)(ws + AR_U), (const char*)(ws + WS_WG), 1536u, 1536u, (size_t)S5ROWS * 1536, (size_t)512 * 1536, S5G, 4, 2, C.G, vcu}; EpiS5C E{(bf16*)(ws + AR_Z)};
        pg8::gemm_phase(ring, 768, 1536u, 1536u, S, E); } SEAM(5);
    if (IN(6)) { ph_attention(C, P, vcu);
        SchedDense S{(const char*)(ws + AR_Z), (const char*)(ws + WS_WGLU), 1024u, 1024u, T / 256, 2, C.G, vcu}; EpiGlu E{(const bf16*)(ws + AR_Z), P.glu_b, (bf16*)(ws + AR_CAT)};
        pg8::gemm_phase(ring, 512, 1024u, 1024u, S, E); } SEAM(6);
    if (IN(7)) { SchedDense S{(const char*)(ws + AR_CAT), (const char*)(ws + WS_WOUT), 2048u, 2048u, T / 256, 4, C.G, vcu}; EpiResid E{P.x, P.out, mod + 2048};
        pg8::gemm_phase(ring, 1024, 2048u, 2048u, S, E); } SEAM(7);
#define MOE_LAYER(li, pb) do { \
        if (IN(pb)) { ph_conv_moe(C, P, li); __syncthreads(); ph_router(C, P, P.out, li); } SEAM(pb); \
        if (IN(pb + 1)) { const int nblk = moe_tables(C, P, li); \
            SchedMoE1 S{(const char*)(ws + WS_H), (const char*)(ws + AR_W1), (const int*)(ws + WS_TOK), (const LAS int*)(C.lds + LC_BLKSTART), (const LAS unsigned short*)(C.lds + LC_BLK2HE), nblk, C.G, vcu}; \
            EpiMoE1 E{(bf16*)(ws + AR_HID), (bf16*)(ws + AR_HIDS)}; \
            pg8::gemm_phase(ring, 1024, 2048u, 2048u, S, E); } SEAM(pb + 1); \
        MOE_HALF(li, pb, 0); MOE_HALF(li, pb, 1); } while (0)
#define MOE_HALF(li, pb, hf) do { \
            if (IN(pb + 2 + 2 * hf)) { (void)moe_tables(C, P, li); const LAS int* bs = (const LAS int*)(C.lds + LC_BLKSTART); \
                SchedMoE2 S{(const char*)(ws + AR_HID), (const char*)(ws + AR_W2), (const LAS unsigned short*)(C.lds + LC_BLK2HE), bs[hf * 64], bs[hf * 64 + 64], C.G, vcu}; \
                EpiMoE2 E{(bf16*)(ws + AR_YBUF), (const int*)(ws + WS_TOK), bs, (const LAS int*)(C.lds + LC_CNT), hf}; \
                pg8::gemm_phase(ring, 256, 512u, 512u, S, E); } SEAM(pb + 2 + 2 * hf); \
            if (IN(pb + 3 + 2 * hf)) { SchedDense S{(const char*)(ws + AR_HIDS) + (size_t)hf * HALF_T * 512, (const char*)(ws + AR_W2) + (size_t)64 * 1024 * 512, 512u, 512u, HALF_T / 256, 4, C.G, vcu}; \
                EpiCombine E{(const bf16*)(ws + AR_YBUF), (const float*)(ws + WS_TOPW), P.out, mod + (size_t)li * 8 * 6144 + 5120, hf}; \
                pg8::gemm_phase(ring, 256, 512u, 512u, S, E); } SEAM(pb + 3 + 2 * hf); } while (0)
    MOE_LAYER(0, 8);
    if (IN(14)) { ph_conv_l1(C, P); __syncthreads(); ph_hy_filter(C, P); ph_norm(C, P, P.out, 1, 0, false); } SEAM(14);
    if (IN(15)) { SchedDense S{(const char*)(ws + WS_H), (const char*)(ws + WS_WHIN), 2048u, 2048u, T / 256, 12, C.G, vcu}; EpiStoreBf16 E{(bf16*)(ws + AR_P), 3072};
        pg8::gemm_phase(ring, 1024, 2048u, 2048u, S, E); } SEAM(15);
    if (IN(16)) { ph_hy_prep(C, P); } SEAM(16);
    if (IN(17)) { ph_hy_fft(C, P); } SEAM(17);
    if (IN(18)) { ph_hy_gate(C, P); } SEAM(18);
    if (IN(19)) { SchedDense S{(const char*)(ws + WS_H), (const char*)(ws + WS_WHOUT), 2048u, 2048u, T / 256, 4, C.G, vcu}; EpiResid E{P.out, P.out, mod + (size_t)8 * 6144 + 2048};
        pg8::gemm_phase(ring, 1024, 2048u, 2048u, S, E); } SEAM(19);
    MOE_LAYER(1, 20);
#undef IN
#undef SEAM
}

extern "C" void kernel_launch(void* const* d_in, const int* in_sizes, int n_in, void* d_out, int out_size, void* d_ws, size_t ws_size, hipStream_t stream) {
    static int grid = 0;
    if (grid == 0) {
        if (n_in != 43 || out_size != T * DM || ws_size < WS_END) { fprintf(stderr, "kernel_launch: unexpected shapes (n_in %d, out %d, ws %zu, need %zu)\n", n_in, out_size, ws_size, (size_t)WS_END); grid = -1; return; }
        int dev = 0, cus = 0, per_cu = 0;
        if (hipGetDevice(&dev) != hipSuccess || hipDeviceGetAttribute(&cus, hipDeviceAttributeMultiprocessorCount, dev) != hipSuccess) { grid = -1; return; }
        if (hipFuncSetAttribute((const void*)fwd_kernel, hipFuncAttributeMaxDynamicSharedMemorySize, LDS_BYTES) != hipSuccess) { fprintf(stderr, "kernel_launch: hipFuncSetAttribute failed\n"); grid = -1; return; }
        if (hipOccupancyMaxActiveBlocksPerMultiprocessor(&per_cu, (const void*)fwd_kernel, 512, LDS_BYTES) != hipSuccess || per_cu < 1) fprintf(stderr, "kernel_launch: occupancy query says %d\n", per_cu);
        (void)hipGetLastError();
        grid = cus;
    }
    if (grid < 0) return;
    (void)hipMemsetAsync((char*)d_ws + WS_CTL, 0, CTL_ZERO_BYTES, stream);
    Params p{};
    const float** pp = (const float**)&p;
    for (int i = 0; i < 43; ++i) pp[i] = (const float*)d_in[i];
    p.out = (float*)d_out; p.ws = (unsigned char*)d_ws;
#if N_LAUNCH_MODE == 1
    p.ph_lo = 0; p.ph_hi = NPHASE;
    hipLaunchKernelGGL(fwd_kernel, dim3(grid), dim3(512), LDS_BYTES, stream, p);
#else
    static const int order[NPHASE] = {0, 1, 2, 3, 4, 5, 6, 7, 8, 9, 10, 11, 12, 13, 14, 15, 16, 17, 18, 19, 20, 21, 22, 23, 24, 25};
    for (int k = 0; k < NPHASE; ++k) { p.ph_lo = order[k]; p.ph_hi = order[k] + 1; hipLaunchKernelGGL(fwd_kernel, dim3(grid), dim3(512), LDS_BYTES, stream, p); }
#endif
}
```

```cpp
#include <hip/hip_runtime.h>
#include <cstdio>
#include <cstdint>
#include <cmath>

#define TS_FROM -1
#define TS_TO -1
#ifndef N_LAUNCH_MODE
#define N_LAUNCH_MODE 1
#endif

#define GAS __attribute__((address_space(1)))
#define LAS __attribute__((address_space(3)))
typedef unsigned short bf16;
typedef short bf16x8 __attribute__((ext_vector_type(8)));
typedef short s16x4 __attribute__((ext_vector_type(4)));
typedef float f32x4 __attribute__((ext_vector_type(4)));
typedef float f32x2 __attribute__((ext_vector_type(2)));
typedef float f32x16 __attribute__((ext_vector_type(16)));
typedef unsigned u32x4 __attribute__((ext_vector_type(4)));
typedef unsigned u32x2 __attribute__((ext_vector_type(2)));
typedef GAS unsigned gu32;
#define RLX_AGENT __ATOMIC_RELAXED, __HIP_MEMORY_SCOPE_AGENT
#define LDS_WAIT() asm volatile("s_waitcnt lgkmcnt(0)" ::: "memory")
#define VM_WAIT() asm volatile("s_waitcnt vmcnt(0)" ::: "memory")
#define LBAR() do { asm volatile("s_waitcnt lgkmcnt(0)" ::: "memory"); __builtin_amdgcn_s_barrier(); asm volatile("" ::: "memory"); } while (0)

constexpr int DM = 1024, NB = 8, SEQ = 4096, CTXL = 256, T = NB * SEQ  , TC = NB * CTXL  , TA = T + TC  ;
constexpr int NHEAD = 8, QKH = 96, VH = 64, QLORA = 256, KVLORA = 128, QKROPE = 32, QKNOPE = 64;
constexpr int S5W = 512, S5G = 32, S5H = 16, S5P = 64, S5TC = 32  , S5NCH = SEQ / S5TC  , S5NCC = CTXL / S5TC  ;
constexpr int S5ROWS = 1280  , S5K = 768  ;
constexpr int EVEN_IN = 928, UOFF = 416;
constexpr int NEXP = 64, TOPK = 6, EFF = 256;
constexpr float EPS = 1e-6f;
constexpr int HALF_T = T / 2;
constexpr int MOE_CAP = HALF_T;
constexpr int MAXBLK = 2 * ((HALF_T * TOPK) / 256 + NEXP);

__device__ __forceinline__ unsigned f2bf(float f) { unsigned u = __builtin_bit_cast(unsigned, f); return (u + 0x7fffu + ((u >> 16) & 1u)) >> 16; }
__device__ __forceinline__ unsigned pk2(float lo, float hi) { return f2bf(lo) | (f2bf(hi) << 16); }
__device__ __forceinline__ float bf2f(unsigned short b) { return __builtin_bit_cast(float, ((unsigned)b) << 16); }
__device__ __forceinline__ float bflo(unsigned w) { return __builtin_bit_cast(float, w << 16); }
__device__ __forceinline__ float bfhi(unsigned w) { return __builtin_bit_cast(float, w & 0xffff0000u); }
__device__ __forceinline__ float wave_sum(float v) {
#pragma unroll
    for (int o = 1; o < 64; o <<= 1) v += __shfl_xor(v, o);
    return v;
}
__device__ __forceinline__ float siluf(float x) { return x / (1.0f + __expf(-x)); }
__device__ __forceinline__ float sigmf(float x) { return 1.0f / (1.0f + __expf(-x)); }
__device__ __forceinline__ float gelu_tanh(float x) { const float u = 0.7978845608028654f * (x + 0.044715f * x * x * x); const float e = __expf(2.0f * u); return x * (1.0f - 1.0f / (e + 1.0f)); }

namespace pg8 {
constexpr int BM = 256, BK = 64, HALF = 128, HTB = HALF * BK * 2  , STAGE_BYTES = 8 * HTB;
__host__ __device__ __forceinline__ int lds_byte(int r, int c) { const int st = (r >> 4) * 2 + (c >> 5), rr = r & 15, cc = c & 31, ob = rr * 64 + cc * 2; return st * 1024 + (ob ^ (((ob >> 9) & 1) << 5)); }
__host__ __device__ __forceinline__ void stage_rc(int b, int& R, int& C) { const int st = b / 1024, sb = b % 1024, swz = sb ^ (((sb >> 9) & 1) << 5); R = (st >> 1) * 16 + swz / 64; C = (st & 1) * 32 + (swz % 64) / 2; }
__host__ __device__ __forceinline__ int perm32(int rho) { const int n = rho >> 4, i = rho & 15; return 8 * (i >> 2) + 4 * n + (i & 3); }

struct Unit { const char* A; const char* B; const int* rows; int pm, pn, z; };

__device__ __forceinline__ unsigned cvt_pk_bf16(float lo, float hi) { unsigned r; asm volatile("v_cvt_pk_bf16_f32 %0, %1, %2" : "=v"(r) : "v"(lo), "v"(hi)); return r; }

template <bool ALIGN_EPI = true, class Epi, class Sched>
__device__ __forceinline__ void gemm_phase(LAS unsigned char* lds, const int K, const unsigned lda, const unsigned ldb, const Sched& S, const Epi& E) {
    const int tid = threadIdx.x, wid = __builtin_amdgcn_readfirstlane(tid >> 6), lane = tid & 63, wr = wid >> 2, wc = wid & 3, fr = lane & 15, fq = lane >> 4;
    const int nt = K / BK;
    int Ri[2], Ci[2]; unsigned voffB[2][2];
#pragma unroll
    for (int i = 0; i < 2; ++i) { int R, C; stage_rc(tid * 16 + i * 8192, R, C); Ri[i] = R; Ci[i] = C;
        const int Rb0 = Epi::PERM ? (64 * (R >> 5) + perm32(R & 31)) : R, Rb1 = Epi::PERM ? (Rb0 + 32) : (R + HALF);
        voffB[0][i] = (unsigned)Rb0 * ldb + (unsigned)C * 2u; voffB[1][i] = (unsigned)Rb1 * ldb + (unsigned)C * 2u; }
    const size_t kstep = (size_t)(BK * 2);
    const unsigned ldsw = (unsigned)wid * 1024u;
    const int aoff = lds_byte(wr * 64 + fr, fq * 8), boff = lds_byte(wc * 32 + fr, fq * 8);
#define PG8_SA(b, h) (((b) * 2 + (h)) * HTB)
#define PG8_SB(b, h) ((4 + (b) * 2 + (h)) * HTB)
#define PG8_STAGE(bufoff, gbase, voff) do { _Pragma("unroll") for (int _i = 0; _i < 2; ++_i) \
        __builtin_amdgcn_global_load_lds((const unsigned*)((const char*)(gbase) + (voff)[_i]), (LAS unsigned*)(lds + (bufoff) + ldsw + _i * 8192), 16, 0, 0); } while (0)
#define PG8_LDA(dst, b, h) do { _Pragma("unroll") for (int m = 0; m < 4; ++m) _Pragma("unroll") for (int k = 0; k < 2; ++k) dst[m][k] = *(const LAS bf16x8*)(lds + PG8_SA(b, h) + aoff + m * 2048 + k * 1024); } while (0)
#define PG8_LDB(dst, b, h) do { _Pragma("unroll") for (int n = 0; n < 2; ++n) _Pragma("unroll") for (int k = 0; k < 2; ++k) dst[n][k] = *(const LAS bf16x8*)(lds + PG8_SB(b, h) + boff + n * 2048 + k * 1024); } while (0)
#define PG8_MMA(ai, bj, At, Bt) do { __builtin_amdgcn_s_setprio(1); _Pragma("unroll") for (int m = 0; m < 4; ++m) _Pragma("unroll") for (int n = 0; n < 2; ++n) _Pragma("unroll") for (int k = 0; k < 2; ++k) \
        acc[ai][bj][m][n] = __builtin_amdgcn_mfma_f32_16x16x32_bf16(Bt[n][k], At[m][k], acc[ai][bj][m][n], 0, 0, 0); __builtin_amdgcn_s_setprio(0); } while (0)
#define PG8_WAIT_V(n) asm volatile("s_waitcnt vmcnt(" #n ")" ::: "memory")
#define PG8_WAIT_L(n) asm volatile("s_waitcnt lgkmcnt(" #n ")" ::: "memory")
#define PG8_BAR __builtin_amdgcn_s_barrier()
#define PG8_SCHED __builtin_amdgcn_sched_barrier(0)
#define PG8_AOFF(dst, u) do { if ((u).rows) { _Pragma("unroll") for (int _h = 0; _h < 2; ++_h) _Pragma("unroll") for (int _i = 0; _i < 2; ++_i) \
            { unsigned _t = (unsigned)(u).rows[_h * HALF + Ri[_i]] >> 3; _t = _t < (unsigned)(T - 1) ? _t : (unsigned)(T - 1); dst[_h][_i] = _t * lda + (unsigned)Ci[_i] * 2u; } } \
        else { _Pragma("unroll") for (int _h = 0; _h < 2; ++_h) _Pragma("unroll") for (int _i = 0; _i < 2; ++_i) dst[_h][_i] = (unsigned)(_h * HALF + Ri[_i]) * lda + (unsigned)Ci[_i] * 2u; } } while (0)
    Unit cur, nxt; int ui = 0;
    if (!S.next(0, cur)) return;
    f32x4 acc[2][2][4][2];
#pragma unroll
    for (int a = 0; a < 2; ++a)
#pragma unroll
        for (int b = 0; b < 2; ++b)
#pragma unroll
            for (int m = 0; m < 4; ++m)
#pragma unroll
                for (int n = 0; n < 2; ++n) acc[a][b][m][n] = (f32x4){0.f, 0.f, 0.f, 0.f};
    bf16x8 At[4][2], B0[2][2], B1[2][2];
    unsigned vA[2][2], vN[2][2];
    PG8_AOFF(vA, cur);
    const char* cA = cur.A; const char* cB = cur.B;
    PG8_STAGE(PG8_SB(0, 0), cB, voffB[0]); PG8_STAGE(PG8_SB(0, 1), cB, voffB[1]); PG8_STAGE(PG8_SA(0, 0), cA, vA[0]); PG8_STAGE(PG8_SA(0, 1), cA, vA[1]);
    if (wr == 1) PG8_BAR;
    PG8_WAIT_V(2); PG8_BAR;
    PG8_STAGE(PG8_SB(1, 0), cB + kstep, voffB[0]); PG8_STAGE(PG8_SA(1, 0), cA + kstep, vA[0]); PG8_STAGE(PG8_SB(1, 1), cB + kstep, voffB[1]);
    PG8_WAIT_V(6); PG8_BAR;
    for (;;) {
        const bool has_next = S.next(ui + 1, nxt);
        if (has_next) { PG8_AOFF(vN, nxt); } else {
#pragma unroll
            for (int _h = 0; _h < 2; ++_h)
#pragma unroll
                for (int _i = 0; _i < 2; ++_i) vN[_h][_i] = vA[_h][_i]; }
        const char* nA = has_next ? nxt.A : cA; const char* nB = has_next ? nxt.B : cB;
#pragma nounroll
        for (int t = 0; t < nt; t += 2) {
            const bool last = (t == nt - 2);
            const char* a1 = cA + (size_t)(t + 1) * kstep;
            const char* a2 = last ? nA : cA + (size_t)(t + 2) * kstep; const char* b2 = last ? nB : cB + (size_t)(t + 2) * kstep;
            const char* a3 = a2 + kstep; const char* b3 = b2 + kstep;
            unsigned v2[2][2];
#pragma unroll
            for (int _h = 0; _h < 2; ++_h)
#pragma unroll
                for (int _i = 0; _i < 2; ++_i) v2[_h][_i] = last ? vN[_h][_i] : vA[_h][_i];
            PG8_LDB(B0, 0, 0); PG8_LDB(B1, 0, 1); PG8_SCHED; PG8_LDA(At, 0, 0); PG8_STAGE(PG8_SA(1, 1), a1, vA[1]);
            PG8_WAIT_V(8); PG8_WAIT_L(0); PG8_BAR; PG8_MMA(0, 0, At, B0); PG8_MMA(0, 1, At, B1); PG8_BAR; PG8_SCHED;
            PG8_LDA(At, 0, 1); PG8_STAGE(PG8_SB(0, 0), b2, voffB[0]); PG8_STAGE(PG8_SB(0, 1), b2, voffB[1]); PG8_STAGE(PG8_SA(0, 0), a2, v2[0]);
            PG8_WAIT_V(8); PG8_WAIT_L(0); PG8_BAR; PG8_MMA(1, 0, At, B0); PG8_MMA(1, 1, At, B1); PG8_BAR; PG8_SCHED;
            PG8_LDB(B0, 1, 0); PG8_LDB(B1, 1, 1); PG8_SCHED; PG8_LDA(At, 1, 0); PG8_STAGE(PG8_SA(0, 1), a2, v2[1]);
            PG8_WAIT_V(8); PG8_WAIT_L(0); PG8_BAR; PG8_MMA(0, 0, At, B0); PG8_MMA(0, 1, At, B1); PG8_BAR; PG8_SCHED;
            PG8_LDA(At, 1, 1); PG8_STAGE(PG8_SB(1, 0), b3, voffB[0]); PG8_STAGE(PG8_SB(1, 1), b3, voffB[1]); PG8_STAGE(PG8_SA(1, 0), a3, v2[0]);
            PG8_WAIT_V(8); PG8_WAIT_L(0); PG8_BAR; PG8_MMA(1, 0, At, B0); PG8_MMA(1, 1, At, B1); PG8_BAR; PG8_SCHED;
        }
        if constexpr (ALIGN_EPI) { if (wr == 0) PG8_BAR; }
        E(acc, cur, wr, wc, fr, fq);
        if (!has_next) break;
#pragma unroll
        for (int a = 0; a < 2; ++a)
#pragma unroll
            for (int b = 0; b < 2; ++b)
#pragma unroll
                for (int m = 0; m < 4; ++m)
#pragma unroll
                    for (int n = 0; n < 2; ++n) acc[a][b][m][n] = (f32x4){0.f, 0.f, 0.f, 0.f};
        cur = nxt; cA = nA; cB = nB; ++ui;
#pragma unroll
        for (int _h = 0; _h < 2; ++_h)
#pragma unroll
            for (int _i = 0; _i < 2; ++_i) vA[_h][_i] = vN[_h][_i];
        if constexpr (ALIGN_EPI) { if (wr == 1) PG8_BAR; }
    }
    PG8_WAIT_V(0);
    if constexpr (!ALIGN_EPI) { if (wr == 0) PG8_BAR; }
    PG8_BAR;
#undef PG8_SA
#undef PG8_SB
#undef PG8_STAGE
#undef PG8_LDA
#undef PG8_LDB
#undef PG8_MMA
#undef PG8_WAIT_V
#undef PG8_WAIT_L
#undef PG8_BAR
#undef PG8_SCHED
#undef PG8_AOFF
}
}

constexpr size_t MiB = 1u << 20;
constexpr size_t WS_CTL = 0, CTL_ZERO_BYTES = 1 * MiB;
constexpr size_t WS_MOD = 1 * MiB;
constexpr size_t WS_MODCTX = WS_MOD + 512 * 1024;
constexpr size_t WS_TOPW = 2 * MiB;
constexpr size_t WS_LAMT = 3 * MiB;
constexpr size_t WS_TOK = 4 * MiB;
constexpr size_t WS_H = 16 * MiB;
constexpr size_t WS_WS = 84 * MiB;
constexpr size_t WS_AR = 128 * MiB;
constexpr size_t WS_WIN = WS_WS, WS_WUQ = WS_WS + 2 * MiB, WS_WUKV = WS_WS + 2 * MiB + 512 * 1024, WS_WGLU = WS_WS + 3 * MiB, WS_WOUT = WS_WS + 4 * MiB;
constexpr size_t WS_SOUT = WS_WS + 6 * MiB;
constexpr size_t WS_WG = WS_WS + 14 * MiB;
constexpr size_t WS_WHIN = WS_WS, WS_WHOUT = WS_WS + 6 * MiB, WS_HFT = WS_WS + 8 * MiB;
constexpr size_t AR_PROJ = WS_AR, AR_U = WS_AR + 34 * MiB, AR_QN = WS_AR + 94 * MiB, AR_CKV = WS_AR + 110 * MiB, AR_QRAW = WS_AR + 127 * MiB,
                 AR_KVRAW = WS_AR + 175 * MiB, AR_KF = WS_AR + 243 * MiB, AR_SRAW = WS_AR + 294 * MiB, AR_Z = WS_AR + 334 * MiB, AR_CAT = WS_AR + 366 * MiB;
constexpr size_t AR_W1 = WS_AR, AR_W2 = WS_AR + 65 * MiB, AR_HID = WS_AR + 98 * MiB, AR_HIDS = WS_AR + 210 * MiB, AR_YBUF = WS_AR + 226 * MiB;
constexpr size_t AR_P = WS_AR, AR_X0 = WS_AR + 192 * MiB, AR_ZT = WS_AR + 256 * MiB, AR_YT = WS_AR + 320 * MiB;
constexpr size_t AR_HSP = WS_AR + 384 * MiB;
constexpr size_t WS_END = WS_AR + 430 * MiB;
static_assert(AR_U + (size_t)S5G * S5ROWS * S5K * 2 <= AR_QN && AR_QRAW + (size_t)T * 768 * 2 <= AR_KVRAW && AR_KVRAW + (size_t)TA * 1024 * 2 <= AR_KF && AR_KF + (size_t)TA * 768 * 2 <= AR_SRAW &&
              AR_SRAW + (size_t)S5G * S5ROWS * 256 * 4 <= AR_Z && AR_CAT + (size_t)T * 1024 * 2 <= WS_END && AR_CKV + (size_t)TA * 256 * 2 <= AR_QRAW && AR_PROJ + (size_t)TA * 512 * 2 <= AR_U, "arena L0");
static_assert(AR_W2 + (size_t)65 * 1024 * 256 * 2 <= AR_HID && AR_HID + (size_t)MAXBLK * 256 * 256 * 2 <= AR_HIDS && AR_HIDS + (size_t)T * 256 * 2 <= AR_YBUF && AR_YBUF + (size_t)HALF_T * 6 * 1024 * 2 <= WS_END, "arena MoE");
static_assert(WS_END <= 600 * MiB, "workspace budget");
constexpr int CW_TMO = 0, CW_CODE = 1;
constexpr int CW_BAR = 4096;
constexpr int CW_CNT = 32768;
constexpr int LDS_CTL_BYTES = 4096, RING_OFF = LDS_CTL_BYTES, LDS_BYTES = 160 * 1024;
constexpr int NPHASE = 26;

struct Params {
    const float *x, *c, *ctx, *c_ctx, *ada_w, *ada_b, *ev_w_in, *q_norm, *w_uq, *kv_norm, *w_ukv, *q_qk, *k_qk,
        *lam_re, *lam_im, *log_step, *b_re, *b_im, *c_re, *c_im, *s5_d, *glu_w, *glu_b, *ev_w_out,
        *hy_w_in, *hy_conv_w, *hy_conv_b, *f_w1, *f_b1, *f_w2, *f_b2, *f_w3, *f_freq, *hy_bias, *hy_w_out,
        *router_w, *router_b, *w_gate, *w_up, *w_down, *sh_gate, *sh_up, *sh_down;
    float* out; unsigned char* ws; int ph_lo, ph_hi;
};

#define XB_TMO      128
#define XB_XCNT(j)  (256  + 64 * (j))
#define XB_XSUB(j)  (1280 + 64 * (j))
#define XB_XGEN(j)  (2304 + 64 * (j))
#define XB_TOP      3328
#define XB_TOPGEN   3392
#define XCD_BAR_WORDS 3456
#define XB_SPIN_CAP (1u << 18)

__device__ __forceinline__ unsigned xb_ld(unsigned* p)              { return __hip_atomic_load(p, __ATOMIC_RELAXED, __HIP_MEMORY_SCOPE_AGENT); }
__device__ __forceinline__ unsigned xb_add(unsigned* p, unsigned v) { return __hip_atomic_fetch_add(p, v, __ATOMIC_RELAXED, __HIP_MEMORY_SCOPE_AGENT); }
__device__ __forceinline__ unsigned xb_xcc_id() { return (unsigned)__builtin_amdgcn_s_getreg((3 << 11) | 20) & 0xFu; }
#define XB_SPIN(cond, bar) do { unsigned _sp = 0; while (cond) { __builtin_amdgcn_s_sleep(1); \
    if ((++_sp & 255u) == 0u) { if (xb_ld(&(bar)[XB_TMO])) break; if (_sp > XB_SPIN_CAP) { atomicAdd(&(bar)[XB_TMO], 1u); break; } } } } while (0)

struct XcdBarrier {
    unsigned* bar; unsigned x;
    volatile LAS unsigned* st;
};

__device__ __forceinline__ XcdBarrier xcd_barrier_post(unsigned* bar, volatile LAS unsigned* st) {
    XcdBarrier b; b.bar = bar; b.x = xb_xcc_id(); b.st = st;
    if (threadIdx.x == 0) (void)xb_add(&bar[XB_XCNT(b.x)], 1u);
    return b;
}
__device__ __forceinline__ void xcd_barrier_complete(unsigned* bar, unsigned x, unsigned& nloc, unsigned& nx) {
    const unsigned G = gridDim.x * gridDim.y * gridDim.z;
    unsigned sum, cnt, mine, sp = 0u;
    for (;;) {
        sum = 0u; cnt = 0u; mine = 0u;
#pragma unroll
        for (unsigned j = 0; j < 16; ++j) { const unsigned c = xb_ld(&bar[XB_XCNT(j)]); sum += c; cnt += (c > 0u) ? 1u : 0u; mine = (j == x) ? c : mine; }
        if (sum == G) break;
        __builtin_amdgcn_s_sleep(1);
        if ((++sp & 255u) == 0u) { if (xb_ld(&bar[XB_TMO])) break; if (sp > XB_SPIN_CAP) { atomicAdd(&bar[XB_TMO], 1u); break; } }
    }
    nloc = mine > 0u ? mine : 1u; nx = cnt > 0u ? cnt : 1u;
}

__device__ __forceinline__ void xcd_barrier(const XcdBarrier& b) {
    asm volatile("s_waitcnt vmcnt(0)" ::: "memory");
    __syncthreads();
    if (threadIdx.x == 0) {
        unsigned* bar = b.bar;
        __builtin_amdgcn_s_waitcnt(0);
        unsigned nloc = b.st[0], nx = b.st[1];
        if (nloc == 0u) { xcd_barrier_complete(bar, b.x, nloc, nx); b.st[0] = nloc; b.st[1] = nx; }
        const unsigned old = xb_add(&bar[XB_XSUB(b.x)], 1u);
        const unsigned gen = old / nloc;
        if (old + 1u == (gen + 1u) * nloc) {
            __builtin_amdgcn_fence(__ATOMIC_RELEASE, "agent");
            asm volatile("s_waitcnt vmcnt(0)" ::: "memory");
            const unsigned og = xb_add(&bar[XB_TOP], 1u);
            const unsigned tg = og / nx;
            if (og + 1u == (tg + 1u) * nx) xb_add(&bar[XB_TOPGEN], 1u);
            else XB_SPIN(xb_ld(&bar[XB_TOPGEN]) == tg, bar);
            __builtin_amdgcn_fence(__ATOMIC_ACQUIRE, "agent");
            xb_add(&bar[XB_XGEN(b.x)], 1u);
            asm volatile("s_waitcnt vmcnt(0)" ::: "memory");
        } else {
            XB_SPIN(xb_ld(&bar[XB_XGEN(b.x)]) == gen, bar);
            __builtin_amdgcn_fence(__ATOMIC_ACQUIRE, "agent");
            asm volatile("s_waitcnt vmcnt(0)" ::: "memory");
        }
    }
    __syncthreads();
}

struct Ctx { LAS unsigned char* lds; int tid, lane, wave, G, bid; mutable unsigned long long tacc, tbeg; };
#define TS_ACC -1
#define TACC_B(C, id) do { if (TS_ACC == (id)) (C).tbeg = wall_clock64(); } while (0)
#define TACC_E(C, id) do { if (TS_ACC == (id)) (C).tacc += wall_clock64() - (C).tbeg; } while (0)

__device__ __forceinline__ void ph_mod(const Ctx& C, const Params& P) {
    if (C.bid >= 192) return;
    LAS float* sc = (LAS float*)(C.lds + RING_OFF);
    LAS float* red = sc + 9 * 1024;
    float* mod = (float*)(P.ws + WS_MOD); float* modctx = (float*)(P.ws + WS_MODCTX);
    for (int i = C.tid; i < 9 * 1024; i += 512) { const float v = (i < 8192) ? P.c[i] : P.c_ctx[i - 8192]; sc[i] = siluf(v); }
    __syncthreads();
    for (int item = C.bid; item < 192; item += C.G) {
        const int li = item / 96, j0 = (item % 96) * 64, c4 = C.tid & 15, kp = C.tid >> 4;
        f32x4 a[9];
#pragma unroll
        for (int r = 0; r < 9; ++r) a[r] = (f32x4){0.f, 0.f, 0.f, 0.f};
        const float* w = P.ada_w + (size_t)li * 1024 * 6144 + j0 + 4 * c4;
#pragma unroll 8
        for (int k = kp * 32; k < kp * 32 + 32; ++k) { const f32x4 wv = *(const f32x4*)(w + (size_t)k * 6144);
#pragma unroll
            for (int r = 0; r < 9; ++r) a[r] += wv * sc[r * 1024 + k]; }
#pragma unroll
        for (int r = 0; r < 9; ++r) *(LAS f32x4*)(red + (kp * 9 + r) * 64 + 4 * c4) = a[r];
        __syncthreads();
        for (int o = C.tid; o < 9 * 64; o += 512) { const int r = o >> 6, cc = o & 63; float s = P.ada_b[li * 6144 + j0 + cc];
#pragma unroll 8
            for (int q = 0; q < 32; ++q) s += red[(q * 9 + r) * 64 + cc];
            if (r < 8) mod[(size_t)(li * 8 + r) * 6144 + j0 + cc] = s; else if (li == 0 && j0 + cc < 2048) modctx[j0 + cc] = s; }
        __syncthreads();
    }
}

__device__ __forceinline__ void tr_item(const float* W, int ldw, bf16* WT, int ldt, int k0, int n0, int drow0, const float* gk, LAS float* scr, int lane) {
    f32x4 v[8]; const int c4 = (lane & 7) * 4;
#pragma unroll
    for (int j = 0; j < 8; ++j) v[j] = *(const f32x4*)(W + (size_t)(k0 + 8 * j + (lane >> 3)) * ldw + n0 + c4);
#pragma unroll
    for (int j = 0; j < 8; ++j) { const int kk = 8 * j + (lane >> 3); const float g = gk ? gk[k0 + kk] : 1.0f; LAS float* d = scr + kk * 33 + c4; d[0] = v[j].x * g; d[1] = v[j].y * g; d[2] = v[j].z * g; d[3] = v[j].w * g; }
    LDS_WAIT(); asm volatile("" ::: "memory");
    const int c = lane & 7;
#pragma unroll
    for (int j = 0; j < 4; ++j) { const int n = (lane >> 3) + 8 * j; const LAS float* s = scr + (8 * c) * 33 + n;
        u32x4 o; o.x = pk2(s[0 * 33], s[1 * 33]); o.y = pk2(s[2 * 33], s[3 * 33]); o.z = pk2(s[4 * 33], s[5 * 33]); o.w = pk2(s[6 * 33], s[7 * 33]);
        *(u32x4*)(WT + (size_t)(drow0 + n) * ldt + k0 + 8 * c) = o; }
    LDS_WAIT(); asm volatile("" ::: "memory");
}
__device__ __forceinline__ void tr_matrix(const Ctx& C, const float* W, int K, int N, int ldw, bf16* WT, int ldt, int row_off, const float* gk, int gw, int NGW) {
    LAS float* scr = (LAS float*)(C.lds + RING_OFF + C.wave * 8448);
    const int nblk = N / 32, nit = (K / 64) * nblk;
    for (int it = gw; it < nit; it += NGW) { const int kb = it / nblk, nb = it % nblk; tr_item(W, ldw, WT, ldt, 64 * kb, 32 * nb, row_off + 32 * nb, gk, scr, C.lane); }
}
__device__ __forceinline__ void zero_bf16(bf16* p, size_t n, int gt, int NGT) { for (size_t i = (size_t)gt * 8; i < n; i += (size_t)NGT * 8) *(u32x4*)(p + i) = (u32x4){0u, 0u, 0u, 0u}; }

__device__ __forceinline__ void ph_conv_l0(const Ctx& C, const Params& P) {
    const int gw = C.bid * 8 + C.wave, NGW = C.G * 8, gt = C.bid * 512 + C.tid, NGT = C.G * 512;
    unsigned char* ws = P.ws;
    tr_matrix(C, P.ev_w_in, 1024, EVEN_IN, EVEN_IN, (bf16*)(ws + WS_WIN), 1024, 0, nullptr, gw, NGW);
    zero_bf16((bf16*)(ws + WS_WIN) + (size_t)EVEN_IN * 1024, (size_t)(1024 - EVEN_IN) * 1024, gt, NGT);
}
__device__ __forceinline__ void ph_conv_l0b(const Ctx& C, const Params& P, int gw, int NGW) {
    const int gt = gw * 64 + C.lane, NGT = NGW * 64; unsigned char* ws = P.ws;
    tr_matrix(C, P.w_uq, 256, 768, 768, (bf16*)(ws + WS_WUQ), 256, 0, P.q_norm, gw, NGW);
    tr_matrix(C, P.w_ukv, 128, 1024, 1024, (bf16*)(ws + WS_WUKV), 256, 0, P.kv_norm, gw, NGW);
    { bf16* w = (bf16*)(ws + WS_WUKV); for (int i = gt; i < 1024 * 16; i += NGT) { const int r = i >> 4, cq = i & 15; *(u32x4*)(w + (size_t)r * 256 + 128 + cq * 8) = (u32x4){0u, 0u, 0u, 0u}; } }
    tr_matrix(C, P.glu_w, 512, 512, 512, (bf16*)(ws + WS_WGLU), 512, 0, nullptr, gw, NGW);
    tr_matrix(C, P.ev_w_out, 1024, 1024, 1024, (bf16*)(ws + WS_WOUT), 1024, 0, nullptr, gw, NGW);
}
__device__ __forceinline__ void ph_conv_l1(const Ctx& C, const Params& P, int gw, int NGW) {
    tr_matrix(C, P.hy_w_in, 1024, 3072, 3072, (bf16*)(P.ws + WS_WHIN), 1024, 0, nullptr, gw, NGW);
    tr_matrix(C, P.hy_w_out, 1024, 1024, 1024, (bf16*)(P.ws + WS_WHOUT), 1024, 0, nullptr, gw, NGW);
}
__device__ __forceinline__ void ph_conv_moe(const Ctx& C, const Params& P, int li) {
    const int gw = C.bid * 8 + C.wave, NGW = C.G * 8;
    LAS float* scr = (LAS float*)(C.lds + RING_OFF + C.wave * 8448);
    bf16* W1 = (bf16*)(P.ws + AR_W1); bf16* W2 = (bf16*)(P.ws + AR_W2);
    for (int it = gw; it < 65 * 384; it += NGW) {
        const int e = it / 384, r = it % 384, kind = r >> 7, idx = r & 127;
        if (kind < 2) { const float* W = (e < 64) ? ((kind == 0 ? P.w_gate : P.w_up) + ((size_t)li * 64 + e) * 1024 * 256) : ((kind == 0 ? P.sh_gate : P.sh_up) + (size_t)li * 1024 * 256);
            const int kb = idx >> 3, nb = idx & 7, n0 = 32 * nb; const int drow0 = (n0 >> 7) * 256 + ((n0 >> 5) & 3) * 64 + kind * 32;
            tr_item(W, 256, W1 + (size_t)e * 512 * 1024, 1024, 64 * kb, n0, drow0, nullptr, scr, C.lane); }
        else { const float* W = (e < 64) ? (P.w_down + ((size_t)li * 64 + e) * 256 * 1024) : (P.sh_down + (size_t)li * 256 * 1024);
            const int kb = idx >> 5, nb = idx & 31;
            tr_item(W, 1024, W2 + (size_t)e * 1024 * 256, 256, 64 * kb, 32 * nb, 32 * nb, nullptr, scr, C.lane); }
    }
}

__device__ __forceinline__ void ph_s5_tables(const Ctx& C, const Params& P, int job0, int jstride) {
    LAS float* LST = (LAS float*)(C.lds + RING_OFF);
    LAS float* BB = LST + 256;
    LAS float* CC = BB + 4096;
    LAS float* LP = CC + 4096;
    LAS float* KT = LP + 8448;
    bf16* SOUT = (bf16*)(P.ws + WS_SOUT); bf16* WG = (bf16*)(P.ws + WS_WG); float* LAMT = (float*)(P.ws + WS_LAMT);
    for (int job = job0; job < S5G * 8; job += jstride) {
        const int g = job >> 3, part = job & 7;
        __syncthreads();
        if (C.tid < 128) { const int dir = C.tid >> 6, p = C.tid & 63, gi = dir * 32 + g;
            const float lr = fminf(P.lam_re[gi * 64 + p], -1e-4f), li = P.lam_im[gi * 64 + p], step = expf(P.log_step[gi]);
            const float a = lr * step, b = li * step; LST[(dir * 64 + p) * 2] = a; LST[(dir * 64 + p) * 2 + 1] = b;
            const float ea = expf(a), lbr = ea * cosf(b), lbi = ea * sinf(b);
            const float nr = lbr - 1.0f, ni = lbi, den = lr * lr + li * li;
            const float qr = (nr * lr + ni * li) / den, qi = (ni * lr - nr * li) / den;
#pragma unroll
            for (int h = 0; h < 16; ++h) { const float br = P.b_re[((size_t)gi * 64 + p) * 16 + h], bi = P.b_im[((size_t)gi * 64 + p) * 16 + h];
                BB[((dir * 64 + p) * 16 + h) * 2] = qr * br - qi * bi; BB[((dir * 64 + p) * 16 + h) * 2 + 1] = qr * bi + qi * br; } }
        for (int i = C.tid; i < 2048; i += 512) { const int dir = i >> 10, r = i & 1023; const size_t gi = (size_t)(dir * 32 + g) * 1024 + r; CC[i * 2] = P.c_re[gi]; CC[i * 2 + 1] = P.c_im[gi]; }
        __syncthreads();
        for (int i = C.tid; i < 2 * 33 * 64; i += 512) { const int dir = i / (33 * 64), r = i % (33 * 64), tau = r >> 6, p = r & 63;
            const float a = LST[(dir * 64 + p) * 2] * (float)tau, b = LST[(dir * 64 + p) * 2 + 1] * (float)tau; const float ea = expf(a);
            LP[i * 2] = ea * cosf(b); LP[i * 2 + 1] = ea * sinf(b); }
        __syncthreads();
        for (int i2 = C.tid; i2 < 2 * 32 * 32; i2 += 512) { const int dir = i2 >> 10, tau = (i2 >> 5) & 31, hp = 2 * part + ((i2 >> 4) & 1), h = i2 & 15; const int i = ((dir * 32 + tau) * 16 + hp) * 16 + h;
            float s = 0.f;
#pragma unroll 8
            for (int p = 0; p < 64; ++p) { const f32x2 c2 = *(const LAS f32x2*)(CC + ((dir * 16 + hp) * 64 + p) * 2), l2 = *(const LAS f32x2*)(LP + ((dir * 33 + tau) * 64 + p) * 2), b2 = *(const LAS f32x2*)(BB + ((dir * 64 + p) * 16 + h) * 2);
                const float xr = c2.x * l2.x - c2.y * l2.y, xi = c2.x * l2.y + c2.y * l2.x;
                s += xr * b2.x - xi * b2.y; }
            KT[i] = s; }
        __syncthreads();
        for (int i = C.tid; i < 64 * 96; i += 512) { const int nn = i / 96, k0 = (i % 96) * 8, t = nn >> 1, hp = 2 * part + (nn & 1), n = t * 16 + hp; float v[8];
#pragma unroll
            for (int j = 0; j < 8; ++j) { const int k = k0 + j;
                if (k < 512) { const int s = k >> 4, h = k & 15;
                    if (t > s) v[j] = KT[((0 * 32 + (t - s)) * 16 + hp) * 16 + h];
                    else if (t < s) v[j] = KT[((1 * 32 + (s - t)) * 16 + hp) * 16 + h];
                    else v[j] = KT[((0 * 32) * 16 + hp) * 16 + h] + KT[((1 * 32) * 16 + hp) * 16 + h] + (hp == h ? P.s5_d[g * 16 + h] : 0.f); }
                else { const int q = k - 512, dir = q >> 7, ri = (q >> 6) & 1, p = q & 63, tau = dir == 0 ? t + 1 : 32 - t;
                    const float cr = CC[((dir * 16 + hp) * 64 + p) * 2], ci = CC[((dir * 16 + hp) * 64 + p) * 2 + 1];
                    const float lr = LP[((dir * 33 + tau) * 64 + p) * 2], li = LP[((dir * 33 + tau) * 64 + p) * 2 + 1];
                    v[j] = ri == 0 ? (cr * lr - ci * li) : -(cr * li + ci * lr); } }
            u32x4 o; o.x = pk2(v[0], v[1]); o.y = pk2(v[2], v[3]); o.z = pk2(v[4], v[5]); o.w = pk2(v[6], v[7]);
            *(u32x4*)(WG + ((size_t)g * 512 + n) * 768 + k0) = o; }
        for (int i = C.tid; i < 32 * 64; i += 512) { const int q = 32 * part + (i >> 6), k0 = (i & 63) * 8, dir = q >> 7, ri = (q >> 6) & 1, p = q & 63; float v[8];
#pragma unroll
            for (int j = 0; j < 8; ++j) { const int k = k0 + j, s = k >> 4, h = k & 15, e = dir == 0 ? 31 - s : s;
                const float lr = LP[((dir * 33 + e) * 64 + p) * 2], li = LP[((dir * 33 + e) * 64 + p) * 2 + 1];
                const float br = BB[((dir * 64 + p) * 16 + h) * 2], bi = BB[((dir * 64 + p) * 16 + h) * 2 + 1];
                v[j] = ri == 0 ? (lr * br - li * bi) : (lr * bi + li * br); }
            u32x4 o; o.x = pk2(v[0], v[1]); o.y = pk2(v[2], v[3]); o.z = pk2(v[4], v[5]); o.w = pk2(v[6], v[7]);
            *(u32x4*)(SOUT + ((size_t)g * 256 + q) * 512 + k0) = o; }
        if (part == 0 && C.tid < 128) { const int dir = C.tid >> 6, p = C.tid & 63; LAMT[((g * 2 + dir) * 64 + p) * 2] = LP[((dir * 33 + 32) * 64 + p) * 2]; LAMT[((g * 2 + dir) * 64 + p) * 2 + 1] = LP[((dir * 33 + 32) * 64 + p) * 2 + 1]; }
    }
    __syncthreads();
}

__device__ __forceinline__ void ph_hy_filter(const Ctx& C, const Params& P, int item0, int istride) {
    LAS float* Z = (LAS float*)(C.lds + RING_OFF);
    LAS float* H1 = Z + 32 * 33 + 32;
    LAS float* H2 = H1 + 2048;
    float* HFT = (float*)(P.ws + WS_HFT);
    constexpr float PI2 = 6.283185307179586f;
    for (int item = item0; item < SEQ / 32; item += istride) {
        const int n0 = item * 32;
        __syncthreads();
        for (int i = C.tid; i < 32 * 33; i += 512) { const int p = i / 33, j = i % 33, n = n0 + p; const float tn = (float)n / 4095.0f, ang = PI2 * (float)n / 4096.0f; float v;
            if (j == 0) v = tn; else { const int bi = (j - 1) & 15; const float band = 1e-4f + (float)bi * ((15.0f - 1e-4f) / 15.0f); v = (j <= 16) ? cosf(band * ang) : -sinf(band * ang); }
            Z[p * 33 + j] = v; }
        __syncthreads();
        for (int i = C.tid; i < 2048; i += 512) { const int p = i >> 6, u = i & 63; float s = P.f_b1[u];
#pragma unroll
            for (int j = 0; j < 33; ++j) s += Z[p * 33 + j] * P.f_w1[j * 64 + u];
            H1[p * 64 + u] = sinf(P.f_freq[u] * s); }
        __syncthreads();
        for (int i = C.tid; i < 2048; i += 512) { const int p = i >> 6, u = i & 63; float s = P.f_b2[u];
#pragma unroll 16
            for (int k = 0; k < 64; ++k) s += H1[p * 64 + k] * P.f_w2[k * 64 + u];
            H2[p * 65 + u] = sinf(P.f_freq[u] * s); }
        __syncthreads();
        for (int ct = C.wave; ct < 64; ct += 8) { const int col = ct * 32 + (C.lane & 31), dir = col >> 10, d = col & 1023, kh = C.lane >> 5;
            f32x16 acc = {};
#pragma unroll 8
            for (int sk = 0; sk < 32; ++sk) { const float a = H2[(C.lane & 31) * 65 + 2 * sk + kh], b = P.f_w3[(size_t)(2 * sk + kh) * 2048 + col]; acc = __builtin_amdgcn_mfma_f32_32x32x2f32(a, b, acc, 0, 0, 0); }
            const float delta = 3.0701134573253945f + (float)d * ((15.350567286626972f - 3.0701134573253945f) / 1023.0f);
            float* o = HFT + ((size_t)d * 2 + dir) * 4096 + n0;
#pragma unroll
            for (int r4 = 0; r4 < 4; ++r4) { const int p0 = 8 * r4 + 4 * kh; f32x4 v;
                v.x = acc[4 * r4] * expf(-((float)(n0 + p0) / 4095.0f) * delta); v.y = acc[4 * r4 + 1] * expf(-((float)(n0 + p0 + 1) / 4095.0f) * delta);
                v.z = acc[4 * r4 + 2] * expf(-((float)(n0 + p0 + 2) / 4095.0f) * delta); v.w = acc[4 * r4 + 3] * expf(-((float)(n0 + p0 + 3) / 4095.0f) * delta);
                *(f32x4*)(o + p0) = v; } }
    }
    __syncthreads();
}

__device__ __forceinline__ void ph_norm(const Ctx& C, const Params& P, const float* xin, int li, int sh_idx, bool with_ctx) {
    const int gw = C.bid * 8 + C.wave, NGW = C.G * 8; bf16* H = (bf16*)(P.ws + WS_H);
    const float* mod = (const float*)(P.ws + WS_MOD); const float* modctx = (const float*)(P.ws + WS_MODCTX);
    const int nrows = with_ctx ? TA : T;
    for (int row0 = gw; row0 < nrows; row0 += 4 * NGW) {
        f32x4 v[4][4]; float s[4]; const float* shp[4]; const float* scp[4]; bool ok[4];
#pragma unroll
        for (int q = 0; q < 4; ++q) { const int row = row0 + q * NGW; ok[q] = row < nrows; const int rr = ok[q] ? row : row0; const float* xr;
            if (rr < T) { xr = xin + (size_t)rr * 1024; const float* m = mod + (size_t)(li * 8 + (rr >> 12)) * 6144; shp[q] = m + sh_idx * 1024; scp[q] = m + (sh_idx + 1) * 1024; }
            else { xr = P.ctx + (size_t)(rr - T) * 1024; shp[q] = modctx; scp[q] = modctx + 1024; }
            s[q] = 0.f;
#pragma unroll
            for (int j = 0; j < 4; ++j) { v[q][j] = *(const f32x4*)(xr + 256 * j + 4 * C.lane); } }
#pragma unroll
        for (int q = 0; q < 4; ++q) {
#pragma unroll
            for (int j = 0; j < 4; ++j) s[q] += (v[q][j].x * v[q][j].x + v[q][j].y * v[q][j].y) + (v[q][j].z * v[q][j].z + v[q][j].w * v[q][j].w);
            const float rstd = 1.0f / sqrtf(wave_sum(s[q]) * (1.0f / 1024.0f) + EPS);
            if (ok[q]) { const int row = row0 + q * NGW;
#pragma unroll
                for (int j = 0; j < 4; ++j) { const f32x4 a = *(const f32x4*)(scp[q] + 256 * j + 4 * C.lane), b = *(const f32x4*)(shp[q] + 256 * j + 4 * C.lane);
                    const f32x4 y = v[q][j] * rstd * (a + 1.0f) + b; u32x2 o; o.x = pk2(y.x, y.y); o.y = pk2(y.z, y.w);
                    *(u32x2*)(H + (size_t)row * 1024 + 256 * j + 4 * C.lane) = o; } } }
    }
}

__device__ __forceinline__ void ph_rownorm1(const Ctx& C, const Params& P) {
    const int gw = C.bid * 8 + C.wave, NGW = C.G * 8; const bf16* PROJ = (const bf16*)(P.ws + AR_PROJ); bf16* QN = (bf16*)(P.ws + AR_QN); bf16* CKV = (bf16*)(P.ws + AR_CKV);
    for (int row0 = gw; row0 < TA; row0 += 4 * NGW) {
        u32x2 q[4]; unsigned kv[4];
#pragma unroll
        for (int r = 0; r < 4; ++r) { const int row = (row0 + r * NGW < TA) ? row0 + r * NGW : row0; q[r] = *(const u32x2*)(PROJ + (size_t)row * 512 + 4 * C.lane); kv[r] = *(const unsigned*)(PROJ + (size_t)row * 512 + 256 + 2 * C.lane); }
        float sq[4], sk[4];
#pragma unroll
        for (int r = 0; r < 4; ++r) { const float q0 = bflo(q[r].x), q1 = bfhi(q[r].x), q2 = bflo(q[r].y), q3 = bfhi(q[r].y), k0 = bflo(kv[r]), k1 = bfhi(kv[r]); sq[r] = (q0 * q0 + q1 * q1) + (q2 * q2 + q3 * q3); sk[r] = k0 * k0 + k1 * k1; }
#pragma unroll
        for (int o = 1; o < 64; o <<= 1) {
#pragma unroll
            for (int r = 0; r < 4; ++r) { sq[r] += __shfl_xor(sq[r], o); sk[r] += __shfl_xor(sk[r], o); } }
#pragma unroll
        for (int r = 0; r < 4; ++r) { const int row = row0 + r * NGW; if (row < TA) {
            const float q0 = bflo(q[r].x), q1 = bfhi(q[r].x), q2 = bflo(q[r].y), q3 = bfhi(q[r].y), k0 = bflo(kv[r]), k1 = bfhi(kv[r]);
            const float rq = 1.0f / sqrtf(sq[r] * (1.0f / 256.0f) + EPS), rk = 1.0f / sqrtf(sk[r] * (1.0f / 128.0f) + EPS);
            if (row < T) { u32x2 o; o.x = pk2(q0 * rq, q1 * rq); o.y = pk2(q2 * rq, q3 * rq); *(u32x2*)(QN + (size_t)row * 256 + 4 * C.lane) = o; }
            *(unsigned*)(CKV + (size_t)row * 256 + 2 * C.lane) = pk2(k0 * rk, k1 * rk);
            *(unsigned*)(CKV + (size_t)row * 256 + 128 + 2 * C.lane) = 0u; } }
    }
}

__device__ __forceinline__ void ph_qkfinal(const Ctx& C, const Params& P) {
    const int gw = C.bid * 8 + C.wave, NGW = C.G * 8;
    const bf16* PROJ = (const bf16*)(P.ws + AR_PROJ); const bf16* KVRAW = (const bf16*)(P.ws + AR_KVRAW); bf16* KF = (bf16*)(P.ws + AR_KF); bf16* Q = (bf16*)(P.ws + AR_QRAW);
    const int hd = C.lane >> 3, sub = C.lane & 7, j0 = 12 * sub;
    constexpr float QSCALE = 0.10206207261596577f * 1.4426950408889634f;
    float gq[12], gk[12];
#pragma unroll
    for (int i = 0; i < 12; ++i) { gq[i] = P.q_qk[j0 + i]; gk[i] = P.k_qk[j0 + i]; }
    for (int row0 = gw; row0 < TA; row0 += 2 * NGW) {
        u32x2 kw[2][3];
#pragma unroll
        for (int rr = 0; rr < 2; ++rr) { const int row = (row0 + rr * NGW < TA) ? row0 + rr * NGW : row0;
#pragma unroll
            for (int i = 0; i < 3; ++i) { const int j = j0 + 4 * i; const bf16* src = (j < 64) ? (KVRAW + (size_t)row * 1024 + hd * 128 + j) : (PROJ + (size_t)row * 512 + 384 + (j - 64));
                kw[rr][i] = *(const u32x2*)src; } }
#pragma unroll
        for (int rr = 0; rr < 2; ++rr) { const int row = row0 + rr * NGW; if (row >= TA) continue;
        const bool lat = row < T; const int pos = row & 4095;
        float cs[6], sn[6];
#pragma unroll
        for (int i = 0; i < 6; ++i) { const int j = j0 + 2 * i; cs[i] = 1.f; sn[i] = 0.f;
            if (j >= 64 && lat) { const int pi = (j - 64) >> 1; const float inv = exp2f(-(float)(pi & 7) * (13.287712379549449f / 8.0f)); const float ang = (float)(pi < 8 ? (pos >> 6) : (pos & 63)) * inv; cs[i] = cosf(ang); sn[i] = sinf(ang); } }
        { float x[12];
#pragma unroll
          for (int i = 0; i < 3; ++i) { const u32x2 w = kw[rr][i]; x[4 * i] = bflo(w.x); x[4 * i + 1] = bfhi(w.x); x[4 * i + 2] = bflo(w.y); x[4 * i + 3] = bfhi(w.y); }
          float s = 0.f;
#pragma unroll
          for (int i = 0; i < 12; ++i) s += x[i] * x[i];
          s += __shfl_xor(s, 1); s += __shfl_xor(s, 2); s += __shfl_xor(s, 4);
          const float r = 1.0f / sqrtf(s * (1.0f / 96.0f) + EPS);
#pragma unroll
          for (int i = 0; i < 12; ++i) x[i] = x[i] * r * gk[i];
#pragma unroll
          for (int i = 0; i < 6; ++i) { const float a = x[2 * i], b = x[2 * i + 1]; x[2 * i] = a * cs[i] - b * sn[i]; x[2 * i + 1] = a * sn[i] + b * cs[i]; }
#pragma unroll
          for (int i = 0; i < 3; ++i) { u32x2 o; o.x = pk2(x[4 * i], x[4 * i + 1]); o.y = pk2(x[4 * i + 2], x[4 * i + 3]); *(u32x2*)(KF + (size_t)row * 768 + hd * 96 + j0 + 4 * i) = o; } }
        if (lat) { float x[12];
#pragma unroll
          for (int i = 0; i < 3; ++i) { const u32x2 w = *(const u32x2*)(Q + (size_t)row * 768 + hd * 96 + j0 + 4 * i); x[4 * i] = bflo(w.x); x[4 * i + 1] = bfhi(w.x); x[4 * i + 2] = bflo(w.y); x[4 * i + 3] = bfhi(w.y); }
          float s = 0.f;
#pragma unroll
          for (int i = 0; i < 12; ++i) s += x[i] * x[i];
          s += __shfl_xor(s, 1); s += __shfl_xor(s, 2); s += __shfl_xor(s, 4);
          const float r = 1.0f / sqrtf(s * (1.0f / 96.0f) + EPS);
#pragma unroll
          for (int i = 0; i < 12; ++i) x[i] = x[i] * r * gq[i];
#pragma unroll
          for (int i = 0; i < 6; ++i) { const float a = x[2 * i], b = x[2 * i + 1]; x[2 * i] = (a * cs[i] - b * sn[i]) * QSCALE; x[2 * i + 1] = (a * sn[i] + b * cs[i]) * QSCALE; }
#pragma unroll
          for (int i = 0; i < 3; ++i) { u32x2 o; o.x = pk2(x[4 * i], x[4 * i + 1]); o.y = pk2(x[4 * i + 2], x[4 * i + 3]); *(u32x2*)(Q + (size_t)row * 768 + hd * 96 + j0 + 4 * i) = o; } }
        }
    }
}

using pg8::Unit;
#define EPI_ARGS const f32x4 (&acc)[2][2][4][2], const Unit& u, int wr, int wc, int fr, int fq
__device__ __forceinline__ u32x4 pack8(const f32x4 a, const f32x4 b) { u32x4 w; w.x = pg8::cvt_pk_bf16(a[0], a[1]); w.y = pg8::cvt_pk_bf16(a[2], a[3]); w.z = pg8::cvt_pk_bf16(b[0], b[1]); w.w = pg8::cvt_pk_bf16(b[2], b[3]); return w; }

__device__ __forceinline__ void widen_pair(const u32x4 d0, const u32x4 d1, bool odd, u32x4& A, u32x4& B) {
    u32x4 send, recv;
#pragma unroll
    for (int q = 0; q < 4; ++q) { send[q] = odd ? d0[q] : d1[q]; recv[q] = (unsigned)__builtin_amdgcn_update_dpp(0, (int)send[q], 0xB1, 0xf, 0xf, false); }
#pragma unroll
    for (int q = 0; q < 4; ++q) { A[q] = odd ? recv[q] : d0[q]; B[q] = odd ? d1[q] : recv[q]; }
}
struct SchedDense {
    const char* A; const char* B; unsigned lda, ldb; int nM, nN, G, c;
    __device__ __forceinline__ bool next(int i, Unit& u) const { const int L = i * G + c; if (L >= nM * nN) return false; const int pm = L / nN, pn = L % nN;
        u.A = A + (size_t)pm * 256 * lda; u.B = B + (size_t)pn * 256 * ldb; u.rows = nullptr; u.pm = pm; u.pn = pn; u.z = 0; return true; }
};
struct SchedBatched {
    const char* A; const char* B; unsigned lda, ldb; size_t sA, sB; int nZ, nM, nN, G, c;
    __device__ __forceinline__ bool next(int i, Unit& u) const { const int L = i * G + c; if (L >= nZ * nM * nN) return false; const int z = L / (nM * nN), r = L % (nM * nN), pm = r / nN, pn = r % nN;
        u.A = A + (size_t)z * sA + (size_t)pm * 256 * lda; u.B = B + (size_t)z * sB + (size_t)pn * 256 * ldb; u.rows = nullptr; u.pm = pm; u.pn = pn; u.z = z; return true; }
};
struct SchedUp {
    const char *QN, *WUQ, *CKV, *WUKV; int G, c;
    __device__ __forceinline__ bool next(int i, Unit& u) const { int L = i * G + c; u.rows = nullptr;
        if (L < 384) { u.pm = L / 3; u.pn = L % 3; u.z = 0; u.A = QN + (size_t)u.pm * 256 * 512; u.B = WUQ + (size_t)u.pn * 256 * 512; return true; }
        L -= 384; if (L >= 544) return false; u.pm = L >> 2; u.pn = L & 3; u.z = 1; u.A = CKV + (size_t)u.pm * 256 * 512; u.B = WUKV + (size_t)u.pn * 256 * 512; return true; }
};

struct EpiInProj {
    static constexpr bool PERM = true; bf16* PROJ; bf16* U;
    __device__ __forceinline__ void operator()(EPI_ARGS) const {
#pragma unroll
        for (int ai = 0; ai < 2; ++ai)
#pragma unroll
            for (int m = 0; m < 4; ++m) { const int row = u.pm * 256 + ai * 128 + wr * 64 + m * 16 + fr; int urow, s;
                if (row < T) { const int b = row >> 12, pos = row & 4095; urow = (pos >> 5) * 8 + b; s = pos & 31; } else { const int rr = row - T, b = rr >> 8, pos = rr & 255; urow = 1024 + (pos >> 5) * 8 + b; s = pos & 31; }
#pragma unroll
                for (int bj = 0; bj < 2; ++bj) { const int col0 = u.pn * 256 + wc * 64 + bj * 32 + 8 * fq; const u32x4 w = pack8(acc[ai][bj][m][0], acc[ai][bj][m][1]);
                    if (col0 < UOFF) *(u32x4*)(PROJ + (size_t)row * 512 + col0) = w;
                    else if (col0 < EVEN_IN) { const int gc = col0 - UOFF, g = gc >> 4, h0 = gc & 15; *(u32x4*)(U + ((size_t)(g * S5ROWS + urow) * S5K + s * 16 + h0)) = w; } } }
    }
};
struct EpiUp {
    static constexpr bool PERM = true; bf16* QRAW; bf16* KVRAW;
    __device__ __forceinline__ void operator()(EPI_ARGS) const { bf16* O = u.z ? KVRAW : QRAW; const int ldc = u.z ? 1024 : 768; const bool odd = fr & 1;
#pragma unroll
        for (int ai = 0; ai < 2; ++ai)
#pragma unroll
            for (int m = 0; m < 4; ++m) { const int rowE = u.pm * 256 + ai * 128 + wr * 64 + m * 16 + (fr & ~1); u32x4 A, B; widen_pair(pack8(acc[ai][0][m][0], acc[ai][0][m][1]), pack8(acc[ai][1][m][0], acc[ai][1][m][1]), odd, A, B);
                bf16* op = O + (size_t)rowE * ldc + u.pn * 256 + wc * 64 + (odd ? 32 : 0) + 8 * fq; *(u32x4*)op = A; *(u32x4*)(op + ldc) = B; }
    }
};
struct EpiF32Batched {
    static constexpr bool PERM = false; float* O; int rows_per_z, ldc;
    __device__ __forceinline__ void operator()(EPI_ARGS) const {
#pragma unroll
        for (int ai = 0; ai < 2; ++ai)
#pragma unroll
            for (int m = 0; m < 4; ++m) { const int row = u.pm * 256 + ai * 128 + wr * 64 + m * 16 + fr; float* rp = O + ((size_t)u.z * rows_per_z + row) * ldc + u.pn * 256 + wc * 32 + 4 * fq;
#pragma unroll
                for (int bj = 0; bj < 2; ++bj)
#pragma unroll
                    for (int n = 0; n < 2; ++n) *(f32x4*)(rp + bj * 128 + n * 16) = acc[ai][bj][m][n]; }
    }
};
struct EpiS5C {
    static constexpr bool PERM = true; bf16* Z;
    __device__ __forceinline__ void operator()(EPI_ARGS) const {
#pragma unroll
        for (int ai = 0; ai < 2; ++ai)
#pragma unroll
            for (int m = 0; m < 4; ++m) { const int rr = u.pm * 256 + ai * 128 + wr * 64 + m * 16 + fr, c = rr >> 3, b = rr & 7;
#pragma unroll
                for (int bj = 0; bj < 2; ++bj) { const int cc = u.pn * 256 + wc * 64 + bj * 32 + 8 * fq, t = cc >> 4, h0 = cc & 15; f32x4 v0 = acc[ai][bj][m][0], v1 = acc[ai][bj][m][1];
#pragma unroll
                    for (int j = 0; j < 4; ++j) { v0[j] = gelu_tanh(v0[j]); v1[j] = gelu_tanh(v1[j]); }
                    *(u32x4*)(Z + ((size_t)(b * 4096 + c * 32 + t) * 512 + u.z * 16 + h0)) = pack8(v0, v1); } }
    }
};
struct EpiGlu {
    static constexpr bool PERM = true; const bf16* Z; const float* gb; bf16* CAT;
    __device__ __forceinline__ void operator()(EPI_ARGS) const {
#pragma unroll
        for (int ai = 0; ai < 2; ++ai)
#pragma unroll
            for (int m = 0; m < 4; ++m) { const int row = u.pm * 256 + ai * 128 + wr * 64 + m * 16 + fr;
#pragma unroll
                for (int bj = 0; bj < 2; ++bj) { const int col0 = u.pn * 256 + wc * 64 + bj * 32 + 8 * fq; const u32x4 zw = *(const u32x4*)(Z + (size_t)row * 512 + col0);
                    const f32x4 b0 = *(const f32x4*)(gb + col0), b1 = *(const f32x4*)(gb + col0 + 4); f32x4 v0 = acc[ai][bj][m][0] + b0, v1 = acc[ai][bj][m][1] + b1;
                    v0[0] = bflo(zw.x) * sigmf(v0[0]); v0[1] = bfhi(zw.x) * sigmf(v0[1]); v0[2] = bflo(zw.y) * sigmf(v0[2]); v0[3] = bfhi(zw.y) * sigmf(v0[3]);
                    v1[0] = bflo(zw.z) * sigmf(v1[0]); v1[1] = bfhi(zw.z) * sigmf(v1[1]); v1[2] = bflo(zw.w) * sigmf(v1[2]); v1[3] = bfhi(zw.w) * sigmf(v1[3]);
                    *(u32x4*)(CAT + (size_t)row * 1024 + 512 + col0) = pack8(v0, v1); } }
    }
};
struct EpiResid {
    static constexpr bool PERM = false; const float* xin; float* xout; const float* gate;
    __device__ __forceinline__ void operator()(EPI_ARGS) const {
#pragma unroll
        for (int ai = 0; ai < 2; ++ai)
#pragma unroll
            for (int m = 0; m < 4; ++m) { const int row = u.pm * 256 + ai * 128 + wr * 64 + m * 16 + fr; const int col0 = u.pn * 256 + wc * 32 + 4 * fq; const float* gp = gate + (size_t)(row >> 12) * 6144 + col0;
#pragma unroll
                for (int bj = 0; bj < 2; ++bj)
#pragma unroll
                    for (int n = 0; n < 2; ++n) { const size_t o = (size_t)row * 1024 + col0 + bj * 128 + n * 16; const f32x4 xv = *(const f32x4*)(xin + o), gv = *(const f32x4*)(gp + bj * 128 + n * 16);
                        *(f32x4*)(xout + o) = xv + gv * acc[ai][bj][m][n]; } }
    }
};

__device__ __forceinline__ void ph_s5_scan(const Ctx& C, const Params& P) {
    const int gt = C.bid * 512 + C.tid; if (gt >= S5G * NB * 128) return;
    const int p = gt & 63, dir = (gt >> 6) & 1, b = (gt >> 7) & 7, g = gt >> 10;
    const float* LAMT = (const float*)(P.ws + WS_LAMT); const float lr = LAMT[((g * 2 + dir) * 64 + p) * 2], li = LAMT[((g * 2 + dir) * 64 + p) * 2 + 1];
    const float* S = (const float*)(P.ws + AR_SRAW) + (size_t)g * S5ROWS * 256 + dir * 128 + p;
    bf16* Ug = (bf16*)(P.ws + AR_U) + (size_t)g * S5ROWS * S5K + 512 + dir * 128 + p;
    float sr = 0.f, si = 0.f;
    if (dir == 0) {
#pragma unroll
        for (int j = 0; j < S5NCC; ++j) { const int row = 1024 + j * 8 + b; const float ar = S[(size_t)row * 256], ai = S[(size_t)row * 256 + 64]; const float nr = lr * sr - li * si + ar, ni = lr * si + li * sr + ai; sr = nr; si = ni; }
#pragma unroll 8
        for (int c = 0; c < S5NCH; ++c) { const int row = c * 8 + b; const float ar = S[(size_t)row * 256], ai = S[(size_t)row * 256 + 64];
            Ug[(size_t)row * S5K] = (bf16)f2bf(sr); Ug[(size_t)row * S5K + 64] = (bf16)f2bf(si);
            const float nr = lr * sr - li * si + ar, ni = lr * si + li * sr + ai; sr = nr; si = ni; }
    } else {
#pragma unroll
        for (int j = S5NCC - 1; j >= 0; --j) { const int row = 1024 + j * 8 + b; const float ar = S[(size_t)row * 256], ai = S[(size_t)row * 256 + 64]; const float nr = lr * sr - li * si + ar, ni = lr * si + li * sr + ai; sr = nr; si = ni; }
#pragma unroll 8
        for (int c = S5NCH - 1; c >= 0; --c) { const int row = c * 8 + b; const float ar = S[(size_t)row * 256], ai = S[(size_t)row * 256 + 64];
            Ug[(size_t)row * S5K] = (bf16)f2bf(sr); Ug[(size_t)row * S5K + 64] = (bf16)f2bf(si);
            const float nr = lr * sr - li * si + ar, ni = lr * si + li * sr + ai; sr = nr; si = ni; }
    }
}

constexpr int AT_KROW = 208, AT_KB = 64 * AT_KROW  , AT_VB = 8192;
constexpr int AT_K = RING_OFF, AT_V = AT_K + 2 * AT_KB, AT_WS = AT_V + 2 * AT_VB, AT_OST = AT_WS + 8 * 256, AT_END = AT_OST + 8 * 4096;
__device__ __forceinline__ int crow(int r, int hi) { return (r & 3) + 8 * (r >> 2) + 4 * hi; }
typedef short v4i16_t __attribute__((ext_vector_type(4)));
__device__ __forceinline__ s16x4 vtr(const LAS unsigned char* p) { return __builtin_bit_cast(s16x4, __builtin_amdgcn_ds_read_tr16_b64_v4i16((LAS v4i16_t*)p)); }
__device__ __forceinline__ float xhalf_max(float m) { auto rr = __builtin_amdgcn_permlane32_swap(__float_as_uint(m), __float_as_uint(m), false, false); return fmaxf(__uint_as_float(rr[0]), __uint_as_float(rr[1])); }
__device__ __forceinline__ float xhalf_sum(float m) { auto rr = __builtin_amdgcn_permlane32_swap(__float_as_uint(m), __float_as_uint(m), false, false); return __uint_as_float(rr[0]) + __uint_as_float(rr[1]); }

__device__ __forceinline__ float max3f(float a, float b, float c) { return fmaxf(fmaxf(a, b), c); }
constexpr int AT2_KB = 64 * 256, AT2_K = RING_OFF, AT2_V = AT2_K + 2 * AT2_KB, AT2_WS = AT2_V + 2 * AT_VB, AT2_OST = AT2_WS + 8 * 256, AT2_END = AT2_OST + 8 * 4096;
static_assert(AT2_END <= LDS_BYTES, "attention LDS");
template <bool NOMAX> __device__ __forceinline__ void ph_attention(const Ctx& C, const Params& P, int vcu) {
    const bf16* Q = (const bf16*)(P.ws + AR_QRAW); const bf16* KF = (const bf16*)(P.ws + AR_KF); const bf16* KV = (const bf16*)(P.ws + AR_KVRAW); bf16* CAT = (bf16*)(P.ws + AR_CAT);
    const int lane = C.lane, wid = C.wave, r32 = lane & 31, hi = lane >> 5;
    LAS unsigned char* lds = C.lds;
    LAS float* wsf = (LAS float*)(lds + AT2_WS) + wid * 64;
    const int vrd = ((lane >> 4) & 1) * 32 + (lane & 3) * 8 + (4 * hi + ((lane & 15) >> 2)) * 64;
    int kro[6];
#pragma unroll
    for (int d0 = 0; d0 < 6; ++d0) kro[d0] = r32 * 256 + (((2 * d0 + hi) ^ (r32 & 15)) << 4);
    constexpr int NTILE = (SEQ + CTXL) / 64;
    constexpr float THR = 8.0f;
#define SB() __builtin_amdgcn_sched_barrier(0)
#define AT_ROW0(j) (((j) < 64) ? ((size_t)b * SEQ + (size_t)(j) * 64) : ((size_t)T + (size_t)b * CTXL + (size_t)((j) - 64) * 64))
#define AT_DMAK(j, buf) do { const bf16* kb_ = KF + AT_ROW0(j) * 768 + hd * 96; _Pragma("unroll") for (int q_ = 0; q_ < 2; ++q_) { \
        const int row_ = 4 * (2 * wid + q_) + (lane >> 4); int c_ = (lane & 15) ^ (row_ & 15); c_ = c_ < 12 ? c_ : c_ - 12;     \
        __builtin_amdgcn_global_load_lds((const unsigned*)(kb_ + row_ * 768 + c_ * 8), (LAS unsigned*)(lds + AT2_K + (buf) * AT2_KB + (2 * wid + q_) * 1024), 16, 0, 0); } } while (0)
#define AT_DMAV(j, buf) do { const bf16* vb_ = KV + AT_ROW0(j) * 1024 + hd * 128; \
        __builtin_amdgcn_global_load_lds((const unsigned*)(vb_ + (16 * (wid & 3) + (lane >> 2)) * 1024 + 64 + ((wid >> 2) * 4 + (lane & 3)) * 8), (LAS unsigned*)(lds + AT2_V + (buf) * AT_VB + wid * 1024), 16, 0, 0); } while (0)
#define AT_KFRAG(Kb, d0, h) (*(const LAS bf16x8*)((Kb) + (h) * 32 * 256 + kro[d0]))
    for (int i = 0;; ++i) {
        const int un = i * C.G + vcu; if (un >= NB * NHEAD * 16) break;
        const int bh = un >> 4, qb = un & 15, b = bh >> 3, hd = bh & 7;
        const size_t qrow = (size_t)b * SEQ + qb * 256 + wid * 32 + r32;
        bf16x8 qr[6];
#pragma unroll
        for (int d0 = 0; d0 < 6; ++d0) qr[d0] = *(const bf16x8*)(Q + qrow * 768 + hd * 96 + d0 * 16 + hi * 8);
        f32x16 o0 = {}, o1 = {}; float m = NOMAX ? 0.f : -1e30f, l = 0.f;
        AT_DMAK(0, 0); AT_DMAV(0, 0); AT_DMAK(1, 1);
        __syncthreads();
        f32x16 pc0 = {}, pc1 = {};
        { const LAS unsigned char* Kb = lds + AT2_K;
#pragma unroll
          for (int d0 = 0; d0 < 6; ++d0) { pc0 = __builtin_amdgcn_mfma_f32_32x32x16_bf16(AT_KFRAG(Kb, d0, 0), qr[d0], pc0, 0, 0, 0); pc1 = __builtin_amdgcn_mfma_f32_32x32x16_bf16(AT_KFRAG(Kb, d0, 1), qr[d0], pc1, 0, 0, 0); } }
        for (int j = 0; j < NTILE; ++j) {
            const int buf = j & 1; const bool more = j + 1 < NTILE;
            if (j + 2 < NTILE) AT_DMAK(j + 2, buf);
            if (more) AT_DMAV(j + 1, buf ^ 1);
            const LAS unsigned char* Kn = lds + AT2_K + (buf ^ 1) * AT2_KB;
            f32x16 pn0 = {}, pn1 = {};
            bf16x8 ka = AT_KFRAG(Kn, 0, 0), kb = AT_KFRAG(Kn, 0, 1), kc = AT_KFRAG(Kn, 1, 0), kd = AT_KFRAG(Kn, 1, 1);
            if (more) { pn0 = __builtin_amdgcn_mfma_f32_32x32x16_bf16(ka, qr[0], pn0, 0, 0, 0); pn1 = __builtin_amdgcn_mfma_f32_32x32x16_bf16(kb, qr[0], pn1, 0, 0, 0); }
            float mt = 0.f, mu = 0.f;
            if constexpr (!NOMAX) { mt = max3f(pc0[0], pc0[1], pc1[0]); mu = max3f(pc0[2], pc0[3], pc1[1]);
            mt = max3f(mt, pc1[2], pc1[3]);
#pragma unroll
            for (int r = 4; r < 16; r += 4) { mt = max3f(mt, pc0[r], pc0[r + 1]); mu = max3f(mu, pc0[r + 2], pc0[r + 3]); mt = max3f(mt, pc1[r], pc1[r + 1]); mu = max3f(mu, pc1[r + 2], pc1[r + 3]); } }
            if (more) { pn0 = __builtin_amdgcn_mfma_f32_32x32x16_bf16(kc, qr[1], pn0, 0, 0, 0); pn1 = __builtin_amdgcn_mfma_f32_32x32x16_bf16(kd, qr[1], pn1, 0, 0, 0); }
            ka = AT_KFRAG(Kn, 2, 0); kb = AT_KFRAG(Kn, 2, 1); kc = AT_KFRAG(Kn, 3, 0); kd = AT_KFRAG(Kn, 3, 1);
            if constexpr (!NOMAX) mt = xhalf_max(fmaxf(mt, mu));
            if (!NOMAX && __any(mt > m + THR)) {
                const float mn = fmaxf(m, mt), alpha = __builtin_amdgcn_exp2f(m - mn); m = mn; l *= alpha;
                if (hi == 0) wsf[r32] = alpha;
                LDS_WAIT();
#pragma unroll
                for (int r = 0; r < 16; ++r) { const float a = wsf[crow(r, hi)]; o0[r] *= a; o1[r] *= a; }
            }
            SB();
            if (more) { pn0 = __builtin_amdgcn_mfma_f32_32x32x16_bf16(ka, qr[2], pn0, 0, 0, 0); pn1 = __builtin_amdgcn_mfma_f32_32x32x16_bf16(kb, qr[2], pn1, 0, 0, 0); }
            float ls = 0.f;
#pragma unroll
            for (int r = 0; r < 8; ++r) { pc0[r] = __builtin_amdgcn_exp2f(NOMAX ? pc0[r] : pc0[r] - m); ls += pc0[r]; }
            SB();
            if (more) { pn0 = __builtin_amdgcn_mfma_f32_32x32x16_bf16(kc, qr[3], pn0, 0, 0, 0); pn1 = __builtin_amdgcn_mfma_f32_32x32x16_bf16(kd, qr[3], pn1, 0, 0, 0); }
            ka = AT_KFRAG(Kn, 4, 0); kb = AT_KFRAG(Kn, 4, 1); kc = AT_KFRAG(Kn, 5, 0); kd = AT_KFRAG(Kn, 5, 1);
#pragma unroll
            for (int r = 8; r < 16; ++r) { pc0[r] = __builtin_amdgcn_exp2f(NOMAX ? pc0[r] : pc0[r] - m); ls += pc0[r]; }
            SB();
            if (more) { pn0 = __builtin_amdgcn_mfma_f32_32x32x16_bf16(ka, qr[4], pn0, 0, 0, 0); pn1 = __builtin_amdgcn_mfma_f32_32x32x16_bf16(kb, qr[4], pn1, 0, 0, 0); }
#pragma unroll
            for (int r = 0; r < 8; ++r) { pc1[r] = __builtin_amdgcn_exp2f(NOMAX ? pc1[r] : pc1[r] - m); ls += pc1[r]; }
            SB();
            if (more) { pn0 = __builtin_amdgcn_mfma_f32_32x32x16_bf16(kc, qr[5], pn0, 0, 0, 0); pn1 = __builtin_amdgcn_mfma_f32_32x32x16_bf16(kd, qr[5], pn1, 0, 0, 0); }
#pragma unroll
            for (int r = 8; r < 16; ++r) { pc1[r] = __builtin_amdgcn_exp2f(NOMAX ? pc1[r] : pc1[r] - m); ls += pc1[r]; }
            l += ls;
            SB();
            const LAS unsigned char* Vb = lds + AT2_V + buf * AT_VB + vrd;
            s16x4 l0 = vtr(Vb), h0 = vtr(Vb + 512), l1 = vtr(Vb + 4096), h1 = vtr(Vb + 4096 + 512);
#pragma unroll
            for (int ks = 0; ks < 4; ++ks) {
                u32x4 w;
#pragma unroll
                for (int q = 0; q < 4; ++q) { const int r = (ks & 1) * 8 + 2 * q; w[q] = (ks < 2) ? pg8::cvt_pk_bf16(pc0[r], pc0[r + 1]) : pg8::cvt_pk_bf16(pc1[r], pc1[r + 1]); }
                const bf16x8 pw = __builtin_bit_cast(bf16x8, w);
                const bf16x8 v0 = (bf16x8){l0[0], l0[1], l0[2], l0[3], h0[0], h0[1], h0[2], h0[3]}, v1 = (bf16x8){l1[0], l1[1], l1[2], l1[3], h1[0], h1[1], h1[2], h1[3]};
                if (ks < 3) { l0 = vtr(Vb + (ks + 1) * 1024); h0 = vtr(Vb + (ks + 1) * 1024 + 512); l1 = vtr(Vb + 4096 + (ks + 1) * 1024); h1 = vtr(Vb + 4096 + (ks + 1) * 1024 + 512); }
                o0 = __builtin_amdgcn_mfma_f32_32x32x16_bf16(pw, v0, o0, 0, 0, 0); o1 = __builtin_amdgcn_mfma_f32_32x32x16_bf16(pw, v1, o1, 0, 0, 0);
                SB();
            }
            pc0 = pn0; pc1 = pn1;
            __syncthreads();
        }
        l = xhalf_sum(l);
        if (hi == 0) wsf[32 + r32] = l;
        LDS_WAIT();
        LAS bf16* stl = (LAS bf16*)(lds + AT2_OST + wid * 4096);
#pragma unroll
        for (int r = 0; r < 16; ++r) { const int orow = crow(r, hi); const float rl = 1.0f / wsf[32 + orow];
            stl[orow * 64 + r32] = (bf16)f2bf(o0[r] * rl); stl[orow * 64 + 32 + r32] = (bf16)f2bf(o1[r] * rl); }
        LDS_WAIT();
        const size_t orow0 = (size_t)b * SEQ + qb * 256 + wid * 32;
#pragma unroll
        for (int q = 0; q < 4; ++q) { const int row = q * 8 + (lane >> 3), ch = lane & 7; const u32x4 v = *(const LAS u32x4*)(stl + row * 64 + ch * 8); *(u32x4*)(CAT + (orow0 + row) * 1024 + hd * 64 + ch * 8) = v; }
        __syncthreads();
    }
#undef SB
#undef AT_ROW0
#undef AT_DMAK
#undef AT_DMAV
#undef AT_KFRAG
}

constexpr int LC_BLKSTART = 128, LC_CNT = 704, LC_BLK2HE = 1216;
constexpr int RT_XH = RING_OFF, RT_XL = RT_XH + 16 * 1032 * 2, RT_LG = RT_XL + 16 * 1032 * 2, RT_MS = RT_LG + 2 * 16 * 64 * 4, RT_KEYS = RT_MS + 2 * 1024 * 4, RT_LCNT = RT_KEYS + 16 * 64 * 4, RT_GBASE = RT_LCNT + 64 * 4  , RT_ST = RT_GBASE + 512  , RT_END = RT_ST + 16 * 1024 * 4;
static_assert(RT_END <= LDS_BYTES && RT_ST % 16 == 0, "router LDS");

__device__ __forceinline__ void ph_router(const Ctx& C, const Params& P, const float* xin, int li, int cset) {
    LAS bf16* XH = (LAS bf16*)(C.lds + RT_XH); LAS bf16* XL = (LAS bf16*)(C.lds + RT_XL); LAS float* LG = (LAS float*)(C.lds + RT_LG);
    LAS float* MS = (LAS float*)(C.lds + RT_MS);
    LAS int* lcnt = (LAS int*)(C.lds + RT_LCNT); LAS int* gbase = (LAS int*)(C.lds + RT_GBASE);
    bf16* H = (bf16*)(P.ws + WS_H); const float* mod = (const float*)(P.ws + WS_MOD); float* TOPW = (float*)(P.ws + WS_TOPW); int* TOK = (int*)(P.ws + WS_TOK);
    unsigned* gcnt = (unsigned*)(P.ws + WS_CTL) + CW_CNT + (cset * 2) * 64 * 16;
    const float* RW = P.router_w + (size_t)li * 1024 * 64; const float* RB = P.router_b + li * 64;
    const int lane = C.lane, w = C.wave, eq = w & 3, kh = w >> 2, fi = lane & 15, fk = lane >> 4;
    constexpr int NT = T / 16;
    const int per = (NT + C.G - 1) / C.G, tbeg = C.bid * per, tend = (tbeg + per < NT) ? tbeg + per : NT;
    if (tbeg >= NT) return;
    bf16x8 bh[16], bl[16];
#pragma unroll
    for (int ks = 0; ks < 16; ++ks) { u32x4 wh, wl;
#pragma unroll
        for (int q = 0; q < 4; ++q) { const int k = kh * 512 + ks * 32 + 8 * fk + 2 * q; const float w0 = RW[(size_t)k * 64 + eq * 16 + fi], w1 = RW[(size_t)(k + 1) * 64 + eq * 16 + fi];
            const unsigned h0 = f2bf(w0), h1 = f2bf(w1); wh[q] = h0 | (h1 << 16); wl[q] = pk2(w0 - bf2f((unsigned short)h0), w1 - bf2f((unsigned short)h1)); }
        bh[ks] = __builtin_bit_cast(bf16x8, wh); bl[ks] = __builtin_bit_cast(bf16x8, wl);
        if ((ks & 3) == 3) asm volatile("" ::: "memory"); }
    const float rb = RB[lane];
    if (C.tid < 64) lcnt[C.tid] = 0;
    LAS float* ST = (LAS float*)(C.lds + RT_ST);
#define RT_LOADROWS(tile_) do { _Pragma("unroll") for (int rr = 0; rr < 2; ++rr) { const float* xr = xin + (size_t)((tile_) * 16 + 2 * w + rr) * 1024; \
        _Pragma("unroll") for (int j = 0; j < 4; ++j) __builtin_amdgcn_global_load_lds((const unsigned*)(xr + 256 * j + 4 * lane), (LAS unsigned*)(ST + (2 * w + rr) * 1024 + 256 * j), 16, 0, 0); } } while (0)
    RT_LOADROWS(tbeg);
    int plr[2] = {0, 0}, ptok[2] = {-1, -1}, phf = 0;
    int qlr[2] = {0, 0}, qtok[2] = {-1, -1}, qhf = 0;
    int gbv = 0, npend = 0, it = 0, bcur = -1;
    for (int tile = tbeg; tile < tend; ++tile) {
        const int t0 = tile * 16, hf = t0 >= HALF_T ? 1 : 0;
        if ((t0 >> 12) != bcur) { bcur = t0 >> 12; const float* m = mod + (size_t)(li * 8 + bcur) * 6144;
            __syncthreads();
            for (int i = C.tid; i < 1024; i += 512) { MS[i] = m[4096 + i] + 1.0f; MS[1024 + i] = m[3072 + i]; }
            __syncthreads(); }
        TACC_B(C, 1);
        f32x4 v[2][4];
        asm volatile("s_waitcnt vmcnt(0)" ::: "memory");
#pragma unroll
        for (int rr = 0; rr < 2; ++rr)
#pragma unroll
            for (int j = 0; j < 4; ++j) v[rr][j] = *(const LAS f32x4*)(ST + (2 * w + rr) * 1024 + 256 * j + 4 * lane);
        LDS_WAIT();
        if (tile + 1 < tend) RT_LOADROWS(tile + 1);
        float ss[2];
#pragma unroll
        for (int rr = 0; rr < 2; ++rr) { float s = 0.f;
#pragma unroll
            for (int j = 0; j < 4; ++j) s += (v[rr][j].x * v[rr][j].x + v[rr][j].y * v[rr][j].y) + (v[rr][j].z * v[rr][j].z + v[rr][j].w * v[rr][j].w);
            ss[rr] = s; }
#pragma unroll
        for (int o = 1; o < 64; o <<= 1) {
#pragma unroll
            for (int rr = 0; rr < 2; ++rr) ss[rr] += __shfl_xor(ss[rr], o); }
#pragma unroll
        for (int j = 0; j < 4; ++j) { const f32x4 a = *(const LAS f32x4*)(MS + 256 * j + 4 * lane), b = *(const LAS f32x4*)(MS + 1024 + 256 * j + 4 * lane);
#pragma unroll
            for (int rr = 0; rr < 2; ++rr) { const int i = 2 * w + rr; const float rstd = 1.0f / sqrtf(ss[rr] * (1.0f / 1024.0f) + EPS);
                const f32x4 y = v[rr][j] * rstd * a + b; u32x2 o; o.x = pk2(y.x, y.y); o.y = pk2(y.z, y.w);
                *(u32x2*)(H + (size_t)(t0 + i) * 1024 + 256 * j + 4 * lane) = o; *(LAS u32x2*)(XH + i * 1032 + 256 * j + 4 * lane) = o;
                u32x2 lo; lo.x = pk2(y.x - bflo(o.x), y.y - bfhi(o.x)); lo.y = pk2(y.z - bflo(o.y), y.w - bfhi(o.y)); *(LAS u32x2*)(XL + i * 1032 + 256 * j + 4 * lane) = lo; } }
        TACC_E(C, 1); TACC_B(C, 4);
        LBAR();
        TACC_E(C, 4); TACC_B(C, 2);
        if (npend == 2) {
#pragma unroll
            for (int rr = 0; rr < 2; ++rr) if (qtok[rr] >= 0) TOK[(size_t)(qhf * 64 + lane) * MOE_CAP + gbase[(it & 1) * 64 + lane] + qlr[rr]] = qtok[rr]; }
        { f32x4 acc0 = {0.f, 0.f, 0.f, 0.f}, acc1 = {0.f, 0.f, 0.f, 0.f}, acc2 = {0.f, 0.f, 0.f, 0.f};
#pragma unroll
          for (int ks = 0; ks < 16; ++ks) { const int ko = fi * 1032 + kh * 512 + ks * 32 + 8 * fk; const bf16x8 ah = *(const LAS bf16x8*)(XH + ko), al = *(const LAS bf16x8*)(XL + ko);
              acc0 = __builtin_amdgcn_mfma_f32_16x16x32_bf16(ah, bh[ks], acc0, 0, 0, 0); acc1 = __builtin_amdgcn_mfma_f32_16x16x32_bf16(ah, bl[ks], acc1, 0, 0, 0); acc2 = __builtin_amdgcn_mfma_f32_16x16x32_bf16(al, bh[ks], acc2, 0, 0, 0);
              if ((ks & 3) == 3) asm volatile("" ::: "memory"); }
          const f32x4 acc = acc0 + (acc1 + acc2);
#pragma unroll
          for (int r = 0; r < 4; ++r) LG[(kh * 16 + 4 * fk + r) * 64 + eq * 16 + fi] = acc[r]; }
        TACC_E(C, 2); TACC_B(C, 4);
        LBAR();
        TACC_E(C, 4); TACC_B(C, 3);
        if (npend >= 1) { if (C.tid < 64) gbase[((it - 1) & 1) * 64 + C.tid] = gbv;
#pragma unroll
            for (int rr = 0; rr < 2; ++rr) { qlr[rr] = plr[rr]; qtok[rr] = ptok[rr]; } qhf = phf; }
        float sc[2], wsum[2]; int rank[2];
#pragma unroll
        for (int rr = 0; rr < 2; ++rr) { const int i = 2 * w + rr; sc[rr] = sigmf(LG[i * 64 + lane] + LG[(16 + i) * 64 + lane]);
            const unsigned key = (__builtin_bit_cast(unsigned, sc[rr] + rb + 1.0f) & ~63u) | (unsigned)(63 - lane);
            unsigned thr = 0u;
#pragma unroll
            for (int bit = 31; bit >= 0; --bit) { const unsigned cand = thr | (1u << bit); if (__popcll(__ballot(key >= cand)) >= TOPK) thr = cand; }
            unsigned long long selm = __ballot(key >= thr); int rk = 0; float ws = 0.f;
#pragma unroll
            for (int k = 0; k < TOPK; ++k) { const int jl = __ffsll((long long)selm) - 1; selm &= selm - 1;
                const unsigned kj = (unsigned)__builtin_amdgcn_readlane((int)key, jl); ws += __builtin_bit_cast(float, __builtin_amdgcn_readlane(__builtin_bit_cast(int, sc[rr]), jl)); rk += (kj > key) ? 1 : 0; }
            rank[rr] = (key >= thr) ? rk : 64; wsum[rr] = ws; }
#pragma unroll
        for (int rr = 0; rr < 2; ++rr) { const int i = 2 * w + rr; ptok[rr] = -1;
            if (rank[rr] < TOPK) { TOPW[(size_t)(t0 + i) * 8 + rank[rr]] = sc[rr] / wsum[rr] * 2.5f; ptok[rr] = (t0 + i) * 8 + rank[rr];
                plr[rr] = __hip_atomic_fetch_add(&lcnt[lane], 1, __ATOMIC_RELAXED, __HIP_MEMORY_SCOPE_WORKGROUP); } }
        phf = hf; npend = npend < 2 ? npend + 1 : 2;
        TACC_E(C, 3); TACC_B(C, 4);
        LBAR();
        TACC_E(C, 4);
        if (C.tid < 64) { const int n = lcnt[C.tid]; lcnt[C.tid] = 0; gbv = n > 0 ? (int)__hip_atomic_fetch_add(gcnt + (hf * 64 + C.tid) * 16, (unsigned)n, RLX_AGENT) : 0; }
        ++it;
    }
    __syncthreads();
    if (npend == 2) {
#pragma unroll
        for (int rr = 0; rr < 2; ++rr) if (qtok[rr] >= 0) TOK[(size_t)(qhf * 64 + lane) * MOE_CAP + gbase[(it & 1) * 64 + lane] + qlr[rr]] = qtok[rr]; }
    if (npend >= 1 && C.tid < 64) gbase[((it - 1) & 1) * 64 + C.tid] = gbv;
    __syncthreads();
    if (npend >= 1) {
#pragma unroll
        for (int rr = 0; rr < 2; ++rr) if (ptok[rr] >= 0) TOK[(size_t)(phf * 64 + lane) * MOE_CAP + gbase[((it - 1) & 1) * 64 + lane] + plr[rr]] = ptok[rr]; }
    __syncthreads();
#undef RT_LOADROWS
}

__device__ __forceinline__ int moe_tables(const Ctx& C, const Params& P, int li) {
    LAS int* blkstart = (LAS int*)(C.lds + LC_BLKSTART); LAS int* cnt = (LAS int*)(C.lds + LC_CNT); LAS unsigned short* blk2he = (LAS unsigned short*)(C.lds + LC_BLK2HE);
    const unsigned* gcnt = (const unsigned*)(P.ws + WS_CTL) + CW_CNT + (li * 2) * 64 * 16;
    __syncthreads();
    if (C.tid < 128) { int n = (int)__hip_atomic_load(gcnt + C.tid * 16, RLX_AGENT); n = n < 0 ? 0 : (n > MOE_CAP ? MOE_CAP : n); cnt[C.tid] = n; }
    __syncthreads();
    if (C.tid == 0) { int s = 0; for (int i = 0; i < 128; ++i) { blkstart[i] = s; s += (cnt[i] + 255) >> 8; } blkstart[128] = s; }
    __syncthreads();
    const int nblk = blkstart[128];
    if (C.tid < 128) { const int b0 = blkstart[C.tid], b1 = blkstart[C.tid + 1]; for (int b = b0; b < b1 && b < MAXBLK; ++b) blk2he[b] = (unsigned short)C.tid; }
    __syncthreads();
    return nblk < MAXBLK ? nblk : MAXBLK;
}
struct SchedMoE1 {
    const char* H; const char* W1; const int* TOK; const LAS int* blkstart; const LAS unsigned short* blk2he; int nblk, G, c;
    __device__ __forceinline__ bool next(int i, Unit& u) const { int L = i * G + c;
        if (L < 2 * nblk) { const int blk = L >> 1, pn = L & 1, he = blk2he[blk], bi = blk - blkstart[he], e = he & 63; u.A = H; u.rows = TOK + (size_t)he * MOE_CAP + bi * 256;
            u.B = W1 + ((size_t)e * 512 + pn * 256) * 2048; u.pm = blk; u.pn = pn; u.z = 0; return true; }
        L -= 2 * nblk; if (L >= 256) return false; u.pm = L >> 1; u.pn = L & 1; u.z = 1; u.A = H + (size_t)u.pm * 256 * 2048; u.rows = nullptr; u.B = W1 + ((size_t)64 * 512 + u.pn * 256) * 2048; return true; }
};
struct EpiMoE1 {
    static constexpr bool PERM = true; bf16* HID; bf16* HIDS;
    __device__ __forceinline__ void operator()(EPI_ARGS) const { bf16* O = u.z ? HIDS : HID;
#pragma unroll
        for (int ai = 0; ai < 2; ++ai)
#pragma unroll
            for (int m = 0; m < 4; ++m) { const size_t row = (size_t)u.pm * 256 + ai * 128 + wr * 64 + m * 16 + fr; f32x4 v0, v1;
#pragma unroll
                for (int j = 0; j < 4; ++j) { v0[j] = siluf(acc[ai][0][m][0][j]) * acc[ai][1][m][0][j]; v1[j] = siluf(acc[ai][0][m][1][j]) * acc[ai][1][m][1][j]; }
                *(u32x4*)(O + row * 256 + u.pn * 128 + wc * 32 + 8 * fq) = pack8(v0, v1); }
    }
};
struct SchedMoE2 {
    const char* HID; const char* W2; const LAS unsigned short* blk2he; int b0, b1, G, c;
    __device__ __forceinline__ bool next(int i, Unit& u) const { const int L = i * G + c; if (L >= (b1 - b0) * 4) return false; const int blk = b0 + (L >> 2), pn = L & 3, he = blk2he[blk], e = he & 63;
        u.A = HID + (size_t)blk * 256 * 512; u.rows = nullptr; u.B = W2 + ((size_t)e * 1024 + pn * 256) * 512; u.pm = blk; u.pn = pn; u.z = he; return true; }
};
struct EpiMoE2 {
    static constexpr bool PERM = true; bf16* YBUF; const int* TOK; const LAS int* blkstart; const LAS int* cnt; int hf;
    __device__ __forceinline__ void operator()(EPI_ARGS) const { const int he = u.z, bi = u.pm - blkstart[he], n = cnt[he]; const bool odd = fr & 1;
        int tvE[2][4], tvO[2][4];
#pragma unroll
        for (int ai = 0; ai < 2; ++ai)
#pragma unroll
            for (int m = 0; m < 4; ++m) { const int r0 = bi * 256 + ai * 128 + wr * 64 + m * 16 + (fr & ~1); tvE[ai][m] = TOK[(size_t)he * MOE_CAP + r0]; tvO[ai][m] = TOK[(size_t)he * MOE_CAP + r0 + 1]; }
#pragma unroll
        for (int ai = 0; ai < 2; ++ai)
#pragma unroll
            for (int m = 0; m < 4; ++m) { const int r0 = bi * 256 + ai * 128 + wr * 64 + m * 16 + (fr & ~1);
                u32x4 A, B; widen_pair(pack8(acc[ai][0][m][0], acc[ai][0][m][1]), pack8(acc[ai][1][m][0], acc[ai][1][m][1]), odd, A, B);
                const int coff = u.pn * 256 + wc * 64 + (odd ? 32 : 0) + 8 * fq;
                if (r0 < n) { const int v = tvE[ai][m]; *(u32x4*)(YBUF + ((size_t)((v >> 3) - hf * HALF_T) * 6 + (v & 7)) * 1024 + coff) = A; }
                if (r0 + 1 < n) { const int v = tvO[ai][m]; *(u32x4*)(YBUF + ((size_t)((v >> 3) - hf * HALF_T) * 6 + (v & 7)) * 1024 + coff) = B; } }
    }
};
struct EpiNull {
    static constexpr bool PERM = true;
    __device__ __forceinline__ void operator()(EPI_ARGS) const {
#pragma unroll
        for (int ai = 0; ai < 2; ++ai)
#pragma unroll
            for (int m = 0; m < 4; ++m)
#pragma unroll
                for (int bj = 0; bj < 2; ++bj) { asm volatile("" :: "v"(acc[ai][bj][m][0]), "v"(acc[ai][bj][m][1])); }
    }
};
struct EpiCombine {
    static constexpr bool PERM = true; const bf16* YBUF; const float* TOPW; float* X; const float* gate; int hf; float* XO;
    __device__ __forceinline__ void operator()(EPI_ARGS) const {
#pragma unroll
        for (int ai = 0; ai < 2; ++ai)
#pragma unroll
            for (int m = 0; m < 4; ++m) { const int th = u.pm * 256 + ai * 128 + wr * 64 + m * 16 + fr, token = hf * HALF_T + th;
                const f32x4 w03 = *(const f32x4*)(TOPW + (size_t)token * 8), w47 = *(const f32x4*)(TOPW + (size_t)token * 8 + 4); const float wk[6] = {w03.x, w03.y, w03.z, w03.w, w47.x, w47.y};
#pragma unroll
                for (int bj = 0; bj < 2; ++bj) { const int col0 = u.pn * 256 + wc * 64 + bj * 32 + 8 * fq; f32x4 v0 = acc[ai][bj][m][0], v1 = acc[ai][bj][m][1];
#pragma unroll
                    for (int k = 0; k < 6; ++k) { const u32x4 y = *(const u32x4*)(YBUF + ((size_t)th * 6 + k) * 1024 + col0);
                        v0[0] += wk[k] * bflo(y.x); v0[1] += wk[k] * bfhi(y.x); v0[2] += wk[k] * bflo(y.y); v0[3] += wk[k] * bfhi(y.y);
                        v1[0] += wk[k] * bflo(y.z); v1[1] += wk[k] * bfhi(y.z); v1[2] += wk[k] * bflo(y.w); v1[3] += wk[k] * bfhi(y.w); }
                    const float* gp = gate + (size_t)(token >> 12) * 6144 + col0; float* xp = X + (size_t)token * 1024 + col0;
                    const f32x4 g0 = *(const f32x4*)gp, g1 = *(const f32x4*)(gp + 4), x0 = *(const f32x4*)xp, x1 = *(const f32x4*)(xp + 4);
                    float* xo = XO + (size_t)token * 1024 + col0; *(f32x4*)xo = x0 + g0 * v0; *(f32x4*)(xo + 4) = x1 + g1 * v1; } }
    }
};

__device__ __forceinline__ void ph_hy_prep(const Ctx& C, const Params& P) {
    const bf16* PP = (const bf16*)(P.ws + AR_P); bf16* X0 = (bf16*)(P.ws + AR_X0); bf16* ZT = (bf16*)(P.ws + AR_ZT);
    LAS bf16* ZS = (LAS bf16*)(C.lds + RING_OFF);
    const int tl = C.tid >> 3, d8 = (C.tid & 7) * 8;
    if (C.G % 16 != 0) return;
    const int dt = C.bid & 15, d0 = dt * 64, nwg = C.G >> 4;
    float cw[3][3][8], cb[3][8];
#pragma unroll
    for (int sec = 0; sec < 3; ++sec) {
#pragma unroll
        for (int e = 0; e < 8; ++e) { cb[sec][e] = P.hy_conv_b[sec * 1024 + d0 + d8 + e];
#pragma unroll
            for (int j = 0; j < 3; ++j) cw[sec][j][e] = P.hy_conv_w[j * 3072 + sec * 1024 + d0 + d8 + e]; } }
    u32x4 g[3][3];
#define HP_LOAD(step_) do { const int it_ = (step_) >> 1, b_ = 2 * (it_ >> 6) + ((step_) & 1), t_ = (it_ & 63) * 64 + tl; \
        _Pragma("unroll") for (int j = 0; j < 3; ++j) { const int tt = t_ - 1 + j; const bool ok = tt >= 0 && tt < SEQ; const size_t r_ = (size_t)b_ * SEQ + (ok ? tt : t_); \
            _Pragma("unroll") for (int sec = 0; sec < 3; ++sec) { g[sec][j] = *(const u32x4*)(PP + r_ * 3072 + sec * 1024 + d0 + d8); if (!ok) g[sec][j] = (u32x4){0u, 0u, 0u, 0u}; } } } while (0)
    constexpr int NSTEP = 2 * 4 * 64;
    int step = 2 * (C.bid >> 4), par = 0;
    if (step < NSTEP) HP_LOAD(step);
    for (; step < NSTEP; ) {
        const int it = step >> 1, q = step & 1, bp = it >> 6, b = 2 * bp + q, t0 = (it & 63) * 64, t = t0 + tl; const size_t row = (size_t)b * SEQ + t;
        float o[3][8];
#pragma unroll
        for (int sec = 0; sec < 3; ++sec) {
#pragma unroll
            for (int e = 0; e < 8; ++e) o[sec][e] = cb[sec][e];
#pragma unroll
            for (int j = 0; j < 3; ++j) { const u32x4 w = g[sec][j];
                o[sec][0] += bflo(w.x) * cw[sec][j][0]; o[sec][1] += bfhi(w.x) * cw[sec][j][1]; o[sec][2] += bflo(w.y) * cw[sec][j][2]; o[sec][3] += bfhi(w.y) * cw[sec][j][3];
                o[sec][4] += bflo(w.z) * cw[sec][j][4]; o[sec][5] += bfhi(w.z) * cw[sec][j][5]; o[sec][6] += bflo(w.w) * cw[sec][j][6]; o[sec][7] += bfhi(w.w) * cw[sec][j][7]; } }
        const int nstep = q == 0 ? step + 1 : step + 2 * nwg - 1;
        if (nstep < NSTEP) HP_LOAD(nstep);
        { u32x4 w; w.x = pk2(o[0][0], o[0][1]); w.y = pk2(o[0][2], o[0][3]); w.z = pk2(o[0][4], o[0][5]); w.w = pk2(o[0][6], o[0][7]); *(u32x4*)(X0 + row * 1024 + d0 + d8) = w; }
        LAS bf16* zs = ZS + par * (64 * 136);
#pragma unroll
        for (int e = 0; e < 8; ++e) zs[(d8 + e) * 136 + tl * 2 + q] = (bf16)f2bf(o[2][e] * o[1][e]);
        if (q == 1) {
            LBAR();
            { const int dl = C.tid >> 3, tp = (C.tid & 7) * 8; const u32x4 w0 = *(const LAS u32x4*)(zs + dl * 136 + tp * 2), w1 = *(const LAS u32x4*)(zs + dl * 136 + tp * 2 + 8);
              bf16* zo = ZT + (((size_t)(d0 + dl) * 4 + bp) * SEQ + t0 + tp) * 2; *(u32x4*)zo = w0; *(u32x4*)(zo + 8) = w1; }
            par ^= 1;
        }
        step = nstep;
    }
#undef HP_LOAD
    __syncthreads();
}

__device__ __forceinline__ f32x2 cmul(f32x2 a, f32x2 b) { return (f32x2){a.x * b.x - a.y * b.y, a.x * b.y + a.y * b.x}; }
__device__ __forceinline__ f32x2 cmulc(f32x2 a, f32x2 b) { return (f32x2){a.x * b.x + a.y * b.y, a.y * b.x - a.x * b.y}; }
template <bool INV> __device__ __forceinline__ void dft16(f32x2 (&v)[16]) {
    constexpr float WC[10] = {1.f, 0.9238795325112867f, 0.7071067811865476f, 0.3826834323650898f, 0.f, 0.f, -0.7071067811865476f, 0.f, 0.f, -0.9238795325112867f};
    constexpr float WS_[10] = {0.f, 0.3826834323650898f, 0.7071067811865476f, 0.9238795325112867f, 1.f, 0.f, 0.7071067811865476f, 0.f, 0.f, -0.3826834323650898f};
    f32x2 t[16];
#pragma unroll
    for (int b = 0; b < 4; ++b) { const f32x2 x0 = v[b], x1 = v[4 + b], x2 = v[8 + b], x3 = v[12 + b];
        const f32x2 s0 = x0 + x2, s1 = x0 - x2, s2 = x1 + x3, s3 = x1 - x3; const f32x2 is3 = (f32x2){-s3.y, s3.x};
        t[0 * 4 + b] = s0 + s2; t[2 * 4 + b] = s0 - s2; t[1 * 4 + b] = INV ? s1 + is3 : s1 - is3; t[3 * 4 + b] = INV ? s1 - is3 : s1 + is3; }
#pragma unroll
    for (int c = 1; c < 4; ++c)
#pragma unroll
        for (int b = 1; b < 4; ++b) { const int mm = b * c; const f32x2 w = (f32x2){WC[mm], WS_[mm]}; t[c * 4 + b] = INV ? cmul(t[c * 4 + b], w) : cmulc(t[c * 4 + b], w); }
#pragma unroll
    for (int c = 0; c < 4; ++c) { const f32x2 x0 = t[c * 4], x1 = t[c * 4 + 1], x2 = t[c * 4 + 2], x3 = t[c * 4 + 3];
        const f32x2 s0 = x0 + x2, s1 = x0 - x2, s2 = x1 + x3, s3 = x1 - x3; const f32x2 is3 = (f32x2){-s3.y, s3.x};
        v[c] = s0 + s2; v[c + 8] = s0 - s2; v[c + 4] = INV ? s1 + is3 : s1 - is3; v[c + 12] = INV ? s1 - is3 : s1 + is3; }
}
constexpr int FF_TW = RING_OFF, FF_TW2 = FF_TW + 32768, FF_DE = FF_TW2 + 32768, FF_DO = FF_DE + 4352 * 8, FF_RED = FF_DO + 4352 * 8, FF_ZST = FF_RED + 64  , FF_END = FF_ZST + 16384;
static_assert(FF_END <= LDS_BYTES, "FFT LDS");
__device__ __forceinline__ int pidx(int i) { return i + (i >> 4); }
__device__ __forceinline__ void fft_fwd(LAS f32x2* D, const LAS f32x2* TW, int t8, f32x2 (&v)[16]) {
#pragma unroll
    for (int a = 0; a < 16; ++a) v[a] = D[pidx(256 * a + t8)];
    dft16<false>(v);
    { const int n1 = t8 >> 4;
#pragma unroll
      for (int k0 = 0; k0 < 16; ++k0) D[pidx(256 * k0 + t8)] = cmul(v[k0], TW[(16 * n1 * k0) & 4095]); }
    LBAR();
    { const int k0 = t8 >> 4, n0 = t8 & 15;
#pragma unroll
      for (int a = 0; a < 16; ++a) v[a] = D[pidx(256 * k0 + 16 * a + n0)];
      dft16<false>(v);
#pragma unroll
      for (int k1 = 0; k1 < 16; ++k1) D[pidx(256 * k0 + 16 * k1 + n0)] = cmul(v[k1], TW[(n0 * (k0 + 16 * k1)) & 4095]); }
    LBAR();
#pragma unroll
    for (int a = 0; a < 16; ++a) v[a] = D[pidx(16 * t8 + a)];
    dft16<false>(v);
}
__device__ __forceinline__ void fft_inv(LAS f32x2* D, const LAS f32x2* TW, int t8, f32x2 (&v)[16]) {
    dft16<true>(v);
    { const int kk = t8;
      const int kq = (kk >> 4) + 16 * (kk & 15);
#pragma unroll
      for (int n0 = 0; n0 < 16; ++n0) D[pidx(16 * t8 + n0)] = cmulc(v[n0], TW[(n0 * kq) & 4095]); }
    LBAR();
    { const int k0 = t8 >> 4, n0 = t8 & 15;
#pragma unroll
      for (int a = 0; a < 16; ++a) v[a] = D[pidx(256 * k0 + 16 * a + n0)];
      dft16<true>(v);
#pragma unroll
      for (int n1 = 0; n1 < 16; ++n1) D[pidx(256 * k0 + 16 * n1 + n0)] = cmulc(v[n1], TW[(16 * n1 * k0) & 4095]); }
    LBAR();
#pragma unroll
    for (int a = 0; a < 16; ++a) v[a] = D[pidx(256 * a + t8)];
    dft16<true>(v);
#pragma unroll
    for (int a = 0; a < 16; ++a) D[pidx(256 * a + t8)] = v[a];
    LBAR();
}
__device__ __forceinline__ void ph_hy_fft(const Ctx& C, const Params& P) {
    LAS f32x2* TW = (LAS f32x2*)(C.lds + FF_TW); LAS f32x2* TW2 = (LAS f32x2*)(C.lds + FF_TW2); LAS f32x2* DE = (LAS f32x2*)(C.lds + FF_DE); LAS f32x2* DO = (LAS f32x2*)(C.lds + FF_DO); LAS float* RED = (LAS float*)(C.lds + FF_RED);
    const float* HFT = (const float*)(P.ws + WS_HFT); const unsigned* ZT2 = (const unsigned*)(P.ws + AR_ZT); unsigned* YT2 = (unsigned*)(P.ws + AR_YT);
    const int br = C.tid >> 8, t8 = C.tid & 255; LAS f32x2* D = br ? DO : DE;
    LAS unsigned* ZST = (LAS unsigned*)(C.lds + FF_ZST);
#define FF_DMA(bp_) do { _Pragma("unroll") for (int q_ = 0; q_ < 2; ++q_) __builtin_amdgcn_global_load_lds(ZT2 + ((size_t)d * 4 + (bp_)) * SEQ + (C.wave * 2 + q_) * 256 + C.lane * 4, ZST + (C.wave * 2 + q_) * 256, 16, 0, 0); } while (0)
    for (int i = C.tid; i < 4096; i += 512) { float s, c; sincosf(6.283185307179586f * (float)i / 4096.0f, &s, &c); TW[i] = (f32x2){c, -s}; sincosf(6.283185307179586f * (float)i / 8192.0f, &s, &c); TW2[i] = (f32x2){c, -s}; }
    __syncthreads();
    for (int d = C.bid; d < 1024; d += C.G) {
        const float* hf = HFT + (size_t)d * 2 * 4096; const float* hb = hf + 4096;
        FF_DMA(0);
        float ss = 0.f;
#pragma unroll
        for (int a = 0; a < 16; ++a) { const int n = 256 * a + t8; const float f = hf[n], g = hb[n == 0 ? 0 : 4096 - n]; ss += f * f + g * g;
            D[pidx(n)] = br == 0 ? (f32x2){f + g, 0.f} : (n == 0 ? (f32x2){f + g, 0.f} : (f32x2){(f - g) * TW2[n].x, (f - g) * TW2[n].y}); }
        ss = wave_sum(ss); if (C.lane == 0) RED[C.wave] = ss;
        __syncthreads();
        const float scale = 1.0f / sqrtf(RED[0] + RED[1] + RED[2] + RED[3] + EPS);
        f32x2 v[16]; const float bias = P.hy_bias[d];
        fft_fwd(D, TW, t8, v);
        f32x2* HSP = (f32x2*)(P.ws + AR_HSP) + (size_t)C.bid * 8192 + br * 4096 + t8;
#pragma unroll
        for (int a = 0; a < 16; ++a) { f32x2 hv = v[a] * scale; hv.x += bias; HSP[a * 256] = hv; }
        for (int bp = 0; bp < 4; ++bp) {
            __syncthreads();
#pragma unroll
            for (int a = 0; a < 16; ++a) { const int n = 256 * a + t8; const unsigned zw = ZST[n]; const f32x2 zc = (f32x2){bflo(zw), bfhi(zw)}; D[pidx(n)] = br == 0 ? zc : cmul(zc, TW2[n]); }
            LBAR();
            if (bp < 3) FF_DMA(bp + 1);
            fft_fwd(D, TW, t8, v);
#pragma unroll
            for (int a = 0; a < 16; ++a) v[a] = cmul(v[a], HSP[a * 256]);
            fft_inv(D, TW, t8, v);
            unsigned* yo = YT2 + ((size_t)d * 4 + bp) * SEQ;
#pragma unroll
            for (int j = 0; j < 8; ++j) { const int n = C.tid + 512 * j; const f32x2 ye = DE[pidx(n)], yo2 = DO[pidx(n)]; const f32x2 y = (ye + cmulc(yo2, TW2[n])) * (1.0f / 8192.0f);
                yo[n] = pk2(y.x, y.y); }
        }
        __syncthreads();
    }
#undef FF_DMA
}
__device__ __forceinline__ void ph_hy_gate(const Ctx& C, const Params& P) {
    const bf16* X0 = (const bf16*)(P.ws + AR_X0); const bf16* YT = (const bf16*)(P.ws + AR_YT); bf16* AO = (bf16*)(P.ws + WS_H);
    LAS bf16* TS = (LAS bf16*)(C.lds + RING_OFF);
    const int dl = C.tid >> 3, tp = (C.tid & 7) * 8;
    const int tl = C.tid >> 3, d8 = (C.tid & 7) * 8;
    constexpr int NIT = 4 * 64 * 16;
    u32x4 gy0, gy1, gx0, gx1;
#define HG_LOAD(item_) do { const int dt_ = (item_) & 15, it_ = (item_) >> 4, bp_ = it_ >> 6, t0_ = (it_ & 63) * 64, d0_ = dt_ * 64; \
        const bf16* yp_ = YT + (((size_t)(d0_ + dl) * 4 + bp_) * SEQ + t0_ + tp) * 2; gy0 = *(const u32x4*)yp_; gy1 = *(const u32x4*)(yp_ + 8); \
        gx0 = *(const u32x4*)(X0 + ((size_t)(2 * bp_) * SEQ + t0_ + tl) * 1024 + d0_ + d8); gx1 = *(const u32x4*)(X0 + ((size_t)(2 * bp_ + 1) * SEQ + t0_ + tl) * 1024 + d0_ + d8); } while (0)
    int item = C.bid, par = 0;
    if (item < NIT) HG_LOAD(item);
    for (; item < NIT; item += C.G) {
        const int dt = item & 15, it = item >> 4, bp = it >> 6, t0 = (it & 63) * 64, d0 = dt * 64;
        LAS bf16* ts = TS + par * (2 * 64 * 72);
        { const unsigned w[8] = {gy0.x, gy0.y, gy0.z, gy0.w, gy1.x, gy1.y, gy1.z, gy1.w};
#pragma unroll
          for (int e = 0; e < 8; ++e) { ts[(tp + e) * 72 + dl] = (bf16)(w[e] & 0xffff); ts[64 * 72 + (tp + e) * 72 + dl] = (bf16)(w[e] >> 16); } }
        const u32x4 x0 = gx0, x1 = gx1;
        if (item + C.G < NIT) HG_LOAD(item + C.G);
        LBAR();
#pragma unroll
        for (int q = 0; q < 2; ++q) { const u32x4 x = q ? x1 : x0; const size_t o = ((size_t)(2 * bp + q) * SEQ + t0 + tl) * 1024 + d0 + d8; const u32x4 y = *(const LAS u32x4*)(ts + q * 64 * 72 + tl * 72 + d8);
          u32x4 w; w.x = pk2(bflo(x.x) * bflo(y.x), bfhi(x.x) * bfhi(y.x)); w.y = pk2(bflo(x.y) * bflo(y.y), bfhi(x.y) * bfhi(y.y)); w.z = pk2(bflo(x.z) * bflo(y.z), bfhi(x.z) * bfhi(y.z)); w.w = pk2(bflo(x.w) * bflo(y.w), bfhi(x.w) * bfhi(y.w));
          *(u32x4*)(AO + o) = w; }
        par ^= 1;
    }
#undef HG_LOAD
    __syncthreads();
}
struct EpiStoreBf16 {
    static constexpr bool PERM = true; bf16* O; int ldc;
    __device__ __forceinline__ void operator()(EPI_ARGS) const { const bool odd = fr & 1;
#pragma unroll
        for (int ai = 0; ai < 2; ++ai)
#pragma unroll
            for (int m = 0; m < 4; ++m) { const size_t rowE = (size_t)u.pm * 256 + ai * 128 + wr * 64 + m * 16 + (fr & ~1); u32x4 A, B; widen_pair(pack8(acc[ai][0][m][0], acc[ai][0][m][1]), pack8(acc[ai][1][m][0], acc[ai][1][m][1]), odd, A, B);
                bf16* op = O + rowE * ldc + u.pn * 256 + wc * 64 + (odd ? 32 : 0) + 8 * fq; *(u32x4*)op = A; *(u32x4*)(op + ldc) = B; }
    }
};

__global__ void __launch_bounds__(512, 2) fwd_kernel(Params P) {
    extern __shared__ __attribute__((aligned(16))) unsigned char lds_raw[];
    Ctx C; C.tacc = 0; C.tbeg = 0; C.lds = (LAS unsigned char*)lds_raw; C.tid = threadIdx.x; C.lane = C.tid & 63; C.wave = __builtin_amdgcn_readfirstlane(C.tid >> 6); C.G = gridDim.x; C.bid = blockIdx.x;
    const int vcu = (C.G % 8 == 0) ? (C.bid % 8) * (C.G / 8) + C.bid / 8 : C.bid;
    for (int i = C.tid; i < LDS_CTL_BYTES / 4; i += 512) ((LAS unsigned*)C.lds)[i] = 0u;
    __syncthreads();
    unsigned char* ws = P.ws;
#if N_LAUNCH_MODE == 1
    XcdBarrier bar = xcd_barrier_post((unsigned*)(ws + WS_CTL) + CW_BAR, (volatile LAS unsigned*)(C.lds + 32));
#define SEAM(k) do { if (IN(k) && IN((k) + 1)) xcd_barrier(bar); EVT((k) + 1); } while (0)
#else
#define SEAM(k) do { EVT((k) + 1); } while (0)
#endif
#ifndef DUP_ID
#define DUP_ID -1
#endif
#ifndef DUP_MASK
#define DUP_MASK 0u
#endif
#define DUP(id, ...) do { __VA_ARGS__; if (DUP_ID == (id) || ((DUP_MASK >> (id)) & 1u)) { __syncthreads(); __VA_ARGS__; } } while (0)
#define TS_AMP 8
    unsigned long long tsA = 0, tsB = 0;
#define EVT(id) do { if (TS_FROM == (id)) tsA = wall_clock64(); if (TS_TO == (id)) tsB = wall_clock64(); } while (0)
    EVT(0);
    const int lo = P.ph_lo, hi = P.ph_hi;
#ifndef PH_MASK
#define PH_MASK 0xffffffffu
#endif
#define IN(k) (((PH_MASK >> (k)) & 1u) && lo <= (k) && (k) < hi)
    LAS unsigned char* ring = C.lds + RING_OFF;
    const float* mod = (const float*)(ws + WS_MOD);

    if (IN(0)) { ph_mod(C, P); __syncthreads(); EVT(100); ph_conv_l0(C, P); __syncthreads(); ph_s5_tables(C, P, C.G - 1 - C.bid, C.G); } SEAM(0);
    if (IN(1)) { DUP(1, ph_norm(C, P, P.x, 0, 0, true)); } SEAM(1);
    if (IN(2)) { SchedDense S{(const char*)(ws + WS_H), (const char*)(ws + WS_WIN), 2048u, 2048u, TA / 256, 4, C.G, vcu}; EpiInProj E{(bf16*)(ws + AR_PROJ), (bf16*)(ws + AR_U)};
        pg8::gemm_phase(ring, 1024, 2048u, 2048u, S, E);
        const int nfree = C.G - (TA / 256 * 4 - 2 * C.G);
        if (C.G == 256 && vcu >= C.G - nfree) { const int r = vcu - (C.G - nfree); ph_conv_l0b(C, P, r * 8 + C.wave, nfree * 8); }
        else if (C.G != 256) { ph_conv_l0b(C, P, C.bid * 8 + C.wave, C.G * 8); } } SEAM(2);
    if (IN(3)) { ph_rownorm1(C, P); EVT(103);
        SchedBatched S{(const char*)(ws + AR_U), (const char*)(ws + WS_SOUT), 1536u, 1024u, (size_t)S5ROWS * 1536, (size_t)256 * 1024, S5G, 5, 1, C.G, vcu}; EpiF32Batched E{(float*)(ws + AR_SRAW), S5ROWS, 256};
        DUP(3, pg8::gemm_phase(ring, 512, 1536u, 1024u, S, E)); } SEAM(3);
    if (IN(4)) { SchedUp S{(const char*)(ws + AR_QN), (const char*)(ws + WS_WUQ), (const char*)(ws + AR_CKV), (const char*)(ws + WS_WUKV), C.G, vcu}; EpiUp E{(bf16*)(ws + AR_QRAW), (bf16*)(ws + AR_KVRAW)};
        DUP(4, pg8::gemm_phase(ring, 256, 512u, 512u, S, E); ph_s5_scan(C, P)); } SEAM(4);
    if (IN(5)) { ph_qkfinal(C, P); EVT(105);
        SchedBatched S{(const char*)(ws + AR_U), (const char*)(ws + WS_WG), 1536u, 1536u, (size_t)S5ROWS * 1536, (size_t)512 * 1536, S5G, 4, 2, C.G, vcu}; EpiS5C E{(bf16*)(ws + AR_Z)};
        DUP(5, pg8::gemm_phase(ring, 768, 1536u, 1536u, S, E)); } SEAM(5);
    if (IN(6)) { float gqm = 0.f, gkm = 0.f;
        for (int j = 0; j < QKH; ++j) { gqm = fmaxf(gqm, fabsf(P.q_qk[j])); gkm = fmaxf(gkm, fabsf(P.k_qk[j])); }
        const float sbound = 96.0f * gqm * gkm * (0.10206207261596577f * 1.4426950408889634f) * 1.02f;
        if (sbound < 90.0f) ph_attention<true>(C, P, vcu); else ph_attention<false>(C, P, vcu);
        EVT(106);
        SchedDense S{(const char*)(ws + AR_Z), (const char*)(ws + WS_WGLU), 1024u, 1024u, T / 256, 2, C.G, vcu}; EpiGlu E{(const bf16*)(ws + AR_Z), P.glu_b, (bf16*)(ws + AR_CAT)};
        DUP(26, pg8::gemm_phase(ring, 512, 1024u, 1024u, S, E)); } SEAM(6);
    if (IN(7)) { SchedDense S{(const char*)(ws + AR_CAT), (const char*)(ws + WS_WOUT), 2048u, 2048u, T / 256, 4, C.G, vcu}; EpiResid E{P.x, P.out, mod + 2048};
        pg8::gemm_phase(ring, 1024, 2048u, 2048u, S, E); } SEAM(7);
#define MOE_LAYER(li, pb) do { \
        if (IN(pb)) { ph_conv_moe(C, P, li); __syncthreads(); EVT(110 + li); ph_router(C, P, P.out, li, li); if ((DUP_MASK >> 27) & 1u) { __syncthreads(); ph_router(C, P, P.out, li, 2 + li); } } SEAM(pb); \
        if (IN(pb + 1)) { const int nblk = moe_tables(C, P, li); \
            SchedMoE1 S{(const char*)(ws + WS_H), (const char*)(ws + AR_W1), (const int*)(ws + WS_TOK), (const LAS int*)(C.lds + LC_BLKSTART), (const LAS unsigned short*)(C.lds + LC_BLK2HE), nblk, C.G, vcu}; \
            EpiMoE1 E{(bf16*)(ws + AR_HID), (bf16*)(ws + AR_HIDS)}; \
            DUP(pb + 1, pg8::gemm_phase(ring, 1024, 2048u, 2048u, S, E)); \
            if (TS_FROM == 210 && li == 0) { __syncthreads(); EVT(210); EpiNull EN{}; pg8::gemm_phase(ring, 1024, 2048u, 2048u, S, EN); EVT(211); } \
            if (TS_FROM == 212 && li == 0) { __syncthreads(); EVT(212); pg8::gemm_phase(ring, 1024, 2048u, 2048u, S, E); EVT(213); } \
            if (li == 0) {   \
                const int total = 2 * nblk + 256, rem = total % C.G, nshort = rem == 0 ? C.G : C.G - rem, r = rem == 0 ? vcu : vcu - rem; \
                if (r >= 0) { ph_hy_filter(C, P, r, nshort); ph_conv_l1(C, P, r * 8 + C.wave, nshort * 8); } } \
            } SEAM(pb + 1); \
        MOE_HALF(li, pb, 0); MOE_HALF(li, pb, 1); } while (0)
#define MOE_HALF(li, pb, hf) do { \
            if (IN(pb + 2 + 2 * hf)) { (void)moe_tables(C, P, li); const LAS int* bs = (const LAS int*)(C.lds + LC_BLKSTART); \
                SchedMoE2 S{(const char*)(ws + AR_HID), (const char*)(ws + AR_W2), (const LAS unsigned short*)(C.lds + LC_BLK2HE), bs[hf * 64], bs[hf * 64 + 64], C.G, vcu}; \
                EpiMoE2 E{(bf16*)(ws + AR_YBUF), (const int*)(ws + WS_TOK), bs, (const LAS int*)(C.lds + LC_CNT), hf}; \
                pg8::gemm_phase(ring, 256, 512u, 512u, S, E); } SEAM(pb + 2 + 2 * hf); \
            if (IN(pb + 3 + 2 * hf)) { SchedDense S{(const char*)(ws + AR_HIDS) + (size_t)hf * HALF_T * 512, (const char*)(ws + AR_W2) + (size_t)64 * 1024 * 512, 512u, 512u, HALF_T / 256, 4, C.G, vcu}; \
                EpiCombine E{(const bf16*)(ws + AR_YBUF), (const float*)(ws + WS_TOPW), P.out, mod + (size_t)li * 8 * 6144 + 5120, hf, P.out}; \
                pg8::gemm_phase(ring, 256, 512u, 512u, S, E); \
                } SEAM(pb + 3 + 2 * hf); } while (0)
    MOE_LAYER(0, 8);
    if (IN(14)) { ph_norm(C, P, P.out, 1, 0, false); } SEAM(14);
    if (IN(15)) { SchedDense S{(const char*)(ws + WS_H), (const char*)(ws + WS_WHIN), 2048u, 2048u, T / 256, 12, C.G, vcu}; EpiStoreBf16 E{(bf16*)(ws + AR_P), 3072};
        DUP(15, pg8::gemm_phase(ring, 1024, 2048u, 2048u, S, E)); } SEAM(15);
    if (IN(16)) { DUP(16, ph_hy_prep(C, P)); } SEAM(16);
    if (IN(17)) { DUP(17, ph_hy_fft(C, P)); } SEAM(17);
    if (IN(18)) { DUP(18, ph_hy_gate(C, P)); } SEAM(18);
    if (IN(19)) { SchedDense S{(const char*)(ws + WS_H), (const char*)(ws + WS_WHOUT), 2048u, 2048u, T / 256, 4, C.G, vcu}; EpiResid E{P.out, P.out, mod + (size_t)8 * 6144 + 2048};
        pg8::gemm_phase(ring, 1024, 2048u, 2048u, S, E); } SEAM(19);
    MOE_LAYER(1, 20);
    if ((TS_FROM >= 0 || TS_ACC >= 0) && C.bid == 0 && C.tid == 0) { const unsigned long long t0 = wall_clock64(), need = (TS_ACC >= 0 ? C.tacc : (tsB - tsA)) * TS_AMP; while (wall_clock64() - t0 < need) __builtin_amdgcn_s_sleep(8); }
#undef IN
#undef SEAM
}

extern "C" void kernel_launch(void* const* d_in, const int* in_sizes, int n_in, void* d_out, int out_size, void* d_ws, size_t ws_size, hipStream_t stream) {
    static int grid = 0;
    if (grid == 0) {
        if (n_in != 43 || out_size != T * DM || ws_size < WS_END) { fprintf(stderr, "kernel_launch: unexpected shapes (n_in %d, out %d, ws %zu, need %zu)\n", n_in, out_size, ws_size, (size_t)WS_END); grid = -1; return; }
        int dev = 0, cus = 0, per_cu = 0;
        if (hipGetDevice(&dev) != hipSuccess || hipDeviceGetAttribute(&cus, hipDeviceAttributeMultiprocessorCount, dev) != hipSuccess) { grid = -1; return; }
        if (hipFuncSetAttribute((const void*)fwd_kernel, hipFuncAttributeMaxDynamicSharedMemorySize, LDS_BYTES) != hipSuccess) { fprintf(stderr, "kernel_launch: hipFuncSetAttribute failed\n"); grid = -1; return; }
        if (hipOccupancyMaxActiveBlocksPerMultiprocessor(&per_cu, (const void*)fwd_kernel, 512, LDS_BYTES) != hipSuccess || per_cu < 1) fprintf(stderr, "kernel_launch: occupancy query says %d\n", per_cu);
        (void)hipGetLastError();
        grid = cus;
    }
    if (grid < 0) return;
    (void)hipMemsetAsync((char*)d_ws + WS_CTL, 0, CTL_ZERO_BYTES, stream);
    Params p{};
    const float** pp = (const float**)&p;
    for (int i = 0; i < 43; ++i) pp[i] = (const float*)d_in[i];
    p.out = (float*)d_out; p.ws = (unsigned char*)d_ws;
#if N_LAUNCH_MODE == 1
    p.ph_lo = 0; p.ph_hi = NPHASE;
    hipLaunchKernelGGL(fwd_kernel, dim3(grid), dim3(512), LDS_BYTES, stream, p);
#else
    static const int order[NPHASE] = {0, 1, 2, 3, 4, 5, 6, 7, 8, 9, 10, 11, 12, 13, 14, 15, 16, 17, 18, 19, 20, 21, 22, 23, 24, 25};
    for (int k = 0; k < NPHASE; ++k) { p.ph_lo = order[k]; p.ph_hi = order[k] + 1; hipLaunchKernelGGL(fwd_kernel, dim3(grid), dim3(512), LDS_BYTES, stream, p); }
#endif
}
```

```cpp
#include <hip/hip_runtime.h>
#include <cstdio>
#include <cstdint>
#include <cmath>

#define TS_FROM -1
#define TS_TO -1
#ifndef N_LAUNCH_MODE
#define N_LAUNCH_MODE 1
#endif

#define GAS __attribute__((address_space(1)))
#define LAS __attribute__((address_space(3)))
typedef unsigned short bf16;
typedef short bf16x8 __attribute__((ext_vector_type(8)));
typedef short s16x4 __attribute__((ext_vector_type(4)));
typedef float f32x4 __attribute__((ext_vector_type(4)));
typedef float f32x2 __attribute__((ext_vector_type(2)));
typedef float f32x16 __attribute__((ext_vector_type(16)));
typedef unsigned u32x4 __attribute__((ext_vector_type(4)));
typedef unsigned u32x2 __attribute__((ext_vector_type(2)));
typedef GAS unsigned gu32;
#define RLX_AGENT __ATOMIC_RELAXED, __HIP_MEMORY_SCOPE_AGENT
#define LDS_WAIT() asm volatile("s_waitcnt lgkmcnt(0)" ::: "memory")
#define VM_WAIT() asm volatile("s_waitcnt vmcnt(0)" ::: "memory")
#define LBAR() do { asm volatile("s_waitcnt lgkmcnt(0)" ::: "memory"); __builtin_amdgcn_s_barrier(); asm volatile("" ::: "memory"); } while (0)

constexpr int DM = 1024, NB = 8, SEQ = 4096, CTXL = 256, T = NB * SEQ  , TC = NB * CTXL  , TA = T + TC  ;
constexpr int NHEAD = 8, QKH = 96, VH = 64, QLORA = 256, KVLORA = 128, QKROPE = 32, QKNOPE = 64;
constexpr int S5W = 512, S5G = 32, S5H = 16, S5P = 64, S5TC = 32  , S5NCH = SEQ / S5TC  , S5NCC = CTXL / S5TC  ;
constexpr int S5ROWS = 1280  , S5K = 768  ;
constexpr int EVEN_IN = 928, UOFF = 416;
constexpr int NEXP = 64, TOPK = 6, EFF = 256;
constexpr float EPS = 1e-6f;
constexpr int HALF_T = T / 2;
constexpr int MOE_CAP = HALF_T;
constexpr int MAXBLK = 2 * ((HALF_T * TOPK) / 256 + NEXP);

__device__ __forceinline__ unsigned f2bf(float f) { unsigned u = __builtin_bit_cast(unsigned, f); return (u + 0x7fffu + ((u >> 16) & 1u)) >> 16; }
__device__ __forceinline__ unsigned pk2(float lo, float hi) { return f2bf(lo) | (f2bf(hi) << 16); }
__device__ __forceinline__ float bf2f(unsigned short b) { return __builtin_bit_cast(float, ((unsigned)b) << 16); }
__device__ __forceinline__ float bflo(unsigned w) { return __builtin_bit_cast(float, w << 16); }
__device__ __forceinline__ float bfhi(unsigned w) { return __builtin_bit_cast(float, w & 0xffff0000u); }
__device__ __forceinline__ float wave_sum(float v) {
#pragma unroll
    for (int o = 1; o < 64; o <<= 1) v += __shfl_xor(v, o);
    return v;
}
__device__ __forceinline__ float siluf(float x) { return x / (1.0f + __expf(-x)); }
__device__ __forceinline__ float sigmf(float x) { return 1.0f / (1.0f + __expf(-x)); }
__device__ __forceinline__ float gelu_tanh(float x) { const float u = 0.7978845608028654f * (x + 0.044715f * x * x * x); const float e = __expf(2.0f * u); return x * (1.0f - 1.0f / (e + 1.0f)); }

namespace pg8 {
constexpr int BM = 256, BK = 64, HALF = 128, HTB = HALF * BK * 2  , STAGE_BYTES = 8 * HTB;
__host__ __device__ __forceinline__ int lds_byte(int r, int c) { const int st = (r >> 4) * 2 + (c >> 5), rr = r & 15, cc = c & 31, ob = rr * 64 + cc * 2; return st * 1024 + (ob ^ (((ob >> 9) & 1) << 5)); }
__host__ __device__ __forceinline__ void stage_rc(int b, int& R, int& C) { const int st = b / 1024, sb = b % 1024, swz = sb ^ (((sb >> 9) & 1) << 5); R = (st >> 1) * 16 + swz / 64; C = (st & 1) * 32 + (swz % 64) / 2; }
__host__ __device__ __forceinline__ int perm32(int rho) { const int n = rho >> 4, i = rho & 15; return 8 * (i >> 2) + 4 * n + (i & 3); }

struct Unit { const char* A; const char* B; const int* rows; int pm, pn, z; };

__device__ __forceinline__ unsigned cvt_pk_bf16(float lo, float hi) { unsigned r; asm volatile("v_cvt_pk_bf16_f32 %0, %1, %2" : "=v"(r) : "v"(lo), "v"(hi)); return r; }

template <bool ALIGN_EPI = true, class Epi, class Sched>
__device__ __forceinline__ void gemm_phase(LAS unsigned char* lds, const int K, const unsigned lda, const unsigned ldb, const Sched& S, const Epi& E) {
    const int tid = threadIdx.x, wid = __builtin_amdgcn_readfirstlane(tid >> 6), lane = tid & 63, wr = wid >> 2, wc = wid & 3, fr = lane & 15, fq = lane >> 4;
    const int nt = K / BK;
    int Ri[2], Ci[2]; unsigned voffB[2][2];
#pragma unroll
    for (int i = 0; i < 2; ++i) { int R, C; stage_rc(tid * 16 + i * 8192, R, C); Ri[i] = R; Ci[i] = C;
        const int Rb0 = Epi::PERM ? (64 * (R >> 5) + perm32(R & 31)) : R, Rb1 = Epi::PERM ? (Rb0 + 32) : (R + HALF);
        voffB[0][i] = (unsigned)Rb0 * ldb + (unsigned)C * 2u; voffB[1][i] = (unsigned)Rb1 * ldb + (unsigned)C * 2u; }
    const size_t kstep = (size_t)(BK * 2);
    const unsigned ldsw = (unsigned)wid * 1024u;
    const int aoff = lds_byte(wr * 64 + fr, fq * 8), boff = lds_byte(wc * 32 + fr, fq * 8);
#define PG8_SA(b, h) (((b) * 2 + (h)) * HTB)
#define PG8_SB(b, h) ((4 + (b) * 2 + (h)) * HTB)
#define PG8_STAGE(bufoff, gbase, voff) do { _Pragma("unroll") for (int _i = 0; _i < 2; ++_i) \
        __builtin_amdgcn_global_load_lds((const unsigned*)((const char*)(gbase) + (voff)[_i]), (LAS unsigned*)(lds + (bufoff) + ldsw + _i * 8192), 16, 0, 0); } while (0)
#define PG8_LDA(dst, b, h) do { _Pragma("unroll") for (int m = 0; m < 4; ++m) _Pragma("unroll") for (int k = 0; k < 2; ++k) dst[m][k] = *(const LAS bf16x8*)(lds + PG8_SA(b, h) + aoff + m * 2048 + k * 1024); } while (0)
#define PG8_LDB(dst, b, h) do { _Pragma("unroll") for (int n = 0; n < 2; ++n) _Pragma("unroll") for (int k = 0; k < 2; ++k) dst[n][k] = *(const LAS bf16x8*)(lds + PG8_SB(b, h) + boff + n * 2048 + k * 1024); } while (0)
#define PG8_MMA(ai, bj, At, Bt) do { __builtin_amdgcn_s_setprio(1); _Pragma("unroll") for (int m = 0; m < 4; ++m) _Pragma("unroll") for (int n = 0; n < 2; ++n) _Pragma("unroll") for (int k = 0; k < 2; ++k) \
        acc[ai][bj][m][n] = __builtin_amdgcn_mfma_f32_16x16x32_bf16(Bt[n][k], At[m][k], acc[ai][bj][m][n], 0, 0, 0); __builtin_amdgcn_s_setprio(0); } while (0)
#define PG8_WAIT_V(n) asm volatile("s_waitcnt vmcnt(" #n ")" ::: "memory")
#define PG8_WAIT_L(n) asm volatile("s_waitcnt lgkmcnt(" #n ")" ::: "memory")
#define PG8_BAR __builtin_amdgcn_s_barrier()
#define PG8_SCHED __builtin_amdgcn_sched_barrier(0)
#define PG8_AOFF(dst, u) do { if ((u).rows) { _Pragma("unroll") for (int _h = 0; _h < 2; ++_h) _Pragma("unroll") for (int _i = 0; _i < 2; ++_i) \
            { unsigned _t = (unsigned)(u).rows[_h * HALF + Ri[_i]] >> 3; _t = _t < (unsigned)(T - 1) ? _t : (unsigned)(T - 1); dst[_h][_i] = _t * lda + (unsigned)Ci[_i] * 2u; } } \
        else { _Pragma("unroll") for (int _h = 0; _h < 2; ++_h) _Pragma("unroll") for (int _i = 0; _i < 2; ++_i) dst[_h][_i] = (unsigned)(_h * HALF + Ri[_i]) * lda + (unsigned)Ci[_i] * 2u; } } while (0)
    Unit cur, nxt; int ui = 0;
    if (!S.next(0, cur)) return;
    f32x4 acc[2][2][4][2];
#pragma unroll
    for (int a = 0; a < 2; ++a)
#pragma unroll
        for (int b = 0; b < 2; ++b)
#pragma unroll
            for (int m = 0; m < 4; ++m)
#pragma unroll
                for (int n = 0; n < 2; ++n) acc[a][b][m][n] = (f32x4){0.f, 0.f, 0.f, 0.f};
    bf16x8 At[4][2], B0[2][2], B1[2][2];
    unsigned vA[2][2], vN[2][2];
    PG8_AOFF(vA, cur);
    const char* cA = cur.A; const char* cB = cur.B;
    PG8_STAGE(PG8_SB(0, 0), cB, voffB[0]); PG8_STAGE(PG8_SB(0, 1), cB, voffB[1]); PG8_STAGE(PG8_SA(0, 0), cA, vA[0]); PG8_STAGE(PG8_SA(0, 1), cA, vA[1]);
    if (wr == 1) PG8_BAR;
    PG8_WAIT_V(2); PG8_BAR;
    PG8_STAGE(PG8_SB(1, 0), cB + kstep, voffB[0]); PG8_STAGE(PG8_SA(1, 0), cA + kstep, vA[0]); PG8_STAGE(PG8_SB(1, 1), cB + kstep, voffB[1]);
    PG8_WAIT_V(6); PG8_BAR;
    for (;;) {
        const bool has_next = S.next(ui + 1, nxt);
        if (has_next) { PG8_AOFF(vN, nxt); } else {
#pragma unroll
            for (int _h = 0; _h < 2; ++_h)
#pragma unroll
                for (int _i = 0; _i < 2; ++_i) vN[_h][_i] = vA[_h][_i]; }
        const char* nA = has_next ? nxt.A : cA; const char* nB = has_next ? nxt.B : cB;
#pragma nounroll
        for (int t = 0; t < nt; t += 2) {
            const bool last = (t == nt - 2);
            const char* a1 = cA + (size_t)(t + 1) * kstep;
            const char* a2 = last ? nA : cA + (size_t)(t + 2) * kstep; const char* b2 = last ? nB : cB + (size_t)(t + 2) * kstep;
            const char* a3 = a2 + kstep; const char* b3 = b2 + kstep;
            unsigned v2[2][2];
#pragma unroll
            for (int _h = 0; _h < 2; ++_h)
#pragma unroll
                for (int _i = 0; _i < 2; ++_i) v2[_h][_i] = last ? vN[_h][_i] : vA[_h][_i];
            PG8_LDB(B0, 0, 0); PG8_LDB(B1, 0, 1); PG8_SCHED; PG8_LDA(At, 0, 0); PG8_STAGE(PG8_SA(1, 1), a1, vA[1]);
            PG8_WAIT_V(8); PG8_WAIT_L(0); PG8_BAR; PG8_MMA(0, 0, At, B0); PG8_MMA(0, 1, At, B1); PG8_BAR; PG8_SCHED;
            PG8_LDA(At, 0, 1); PG8_STAGE(PG8_SB(0, 0), b2, voffB[0]); PG8_STAGE(PG8_SB(0, 1), b2, voffB[1]); PG8_STAGE(PG8_SA(0, 0), a2, v2[0]);
            PG8_WAIT_V(8); PG8_WAIT_L(0); PG8_BAR; PG8_MMA(1, 0, At, B0); PG8_MMA(1, 1, At, B1); PG8_BAR; PG8_SCHED;
            PG8_LDB(B0, 1, 0); PG8_LDB(B1, 1, 1); PG8_SCHED; PG8_LDA(At, 1, 0); PG8_STAGE(PG8_SA(0, 1), a2, v2[1]);
            PG8_WAIT_V(8); PG8_WAIT_L(0); PG8_BAR; PG8_MMA(0, 0, At, B0); PG8_MMA(0, 1, At, B1); PG8_BAR; PG8_SCHED;
            PG8_LDA(At, 1, 1); PG8_STAGE(PG8_SB(1, 0), b3, voffB[0]); PG8_STAGE(PG8_SB(1, 1), b3, voffB[1]); PG8_STAGE(PG8_SA(1, 0), a3, v2[0]);
            PG8_WAIT_V(8); PG8_WAIT_L(0); PG8_BAR; PG8_MMA(1, 0, At, B0); PG8_MMA(1, 1, At, B1); PG8_BAR; PG8_SCHED;
        }
        if constexpr (ALIGN_EPI) { if (wr == 0) PG8_BAR; }
        E(acc, cur, wr, wc, fr, fq);
        if (!has_next) break;
#pragma unroll
        for (int a = 0; a < 2; ++a)
#pragma unroll
            for (int b = 0; b < 2; ++b)
#pragma unroll
                for (int m = 0; m < 4; ++m)
#pragma unroll
                    for (int n = 0; n < 2; ++n) acc[a][b][m][n] = (f32x4){0.f, 0.f, 0.f, 0.f};
        cur = nxt; cA = nA; cB = nB; ++ui;
#pragma unroll
        for (int _h = 0; _h < 2; ++_h)
#pragma unroll
            for (int _i = 0; _i < 2; ++_i) vA[_h][_i] = vN[_h][_i];
        if constexpr (ALIGN_EPI) { if (wr == 1) PG8_BAR; }
    }
    PG8_WAIT_V(0);
    if constexpr (!ALIGN_EPI) { if (wr == 0) PG8_BAR; }
    PG8_BAR;
#undef PG8_SA
#undef PG8_SB
#undef PG8_STAGE
#undef PG8_LDA
#undef PG8_LDB
#undef PG8_MMA
#undef PG8_WAIT_V
#undef PG8_WAIT_L
#undef PG8_BAR
#undef PG8_SCHED
#undef PG8_AOFF
}
}

constexpr size_t MiB = 1u << 20;
constexpr size_t WS_CTL = 0, CTL_ZERO_BYTES = 1 * MiB;
constexpr size_t WS_MOD = 1 * MiB;
constexpr size_t WS_MODCTX = WS_MOD + 512 * 1024;
constexpr size_t WS_TOPW = 2 * MiB;
constexpr size_t WS_LAMT = 3 * MiB;
constexpr size_t WS_SSP = 12 * MiB;
constexpr size_t WS_SHW = 3 * MiB + 256 * 1024;
constexpr size_t WS_TOK = 4 * MiB;
constexpr size_t WS_H = 16 * MiB;
constexpr size_t WS_WS = 84 * MiB;
constexpr size_t WS_AR = 128 * MiB;
constexpr size_t WS_WIN = WS_WS, WS_WUQ = WS_WS + 2 * MiB, WS_WUKV = WS_WS + 2 * MiB + 512 * 1024, WS_WGLU = WS_WS + 3 * MiB, WS_WOUT = WS_WS + 4 * MiB;
constexpr size_t WS_SOUT = WS_WS + 6 * MiB;
constexpr size_t WS_WG = WS_WS + 14 * MiB;
constexpr size_t WS_WHIN = WS_WS, WS_WHOUT = WS_WS + 6 * MiB, WS_HFT = WS_WS + 8 * MiB;
constexpr size_t AR_PROJ = WS_AR, AR_U = WS_AR + 34 * MiB, AR_QN = WS_AR + 94 * MiB, AR_CKV = WS_AR + 110 * MiB, AR_QRAW = WS_AR + 127 * MiB,
                 AR_KVRAW = WS_AR + 175 * MiB, AR_KF = WS_AR + 243 * MiB, AR_SRAW = WS_AR + 294 * MiB, AR_Z = WS_AR + 334 * MiB, AR_CAT = WS_AR + 366 * MiB;
constexpr size_t AR_W1 = WS_AR, AR_W2 = WS_AR + 65 * MiB, AR_HID = WS_AR + 98 * MiB, AR_HIDS = WS_AR + 210 * MiB, AR_YBUF = WS_AR + 226 * MiB;
constexpr size_t AR_P = WS_AR, AR_X0 = WS_AR + 192 * MiB, AR_ZT = WS_AR + 256 * MiB, AR_YT = WS_AR + 320 * MiB;
constexpr size_t AR_HSP = WS_AR + 384 * MiB;
constexpr size_t WS_END = WS_AR + 430 * MiB;
static_assert(AR_U + (size_t)S5G * S5ROWS * S5K * 2 <= AR_QN && AR_QRAW + (size_t)T * 768 * 2 <= AR_KVRAW && AR_KVRAW + (size_t)TA * 1024 * 2 <= AR_KF && AR_KF + (size_t)TA * 768 * 2 <= AR_SRAW &&
              AR_SRAW + (size_t)S5G * S5ROWS * 256 * 4 <= AR_Z && AR_CAT + (size_t)T * 1024 * 2 <= WS_END && AR_CKV + (size_t)TA * 256 * 2 <= AR_QRAW && AR_PROJ + (size_t)TA * 512 * 2 <= AR_U, "arena L0");
static_assert(AR_W2 + (size_t)65 * 1024 * 256 * 2 <= AR_HID && AR_HID + (size_t)MAXBLK * 256 * 256 * 2 <= AR_HIDS && AR_HIDS + (size_t)T * 256 * 2 <= AR_YBUF && AR_YBUF + (size_t)HALF_T * 6 * 1024 * 2 <= WS_END, "arena MoE");
static_assert(WS_END <= 600 * MiB, "workspace budget");
constexpr int CW_TMO = 0, CW_CODE = 1;
constexpr int CW_BAR = 4096;
constexpr int CW_CNT = 32768;
constexpr int LDS_CTL_BYTES = 4096, RING_OFF = LDS_CTL_BYTES, LDS_BYTES = 160 * 1024;
constexpr int NPHASE = 26;

struct Params {
    const float *x, *c, *ctx, *c_ctx, *ada_w, *ada_b, *ev_w_in, *q_norm, *w_uq, *kv_norm, *w_ukv, *q_qk, *k_qk,
        *lam_re, *lam_im, *log_step, *b_re, *b_im, *c_re, *c_im, *s5_d, *glu_w, *glu_b, *ev_w_out,
        *hy_w_in, *hy_conv_w, *hy_conv_b, *f_w1, *f_b1, *f_w2, *f_b2, *f_w3, *f_freq, *hy_bias, *hy_w_out,
        *router_w, *router_b, *w_gate, *w_up, *w_down, *sh_gate, *sh_up, *sh_down;
    float* out; unsigned char* ws; int ph_lo, ph_hi;
};

#define XB_TMO      128
#define XB_XCNT(j)  (256  + 64 * (j))
#define XB_XSUB(j)  (1280 + 64 * (j))
#define XB_XGEN(j)  (2304 + 64 * (j))
#define XB_TOP      3328
#define XB_TOPGEN   3392
#define XCD_BAR_WORDS 3456
#define XB_SPIN_CAP (1u << 18)

__device__ __forceinline__ unsigned xb_ld(unsigned* p)              { return __hip_atomic_load(p, __ATOMIC_RELAXED, __HIP_MEMORY_SCOPE_AGENT); }
__device__ __forceinline__ unsigned xb_add(unsigned* p, unsigned v) { return __hip_atomic_fetch_add(p, v, __ATOMIC_RELAXED, __HIP_MEMORY_SCOPE_AGENT); }
__device__ __forceinline__ unsigned xb_xcc_id() { return (unsigned)__builtin_amdgcn_s_getreg((3 << 11) | 20) & 0xFu; }
#define XB_SPIN(cond, bar) do { unsigned _sp = 0; while (cond) { __builtin_amdgcn_s_sleep(1); \
    if ((++_sp & 255u) == 0u) { if (xb_ld(&(bar)[XB_TMO])) break; if (_sp > XB_SPIN_CAP) { atomicAdd(&(bar)[XB_TMO], 1u); break; } } } } while (0)

struct XcdBarrier {
    unsigned* bar; unsigned x;
    volatile LAS unsigned* st;
};

__device__ __forceinline__ XcdBarrier xcd_barrier_post(unsigned* bar, volatile LAS unsigned* st) {
    XcdBarrier b; b.bar = bar; b.x = xb_xcc_id(); b.st = st;
    if (threadIdx.x == 0) (void)xb_add(&bar[XB_XCNT(b.x)], 1u);
    return b;
}
__device__ __forceinline__ void xcd_barrier_complete(unsigned* bar, unsigned x, unsigned& nloc, unsigned& nx) {
    const unsigned G = gridDim.x * gridDim.y * gridDim.z;
    unsigned sum, cnt, mine, sp = 0u;
    for (;;) {
        sum = 0u; cnt = 0u; mine = 0u;
#pragma unroll
        for (unsigned j = 0; j < 16; ++j) { const unsigned c = xb_ld(&bar[XB_XCNT(j)]); sum += c; cnt += (c > 0u) ? 1u : 0u; mine = (j == x) ? c : mine; }
        if (sum == G) break;
        __builtin_amdgcn_s_sleep(1);
        if ((++sp & 255u) == 0u) { if (xb_ld(&bar[XB_TMO])) break; if (sp > XB_SPIN_CAP) { atomicAdd(&bar[XB_TMO], 1u); break; } }
    }
    nloc = mine > 0u ? mine : 1u; nx = cnt > 0u ? cnt : 1u;
}

__device__ __forceinline__ void xcd_barrier(const XcdBarrier& b) {
    asm volatile("s_waitcnt vmcnt(0)" ::: "memory");
    __syncthreads();
    if (threadIdx.x == 0) {
        unsigned* bar = b.bar;
        __builtin_amdgcn_s_waitcnt(0);
        unsigned nloc = b.st[0], nx = b.st[1];
        if (nloc == 0u) { xcd_barrier_complete(bar, b.x, nloc, nx); b.st[0] = nloc; b.st[1] = nx; }
        const unsigned old = xb_add(&bar[XB_XSUB(b.x)], 1u);
        const unsigned gen = old / nloc;
        if (old + 1u == (gen + 1u) * nloc) {
            __builtin_amdgcn_fence(__ATOMIC_RELEASE, "agent");
            asm volatile("s_waitcnt vmcnt(0)" ::: "memory");
            const unsigned og = xb_add(&bar[XB_TOP], 1u);
            const unsigned tg = og / nx;
            if (og + 1u == (tg + 1u) * nx) xb_add(&bar[XB_TOPGEN], 1u);
            else XB_SPIN(xb_ld(&bar[XB_TOPGEN]) == tg, bar);
            __builtin_amdgcn_fence(__ATOMIC_ACQUIRE, "agent");
            xb_add(&bar[XB_XGEN(b.x)], 1u);
            asm volatile("s_waitcnt vmcnt(0)" ::: "memory");
        } else {
            XB_SPIN(xb_ld(&bar[XB_XGEN(b.x)]) == gen, bar);
            __builtin_amdgcn_fence(__ATOMIC_ACQUIRE, "agent");
            asm volatile("s_waitcnt vmcnt(0)" ::: "memory");
        }
    }
    __syncthreads();
}

struct Ctx { LAS unsigned char* lds; int tid, lane, wave, G, bid; mutable unsigned long long tacc, tbeg; };
#define TS_ACC -1
#define TACC_B(C, id) do { if (TS_ACC == (id)) (C).tbeg = wall_clock64(); } while (0)
#define TACC_E(C, id) do { if (TS_ACC == (id)) (C).tacc += wall_clock64() - (C).tbeg; } while (0)

__device__ __forceinline__ void ph_mod(const Ctx& C, const Params& P) {
    if (C.bid >= 192) return;
    LAS float* sc = (LAS float*)(C.lds + RING_OFF);
    LAS float* red = sc + 9 * 1024;
    float* mod = (float*)(P.ws + WS_MOD); float* modctx = (float*)(P.ws + WS_MODCTX);
    for (int i = C.tid; i < 9 * 1024; i += 512) { const float v = (i < 8192) ? P.c[i] : P.c_ctx[i - 8192]; sc[i] = siluf(v); }
    __syncthreads();
    for (int item = C.bid; item < 192; item += C.G) {
        const int li = item / 96, j0 = (item % 96) * 64, c4 = C.tid & 15, kp = C.tid >> 4;
        f32x4 a[9];
#pragma unroll
        for (int r = 0; r < 9; ++r) a[r] = (f32x4){0.f, 0.f, 0.f, 0.f};
        const float* w = P.ada_w + (size_t)li * 1024 * 6144 + j0 + 4 * c4;
#pragma unroll 8
        for (int k = kp * 32; k < kp * 32 + 32; ++k) { const f32x4 wv = *(const f32x4*)(w + (size_t)k * 6144);
#pragma unroll
            for (int r = 0; r < 9; ++r) a[r] += wv * sc[r * 1024 + k]; }
#pragma unroll
        for (int r = 0; r < 9; ++r) *(LAS f32x4*)(red + (kp * 9 + r) * 64 + 4 * c4) = a[r];
        __syncthreads();
        for (int o = C.tid; o < 9 * 64; o += 512) { const int r = o >> 6, cc = o & 63; float s = P.ada_b[li * 6144 + j0 + cc];
#pragma unroll 8
            for (int q = 0; q < 32; ++q) s += red[(q * 9 + r) * 64 + cc];
            if (r < 8) mod[(size_t)(li * 8 + r) * 6144 + j0 + cc] = s; else if (li == 0 && j0 + cc < 2048) modctx[j0 + cc] = s; }
        __syncthreads();
    }
}

__device__ __forceinline__ void tr_item(const float* W, int ldw, bf16* WT, int ldt, int k0, int n0, int drow0, const float* gk, LAS float* scr, int lane) {
    f32x4 v[8]; const int c4 = (lane & 7) * 4;
#pragma unroll
    for (int j = 0; j < 8; ++j) v[j] = __builtin_nontemporal_load((const f32x4*)(W + (size_t)(k0 + 8 * j + (lane >> 3)) * ldw + n0 + c4));
#pragma unroll
    for (int j = 0; j < 8; ++j) { const int kk = 8 * j + (lane >> 3); const float g = gk ? gk[k0 + kk] : 1.0f; LAS float* d = scr + kk * 33 + c4; d[0] = v[j].x * g; d[1] = v[j].y * g; d[2] = v[j].z * g; d[3] = v[j].w * g; }
    LDS_WAIT(); asm volatile("" ::: "memory");
    const int c = lane & 7;
#pragma unroll
    for (int j = 0; j < 4; ++j) { const int n = (lane >> 3) + 8 * j; const LAS float* s = scr + (8 * c) * 33 + n;
        u32x4 o; o.x = pk2(s[0 * 33], s[1 * 33]); o.y = pk2(s[2 * 33], s[3 * 33]); o.z = pk2(s[4 * 33], s[5 * 33]); o.w = pk2(s[6 * 33], s[7 * 33]);
        *(u32x4*)(WT + (size_t)(drow0 + n) * ldt + k0 + 8 * c) = o; }
    LDS_WAIT(); asm volatile("" ::: "memory");
}
__device__ __forceinline__ void tr_matrix(const Ctx& C, const float* W, int K, int N, int ldw, bf16* WT, int ldt, int row_off, const float* gk, int gw, int NGW) {
    LAS float* scr = (LAS float*)(C.lds + RING_OFF + C.wave * 8448);
    const int nblk = N / 32, nit = (K / 64) * nblk;
    for (int it = gw; it < nit; it += NGW) { const int kb = it / nblk, nb = it % nblk; tr_item(W, ldw, WT, ldt, 64 * kb, 32 * nb, row_off + 32 * nb, gk, scr, C.lane); }
}
__device__ __forceinline__ void zero_bf16(bf16* p, size_t n, int gt, int NGT) { for (size_t i = (size_t)gt * 8; i < n; i += (size_t)NGT * 8) *(u32x4*)(p + i) = (u32x4){0u, 0u, 0u, 0u}; }

__device__ __forceinline__ void ph_conv_l0(const Ctx& C, const Params& P) {
    const int gw = C.bid * 8 + C.wave, NGW = C.G * 8, gt = C.bid * 512 + C.tid, NGT = C.G * 512;
    unsigned char* ws = P.ws;
    tr_matrix(C, P.ev_w_in, 1024, EVEN_IN, EVEN_IN, (bf16*)(ws + WS_WIN), 1024, 0, nullptr, gw, NGW);
    zero_bf16((bf16*)(ws + WS_WIN) + (size_t)EVEN_IN * 1024, (size_t)(1024 - EVEN_IN) * 1024, gt, NGT);
}
__device__ __forceinline__ void ph_conv_l0b(const Ctx& C, const Params& P, int gw, int NGW) {
    const int gt = gw * 64 + C.lane, NGT = NGW * 64; unsigned char* ws = P.ws;
    tr_matrix(C, P.w_uq, 256, 768, 768, (bf16*)(ws + WS_WUQ), 256, 0, P.q_norm, gw, NGW);
    tr_matrix(C, P.w_ukv, 128, 1024, 1024, (bf16*)(ws + WS_WUKV), 256, 0, P.kv_norm, gw, NGW);
    { bf16* w = (bf16*)(ws + WS_WUKV); for (int i = gt; i < 1024 * 16; i += NGT) { const int r = i >> 4, cq = i & 15; *(u32x4*)(w + (size_t)r * 256 + 128 + cq * 8) = (u32x4){0u, 0u, 0u, 0u}; } }
    tr_matrix(C, P.glu_w, 512, 512, 512, (bf16*)(ws + WS_WGLU), 512, 0, nullptr, gw, NGW);
    tr_matrix(C, P.ev_w_out, 1024, 1024, 1024, (bf16*)(ws + WS_WOUT), 1024, 0, nullptr, gw, NGW);
}
__device__ __forceinline__ void ph_conv_l1(const Ctx& C, const Params& P, int gw, int NGW) {
    tr_matrix(C, P.hy_w_in, 1024, 3072, 3072, (bf16*)(P.ws + WS_WHIN), 1024, 0, nullptr, gw, NGW);
    tr_matrix(C, P.hy_w_out, 1024, 1024, 1024, (bf16*)(P.ws + WS_WHOUT), 1024, 0, nullptr, gw, NGW);
}
__device__ __forceinline__ void ph_conv_moe(const Ctx& C, const Params& P, int li) {
    const int gw = C.bid * 8 + C.wave, NGW = C.G * 8;
    LAS float* scr = (LAS float*)(C.lds + RING_OFF + C.wave * 8448);
    bf16* W1 = (bf16*)(P.ws + AR_W1); bf16* W2 = (bf16*)(P.ws + AR_W2);
    for (int it = gw; it < 65 * 384; it += NGW) {
        const int e = it / 384, r = it % 384, kind = r >> 7, idx = r & 127;
        if (kind < 2) { const float* W = (e < 64) ? ((kind == 0 ? P.w_gate : P.w_up) + ((size_t)li * 64 + e) * 1024 * 256) : ((kind == 0 ? P.sh_gate : P.sh_up) + (size_t)li * 1024 * 256);
            const int kb = idx >> 3, nb = idx & 7, n0 = 32 * nb; const int drow0 = (n0 >> 7) * 256 + ((n0 >> 5) & 3) * 64 + kind * 32;
            tr_item(W, 256, W1 + (size_t)e * 512 * 1024, 1024, 64 * kb, n0, drow0, nullptr, scr, C.lane); }
        else { const float* W = (e < 64) ? (P.w_down + ((size_t)li * 64 + e) * 256 * 1024) : (P.sh_down + (size_t)li * 256 * 1024);
            const int kb = idx >> 5, nb = idx & 31;
            tr_item(W, 1024, W2 + (size_t)e * 1024 * 256, 256, 64 * kb, 32 * nb, 32 * nb, nullptr, scr, C.lane); }
    }
}

__device__ __forceinline__ void ph_s5_tables(const Ctx& C, const Params& P, int job0, int jstride) {
    LAS float* LST = (LAS float*)(C.lds + RING_OFF);
    LAS float* BB = LST + 256;
    LAS float* CC = BB + 4096;
    LAS float* LP = CC + 4096;
    LAS float* KT = LP + 8448;
    bf16* SOUT = (bf16*)(P.ws + WS_SOUT); bf16* WG = (bf16*)(P.ws + WS_WG); float* LAMT = (float*)(P.ws + WS_LAMT);
    for (int job = job0; job < S5G * 8; job += jstride) {
        const int g = job >> 3, part = job & 7;
        __syncthreads();
        if (C.tid < 128) { const int dir = C.tid >> 6, p = C.tid & 63, gi = dir * 32 + g;
            const float lr = fminf(P.lam_re[gi * 64 + p], -1e-4f), li = P.lam_im[gi * 64 + p], step = expf(P.log_step[gi]);
            const float a = lr * step, b = li * step; LST[(dir * 64 + p) * 2] = a; LST[(dir * 64 + p) * 2 + 1] = b;
            const float ea = expf(a), lbr = ea * cosf(b), lbi = ea * sinf(b);
            const float nr = lbr - 1.0f, ni = lbi, den = lr * lr + li * li;
            const float qr = (nr * lr + ni * li) / den, qi = (ni * lr - nr * li) / den;
#pragma unroll
            for (int h = 0; h < 16; ++h) { const float br = P.b_re[((size_t)gi * 64 + p) * 16 + h], bi = P.b_im[((size_t)gi * 64 + p) * 16 + h];
                BB[((dir * 64 + p) * 16 + h) * 2] = qr * br - qi * bi; BB[((dir * 64 + p) * 16 + h) * 2 + 1] = qr * bi + qi * br; } }
        for (int i = C.tid; i < 2048; i += 512) { const int dir = i >> 10, r = i & 1023; const size_t gi = (size_t)(dir * 32 + g) * 1024 + r; CC[i * 2] = P.c_re[gi]; CC[i * 2 + 1] = P.c_im[gi]; }
        __syncthreads();
        for (int i = C.tid; i < 2 * 33 * 64; i += 512) { const int dir = i / (33 * 64), r = i % (33 * 64), tau = r >> 6, p = r & 63;
            const float a = LST[(dir * 64 + p) * 2] * (float)tau, b = LST[(dir * 64 + p) * 2 + 1] * (float)tau; const float ea = expf(a);
            LP[i * 2] = ea * cosf(b); LP[i * 2 + 1] = ea * sinf(b); }
        __syncthreads();
        for (int i2 = C.tid; i2 < 2 * 32 * 32; i2 += 512) { const int dir = i2 >> 10, tau = (i2 >> 5) & 31, hp = 2 * part + ((i2 >> 4) & 1), h = i2 & 15; const int i = ((dir * 32 + tau) * 16 + hp) * 16 + h;
            float s = 0.f;
#pragma unroll 8
            for (int p = 0; p < 64; ++p) { const f32x2 c2 = *(const LAS f32x2*)(CC + ((dir * 16 + hp) * 64 + p) * 2), l2 = *(const LAS f32x2*)(LP + ((dir * 33 + tau) * 64 + p) * 2), b2 = *(const LAS f32x2*)(BB + ((dir * 64 + p) * 16 + h) * 2);
                const float xr = c2.x * l2.x - c2.y * l2.y, xi = c2.x * l2.y + c2.y * l2.x;
                s += xr * b2.x - xi * b2.y; }
            KT[i] = s; }
        __syncthreads();
        for (int i = C.tid; i < 64 * 96; i += 512) { const int nn = i / 96, k0 = (i % 96) * 8, t = nn >> 1, hp = 2 * part + (nn & 1), n = t * 16 + hp; float v[8];
#pragma unroll
            for (int j = 0; j < 8; ++j) { const int k = k0 + j;
                if (k < 512) { const int s = k >> 4, h = k & 15;
                    if (t > s) v[j] = KT[((0 * 32 + (t - s)) * 16 + hp) * 16 + h];
                    else if (t < s) v[j] = KT[((1 * 32 + (s - t)) * 16 + hp) * 16 + h];
                    else v[j] = KT[((0 * 32) * 16 + hp) * 16 + h] + KT[((1 * 32) * 16 + hp) * 16 + h] + (hp == h ? P.s5_d[g * 16 + h] : 0.f); }
                else { const int q = k - 512, dir = q >> 7, ri = (q >> 6) & 1, p = q & 63, tau = dir == 0 ? t + 1 : 32 - t;
                    const float cr = CC[((dir * 16 + hp) * 64 + p) * 2], ci = CC[((dir * 16 + hp) * 64 + p) * 2 + 1];
                    const float lr = LP[((dir * 33 + tau) * 64 + p) * 2], li = LP[((dir * 33 + tau) * 64 + p) * 2 + 1];
                    v[j] = ri == 0 ? (cr * lr - ci * li) : -(cr * li + ci * lr); } }
            u32x4 o; o.x = pk2(v[0], v[1]); o.y = pk2(v[2], v[3]); o.z = pk2(v[4], v[5]); o.w = pk2(v[6], v[7]);
            *(u32x4*)(WG + ((size_t)g * 512 + n) * 768 + k0) = o; }
        for (int i = C.tid; i < 32 * 64; i += 512) { const int q = 32 * part + (i >> 6), k0 = (i & 63) * 8, dir = q >> 7, ri = (q >> 6) & 1, p = q & 63; float v[8];
#pragma unroll
            for (int j = 0; j < 8; ++j) { const int k = k0 + j, s = k >> 4, h = k & 15, e = dir == 0 ? 31 - s : s;
                const float lr = LP[((dir * 33 + e) * 64 + p) * 2], li = LP[((dir * 33 + e) * 64 + p) * 2 + 1];
                const float br = BB[((dir * 64 + p) * 16 + h) * 2], bi = BB[((dir * 64 + p) * 16 + h) * 2 + 1];
                v[j] = ri == 0 ? (lr * br - li * bi) : (lr * bi + li * br); }
            u32x4 o; o.x = pk2(v[0], v[1]); o.y = pk2(v[2], v[3]); o.z = pk2(v[4], v[5]); o.w = pk2(v[6], v[7]);
            *(u32x4*)(SOUT + ((size_t)g * 256 + q) * 512 + k0) = o; }
        if (part == 0 && C.tid < 128) { const int dir = C.tid >> 6, p = C.tid & 63; LAMT[((g * 2 + dir) * 64 + p) * 2] = LP[((dir * 33 + 32) * 64 + p) * 2]; LAMT[((g * 2 + dir) * 64 + p) * 2 + 1] = LP[((dir * 33 + 32) * 64 + p) * 2 + 1]; }
    }
    __syncthreads();
}

__device__ __forceinline__ void ph_hy_filter(const Ctx& C, const Params& P, int item0, int istride) {
    LAS float* Z = (LAS float*)(C.lds + RING_OFF);
    LAS float* H1 = Z + 32 * 33 + 32;
    LAS float* H2 = H1 + 2048;
    float* HFT = (float*)(P.ws + WS_HFT);
    constexpr float PI2 = 6.283185307179586f;
    for (int item = item0; item < SEQ / 32; item += istride) {
        const int n0 = item * 32;
        __syncthreads();
        for (int i = C.tid; i < 32 * 33; i += 512) { const int p = i / 33, j = i % 33, n = n0 + p; const float tn = (float)n / 4095.0f, ang = PI2 * (float)n / 4096.0f; float v;
            if (j == 0) v = tn; else { const int bi = (j - 1) & 15; const float band = 1e-4f + (float)bi * ((15.0f - 1e-4f) / 15.0f); v = (j <= 16) ? cosf(band * ang) : -sinf(band * ang); }
            Z[p * 33 + j] = v; }
        __syncthreads();
        for (int i = C.tid; i < 2048; i += 512) { const int p = i >> 6, u = i & 63; float s = P.f_b1[u];
#pragma unroll
            for (int j = 0; j < 33; ++j) s += Z[p * 33 + j] * P.f_w1[j * 64 + u];
            H1[p * 64 + u] = sinf(P.f_freq[u] * s); }
        __syncthreads();
        for (int i = C.tid; i < 2048; i += 512) { const int p = i >> 6, u = i & 63; float s = P.f_b2[u];
#pragma unroll 16
            for (int k = 0; k < 64; ++k) s += H1[p * 64 + k] * P.f_w2[k * 64 + u];
            H2[p * 65 + u] = sinf(P.f_freq[u] * s); }
        __syncthreads();
        for (int ct = C.wave; ct < 64; ct += 8) { const int col = ct * 32 + (C.lane & 31), dir = col >> 10, d = col & 1023, kh = C.lane >> 5;
            f32x16 acc = {};
#pragma unroll 8
            for (int sk = 0; sk < 32; ++sk) { const float a = H2[(C.lane & 31) * 65 + 2 * sk + kh], b = P.f_w3[(size_t)(2 * sk + kh) * 2048 + col]; acc = __builtin_amdgcn_mfma_f32_32x32x2f32(a, b, acc, 0, 0, 0); }
            const float delta = 3.0701134573253945f + (float)d * ((15.350567286626972f - 3.0701134573253945f) / 1023.0f);
            float* o = HFT + ((size_t)d * 2 + dir) * 4096 + n0;
#pragma unroll
            for (int r4 = 0; r4 < 4; ++r4) { const int p0 = 8 * r4 + 4 * kh; f32x4 v;
                v.x = acc[4 * r4] * expf(-((float)(n0 + p0) / 4095.0f) * delta); v.y = acc[4 * r4 + 1] * expf(-((float)(n0 + p0 + 1) / 4095.0f) * delta);
                v.z = acc[4 * r4 + 2] * expf(-((float)(n0 + p0 + 2) / 4095.0f) * delta); v.w = acc[4 * r4 + 3] * expf(-((float)(n0 + p0 + 3) / 4095.0f) * delta);
                *(f32x4*)(o + p0) = v; } }
    }
    __syncthreads();
}

__device__ __forceinline__ void ph_norm(const Ctx& C, const Params& P, const float* xin, int li, int sh_idx, bool with_ctx) {
    const int gw = C.bid * 8 + C.wave, NGW = C.G * 8; bf16* H = (bf16*)(P.ws + WS_H);
    const float* mod = (const float*)(P.ws + WS_MOD); const float* modctx = (const float*)(P.ws + WS_MODCTX);
    const int nrows = with_ctx ? TA : T;
    for (int row0 = gw; row0 < nrows; row0 += 4 * NGW) {
        f32x4 v[4][4]; float s[4]; const float* shp[4]; const float* scp[4]; bool ok[4];
#pragma unroll
        for (int q = 0; q < 4; ++q) { const int row = row0 + q * NGW; ok[q] = row < nrows; const int rr = ok[q] ? row : row0; const float* xr;
            if (rr < T) { xr = xin + (size_t)rr * 1024; const float* m = mod + (size_t)(li * 8 + (rr >> 12)) * 6144; shp[q] = m + sh_idx * 1024; scp[q] = m + (sh_idx + 1) * 1024; }
            else { xr = P.ctx + (size_t)(rr - T) * 1024; shp[q] = modctx; scp[q] = modctx + 1024; }
            s[q] = 0.f;
#pragma unroll
            for (int j = 0; j < 4; ++j) { v[q][j] = *(const f32x4*)(xr + 256 * j + 4 * C.lane); } }
#pragma unroll
        for (int q = 0; q < 4; ++q) {
#pragma unroll
            for (int j = 0; j < 4; ++j) s[q] += (v[q][j].x * v[q][j].x + v[q][j].y * v[q][j].y) + (v[q][j].z * v[q][j].z + v[q][j].w * v[q][j].w);
            const float rstd = 1.0f / sqrtf(wave_sum(s[q]) * (1.0f / 1024.0f) + EPS);
            if (ok[q]) { const int row = row0 + q * NGW;
#pragma unroll
                for (int j = 0; j < 4; ++j) { const f32x4 a = *(const f32x4*)(scp[q] + 256 * j + 4 * C.lane), b = *(const f32x4*)(shp[q] + 256 * j + 4 * C.lane);
                    const f32x4 y = v[q][j] * rstd * (a + 1.0f) + b; u32x2 o; o.x = pk2(y.x, y.y); o.y = pk2(y.z, y.w);
                    *(u32x2*)(H + (size_t)row * 1024 + 256 * j + 4 * C.lane) = o; } } }
    }
}

__device__ __forceinline__ void ph_rownorm1(const Ctx& C, const Params& P) {
    const int gw = C.bid * 8 + C.wave, NGW = C.G * 8; const bf16* PROJ = (const bf16*)(P.ws + AR_PROJ); bf16* QN = (bf16*)(P.ws + AR_QN); bf16* CKV = (bf16*)(P.ws + AR_CKV);
    for (int row0 = gw; row0 < TA; row0 += 4 * NGW) {
        u32x2 q[4]; unsigned kv[4];
#pragma unroll
        for (int r = 0; r < 4; ++r) { const int row = (row0 + r * NGW < TA) ? row0 + r * NGW : row0; q[r] = *(const u32x2*)(PROJ + (size_t)row * 512 + 4 * C.lane); kv[r] = *(const unsigned*)(PROJ + (size_t)row * 512 + 256 + 2 * C.lane); }
        float sq[4], sk[4];
#pragma unroll
        for (int r = 0; r < 4; ++r) { const float q0 = bflo(q[r].x), q1 = bfhi(q[r].x), q2 = bflo(q[r].y), q3 = bfhi(q[r].y), k0 = bflo(kv[r]), k1 = bfhi(kv[r]); sq[r] = (q0 * q0 + q1 * q1) + (q2 * q2 + q3 * q3); sk[r] = k0 * k0 + k1 * k1; }
#pragma unroll
        for (int o = 1; o < 64; o <<= 1) {
#pragma unroll
            for (int r = 0; r < 4; ++r) { sq[r] += __shfl_xor(sq[r], o); sk[r] += __shfl_xor(sk[r], o); } }
#pragma unroll
        for (int r = 0; r < 4; ++r) { const int row = row0 + r * NGW; if (row < TA) {
            const float q0 = bflo(q[r].x), q1 = bfhi(q[r].x), q2 = bflo(q[r].y), q3 = bfhi(q[r].y), k0 = bflo(kv[r]), k1 = bfhi(kv[r]);
            const float rq = 1.0f / sqrtf(sq[r] * (1.0f / 256.0f) + EPS), rk = 1.0f / sqrtf(sk[r] * (1.0f / 128.0f) + EPS);
            if (row < T) { u32x2 o; o.x = pk2(q0 * rq, q1 * rq); o.y = pk2(q2 * rq, q3 * rq); *(u32x2*)(QN + (size_t)row * 256 + 4 * C.lane) = o; }
            *(unsigned*)(CKV + (size_t)row * 256 + 2 * C.lane) = pk2(k0 * rk, k1 * rk);
            *(unsigned*)(CKV + (size_t)row * 256 + 128 + 2 * C.lane) = 0u; } }
    }
}

__device__ __forceinline__ void ph_qkfinal(const Ctx& C, const Params& P) {
    const int gw = C.bid * 8 + C.wave, NGW = C.G * 8;
    const bf16* PROJ = (const bf16*)(P.ws + AR_PROJ); const bf16* KVRAW = (const bf16*)(P.ws + AR_KVRAW); bf16* KF = (bf16*)(P.ws + AR_KF); bf16* Q = (bf16*)(P.ws + AR_QRAW);
    const int hd = C.lane >> 3, sub = C.lane & 7, j0 = 12 * sub;
    constexpr float QSCALE = 0.10206207261596577f * 1.4426950408889634f;
    float gq[12], gk[12];
#pragma unroll
    for (int i = 0; i < 12; ++i) { gq[i] = P.q_qk[j0 + i]; gk[i] = P.k_qk[j0 + i]; }
    for (int row0 = gw; row0 < TA; row0 += 2 * NGW) {
        u32x2 kw[2][3];
#pragma unroll
        for (int rr = 0; rr < 2; ++rr) { const int row = (row0 + rr * NGW < TA) ? row0 + rr * NGW : row0;
#pragma unroll
            for (int i = 0; i < 3; ++i) { const int j = j0 + 4 * i; const bf16* src = (j < 64) ? (KVRAW + (size_t)row * 1024 + hd * 128 + j) : (PROJ + (size_t)row * 512 + 384 + (j - 64));
                kw[rr][i] = *(const u32x2*)src; } }
#pragma unroll
        for (int rr = 0; rr < 2; ++rr) { const int row = row0 + rr * NGW; if (row >= TA) continue;
        const bool lat = row < T; const int pos = row & 4095;
        float cs[6], sn[6];
#pragma unroll
        for (int i = 0; i < 6; ++i) { const int j = j0 + 2 * i; cs[i] = 1.f; sn[i] = 0.f;
            if (j >= 64 && lat) { const int pi = (j - 64) >> 1; const float inv = exp2f(-(float)(pi & 7) * (13.287712379549449f / 8.0f)); const float ang = (float)(pi < 8 ? (pos >> 6) : (pos & 63)) * inv; cs[i] = cosf(ang); sn[i] = sinf(ang); } }
        { float x[12];
#pragma unroll
          for (int i = 0; i < 3; ++i) { const u32x2 w = kw[rr][i]; x[4 * i] = bflo(w.x); x[4 * i + 1] = bfhi(w.x); x[4 * i + 2] = bflo(w.y); x[4 * i + 3] = bfhi(w.y); }
          float s = 0.f;
#pragma unroll
          for (int i = 0; i < 12; ++i) s += x[i] * x[i];
          s += __shfl_xor(s, 1); s += __shfl_xor(s, 2); s += __shfl_xor(s, 4);
          const float r = 1.0f / sqrtf(s * (1.0f / 96.0f) + EPS);
#pragma unroll
          for (int i = 0; i < 12; ++i) x[i] = x[i] * r * gk[i];
#pragma unroll
          for (int i = 0; i < 6; ++i) { const float a = x[2 * i], b = x[2 * i + 1]; x[2 * i] = a * cs[i] - b * sn[i]; x[2 * i + 1] = a * sn[i] + b * cs[i]; }
#pragma unroll
          for (int i = 0; i < 3; ++i) { u32x2 o; o.x = pk2(x[4 * i], x[4 * i + 1]); o.y = pk2(x[4 * i + 2], x[4 * i + 3]); *(u32x2*)(KF + (size_t)row * 768 + hd * 96 + j0 + 4 * i) = o; } }
        if (lat) { float x[12];
#pragma unroll
          for (int i = 0; i < 3; ++i) { const u32x2 w = *(const u32x2*)(Q + (size_t)row * 768 + hd * 96 + j0 + 4 * i); x[4 * i] = bflo(w.x); x[4 * i + 1] = bfhi(w.x); x[4 * i + 2] = bflo(w.y); x[4 * i + 3] = bfhi(w.y); }
          float s = 0.f;
#pragma unroll
          for (int i = 0; i < 12; ++i) s += x[i] * x[i];
          s += __shfl_xor(s, 1); s += __shfl_xor(s, 2); s += __shfl_xor(s, 4);
          const float r = 1.0f / sqrtf(s * (1.0f / 96.0f) + EPS);
#pragma unroll
          for (int i = 0; i < 12; ++i) x[i] = x[i] * r * gq[i];
#pragma unroll
          for (int i = 0; i < 6; ++i) { const float a = x[2 * i], b = x[2 * i + 1]; x[2 * i] = (a * cs[i] - b * sn[i]) * QSCALE; x[2 * i + 1] = (a * sn[i] + b * cs[i]) * QSCALE; }
#pragma unroll
          for (int i = 0; i < 3; ++i) { u32x2 o; o.x = pk2(x[4 * i], x[4 * i + 1]); o.y = pk2(x[4 * i + 2], x[4 * i + 3]); *(u32x2*)(Q + (size_t)row * 768 + hd * 96 + j0 + 4 * i) = o; } }
        }
    }
}

using pg8::Unit;
#define EPI_ARGS const f32x4 (&acc)[2][2][4][2], const Unit& u, int wr, int wc, int fr, int fq
__device__ __forceinline__ u32x4 pack8(const f32x4 a, const f32x4 b) { u32x4 w; w.x = pg8::cvt_pk_bf16(a[0], a[1]); w.y = pg8::cvt_pk_bf16(a[2], a[3]); w.z = pg8::cvt_pk_bf16(b[0], b[1]); w.w = pg8::cvt_pk_bf16(b[2], b[3]); return w; }

__device__ __forceinline__ void widen_pair(const u32x4 d0, const u32x4 d1, bool odd, u32x4& A, u32x4& B) {
    u32x4 send, recv;
#pragma unroll
    for (int q = 0; q < 4; ++q) { send[q] = odd ? d0[q] : d1[q]; recv[q] = (unsigned)__builtin_amdgcn_update_dpp(0, (int)send[q], 0xB1, 0xf, 0xf, false); }
#pragma unroll
    for (int q = 0; q < 4; ++q) { A[q] = odd ? recv[q] : d0[q]; B[q] = odd ? d1[q] : recv[q]; }
}
struct SchedDense {
    const char* A; const char* B; unsigned lda, ldb; int nM, nN, G, c;
    __device__ __forceinline__ bool next(int i, Unit& u) const { const int L = i * G + c; if (L >= nM * nN) return false; const int pm = L / nN, pn = L % nN;
        u.A = A + (size_t)pm * 256 * lda; u.B = B + (size_t)pn * 256 * ldb; u.rows = nullptr; u.pm = pm; u.pn = pn; u.z = 0; return true; }
};
struct SchedBatched {
    const char* A; const char* B; unsigned lda, ldb; size_t sA, sB; int nZ, nM, nN, G, c;
    __device__ __forceinline__ bool next(int i, Unit& u) const { const int L = i * G + c; if (L >= nZ * nM * nN) return false; const int z = L / (nM * nN), r = L % (nM * nN), pm = r / nN, pn = r % nN;
        u.A = A + (size_t)z * sA + (size_t)pm * 256 * lda; u.B = B + (size_t)z * sB + (size_t)pn * 256 * ldb; u.rows = nullptr; u.pm = pm; u.pn = pn; u.z = z; return true; }
};
struct SchedUp {
    const char *QN, *WUQ, *CKV, *WUKV; int G, c;
    __device__ __forceinline__ bool next(int i, Unit& u) const { int L = i * G + c; u.rows = nullptr;
        if (L < 384) { u.pm = L / 3; u.pn = L % 3; u.z = 0; u.A = QN + (size_t)u.pm * 256 * 512; u.B = WUQ + (size_t)u.pn * 256 * 512; return true; }
        L -= 384; if (L >= 544) return false; u.pm = L >> 2; u.pn = L & 3; u.z = 1; u.A = CKV + (size_t)u.pm * 256 * 512; u.B = WUKV + (size_t)u.pn * 256 * 512; return true; }
};

struct EpiInProj {
    static constexpr bool PERM = true; bf16* PROJ; bf16* U;
    __device__ __forceinline__ void operator()(EPI_ARGS) const {
#pragma unroll
        for (int ai = 0; ai < 2; ++ai)
#pragma unroll
            for (int m = 0; m < 4; ++m) { const int row = u.pm * 256 + ai * 128 + wr * 64 + m * 16 + fr; int urow, s;
                if (row < T) { const int b = row >> 12, pos = row & 4095; urow = (pos >> 5) * 8 + b; s = pos & 31; } else { const int rr = row - T, b = rr >> 8, pos = rr & 255; urow = 1024 + (pos >> 5) * 8 + b; s = pos & 31; }
#pragma unroll
                for (int bj = 0; bj < 2; ++bj) { const int col0 = u.pn * 256 + wc * 64 + bj * 32 + 8 * fq; const u32x4 w = pack8(acc[ai][bj][m][0], acc[ai][bj][m][1]);
                    if (col0 < UOFF) *(u32x4*)(PROJ + (size_t)row * 512 + col0) = w;
                    else if (col0 < EVEN_IN) { const int gc = col0 - UOFF, g = gc >> 4, h0 = gc & 15; *(u32x4*)(U + ((size_t)(g * S5ROWS + urow) * S5K + s * 16 + h0)) = w; } } }
    }
};
struct EpiUp {
    static constexpr bool PERM = true; bf16* QRAW; bf16* KVRAW;
    __device__ __forceinline__ void operator()(EPI_ARGS) const { bf16* O = u.z ? KVRAW : QRAW; const int ldc = u.z ? 1024 : 768; const bool odd = fr & 1;
#pragma unroll
        for (int ai = 0; ai < 2; ++ai)
#pragma unroll
            for (int m = 0; m < 4; ++m) { const int rowE = u.pm * 256 + ai * 128 + wr * 64 + m * 16 + (fr & ~1); u32x4 A, B; widen_pair(pack8(acc[ai][0][m][0], acc[ai][0][m][1]), pack8(acc[ai][1][m][0], acc[ai][1][m][1]), odd, A, B);
                bf16* op = O + (size_t)rowE * ldc + u.pn * 256 + wc * 64 + (odd ? 32 : 0) + 8 * fq; *(u32x4*)op = A; *(u32x4*)(op + ldc) = B; }
    }
};
struct EpiF32Batched {
    static constexpr bool PERM = false; float* O; int rows_per_z, ldc;
    __device__ __forceinline__ void operator()(EPI_ARGS) const {
#pragma unroll
        for (int ai = 0; ai < 2; ++ai)
#pragma unroll
            for (int m = 0; m < 4; ++m) { const int row = u.pm * 256 + ai * 128 + wr * 64 + m * 16 + fr; float* rp = O + ((size_t)u.z * rows_per_z + row) * ldc + u.pn * 256 + wc * 32 + 4 * fq;
#pragma unroll
                for (int bj = 0; bj < 2; ++bj)
#pragma unroll
                    for (int n = 0; n < 2; ++n) *(f32x4*)(rp + bj * 128 + n * 16) = acc[ai][bj][m][n]; }
    }
};
struct EpiS5C {
    static constexpr bool PERM = true; bf16* Z;
    __device__ __forceinline__ void operator()(EPI_ARGS) const {
#pragma unroll
        for (int ai = 0; ai < 2; ++ai)
#pragma unroll
            for (int m = 0; m < 4; ++m) { const int rr = u.pm * 256 + ai * 128 + wr * 64 + m * 16 + fr, c = rr >> 3, b = rr & 7;
#pragma unroll
                for (int bj = 0; bj < 2; ++bj) { const int cc = u.pn * 256 + wc * 64 + bj * 32 + 8 * fq, t = cc >> 4, h0 = cc & 15; f32x4 v0 = acc[ai][bj][m][0], v1 = acc[ai][bj][m][1];
#pragma unroll
                    for (int j = 0; j < 4; ++j) { v0[j] = gelu_tanh(v0[j]); v1[j] = gelu_tanh(v1[j]); }
                    *(u32x4*)(Z + ((size_t)(b * 4096 + c * 32 + t) * 512 + u.z * 16 + h0)) = pack8(v0, v1); } }
    }
};
struct EpiGlu {
    static constexpr bool PERM = true; const bf16* Z; const float* gb; bf16* CAT;
    __device__ __forceinline__ void operator()(EPI_ARGS) const {
#pragma unroll
        for (int ai = 0; ai < 2; ++ai)
#pragma unroll
            for (int m = 0; m < 4; ++m) { const int row = u.pm * 256 + ai * 128 + wr * 64 + m * 16 + fr;
#pragma unroll
                for (int bj = 0; bj < 2; ++bj) { const int col0 = u.pn * 256 + wc * 64 + bj * 32 + 8 * fq; const u32x4 zw = *(const u32x4*)(Z + (size_t)row * 512 + col0);
                    const f32x4 b0 = *(const f32x4*)(gb + col0), b1 = *(const f32x4*)(gb + col0 + 4); f32x4 v0 = acc[ai][bj][m][0] + b0, v1 = acc[ai][bj][m][1] + b1;
                    v0[0] = bflo(zw.x) * sigmf(v0[0]); v0[1] = bfhi(zw.x) * sigmf(v0[1]); v0[2] = bflo(zw.y) * sigmf(v0[2]); v0[3] = bfhi(zw.y) * sigmf(v0[3]);
                    v1[0] = bflo(zw.z) * sigmf(v1[0]); v1[1] = bfhi(zw.z) * sigmf(v1[1]); v1[2] = bflo(zw.w) * sigmf(v1[2]); v1[3] = bfhi(zw.w) * sigmf(v1[3]);
                    *(u32x4*)(CAT + (size_t)row * 1024 + 512 + col0) = pack8(v0, v1); } }
    }
};
struct EpiResid {
    static constexpr bool PERM = false; const float* xin; float* xout; const float* gate;
    __device__ __forceinline__ void operator()(EPI_ARGS) const { const int col0 = u.pn * 256 + wc * 32 + 4 * fq;
        f32x4 gv[2][2];
        { const float* gp = gate + (size_t)((u.pm * 256) >> 12) * 6144 + col0;
#pragma unroll
          for (int bj = 0; bj < 2; ++bj)
#pragma unroll
              for (int n = 0; n < 2; ++n) gv[bj][n] = *(const f32x4*)(gp + bj * 128 + n * 16); }
#pragma unroll
        for (int ai = 0; ai < 2; ++ai)
#pragma unroll
            for (int mp = 0; mp < 2; ++mp) { f32x4 xv[2][2][2];
#pragma unroll
                for (int mq = 0; mq < 2; ++mq) { const int row = u.pm * 256 + ai * 128 + wr * 64 + (2 * mp + mq) * 16 + fr;
#pragma unroll
                    for (int bj = 0; bj < 2; ++bj)
#pragma unroll
                        for (int n = 0; n < 2; ++n) xv[mq][bj][n] = *(const f32x4*)(xin + (size_t)row * 1024 + col0 + bj * 128 + n * 16); }
#pragma unroll
                for (int mq = 0; mq < 2; ++mq) { const int m = 2 * mp + mq, row = u.pm * 256 + ai * 128 + wr * 64 + m * 16 + fr;
#pragma unroll
                    for (int bj = 0; bj < 2; ++bj)
#pragma unroll
                        for (int n = 0; n < 2; ++n) *(f32x4*)(xout + (size_t)row * 1024 + col0 + bj * 128 + n * 16) = xv[mq][bj][n] + gv[bj][n] * acc[ai][bj][m][n]; } }
    }
};

__device__ __forceinline__ void ph_s5_scan(const Ctx& C, const Params& P) {
    const int gt = C.bid * 512 + C.tid; if (gt >= S5G * NB * 128) return;
    const int p = gt & 63, dir = (gt >> 6) & 1, b = (gt >> 7) & 7, g = gt >> 10;
    const float* LAMT = (const float*)(P.ws + WS_LAMT); const float lr = LAMT[((g * 2 + dir) * 64 + p) * 2], li = LAMT[((g * 2 + dir) * 64 + p) * 2 + 1];
    const float* S = (const float*)(P.ws + AR_SRAW) + (size_t)g * S5ROWS * 256 + dir * 128 + p;
    bf16* Ug = (bf16*)(P.ws + AR_U) + (size_t)g * S5ROWS * S5K + 512 + dir * 128 + p;
    float sr = 0.f, si = 0.f;
    if (dir == 0) {
#pragma unroll
        for (int j = 0; j < S5NCC; ++j) { const int row = 1024 + j * 8 + b; const float ar = S[(size_t)row * 256], ai = S[(size_t)row * 256 + 64]; const float nr = lr * sr - li * si + ar, ni = lr * si + li * sr + ai; sr = nr; si = ni; }
#pragma unroll 8
        for (int c = 0; c < S5NCH; ++c) { const int row = c * 8 + b; const float ar = S[(size_t)row * 256], ai = S[(size_t)row * 256 + 64];
            Ug[(size_t)row * S5K] = (bf16)f2bf(sr); Ug[(size_t)row * S5K + 64] = (bf16)f2bf(si);
            const float nr = lr * sr - li * si + ar, ni = lr * si + li * sr + ai; sr = nr; si = ni; }
    } else {
#pragma unroll
        for (int j = S5NCC - 1; j >= 0; --j) { const int row = 1024 + j * 8 + b; const float ar = S[(size_t)row * 256], ai = S[(size_t)row * 256 + 64]; const float nr = lr * sr - li * si + ar, ni = lr * si + li * sr + ai; sr = nr; si = ni; }
#pragma unroll 8
        for (int c = S5NCH - 1; c >= 0; --c) { const int row = c * 8 + b; const float ar = S[(size_t)row * 256], ai = S[(size_t)row * 256 + 64];
            Ug[(size_t)row * S5K] = (bf16)f2bf(sr); Ug[(size_t)row * S5K + 64] = (bf16)f2bf(si);
            const float nr = lr * sr - li * si + ar, ni = lr * si + li * sr + ai; sr = nr; si = ni; }
    }
}

constexpr int AT_KROW = 208, AT_KB = 64 * AT_KROW  , AT_VB = 8192;
constexpr int AT_K = RING_OFF, AT_V = AT_K + 2 * AT_KB, AT_WS = AT_V + 2 * AT_VB, AT_OST = AT_WS + 8 * 256, AT_END = AT_OST + 8 * 4096;
__device__ __forceinline__ int crow(int r, int hi) { return (r & 3) + 8 * (r >> 2) + 4 * hi; }
typedef short v4i16_t __attribute__((ext_vector_type(4)));
__device__ __forceinline__ s16x4 vtr(const LAS unsigned char* p) { return __builtin_bit_cast(s16x4, __builtin_amdgcn_ds_read_tr16_b64_v4i16((LAS v4i16_t*)p)); }
__device__ __forceinline__ float xhalf_max(float m) { auto rr = __builtin_amdgcn_permlane32_swap(__float_as_uint(m), __float_as_uint(m), false, false); return fmaxf(__uint_as_float(rr[0]), __uint_as_float(rr[1])); }
__device__ __forceinline__ float xhalf_sum(float m) { auto rr = __builtin_amdgcn_permlane32_swap(__float_as_uint(m), __float_as_uint(m), false, false); return __uint_as_float(rr[0]) + __uint_as_float(rr[1]); }

__device__ __forceinline__ float max3f(float a, float b, float c) { return fmaxf(fmaxf(a, b), c); }
constexpr int AT2_KB = 64 * 256, AT2_K = RING_OFF, AT2_V = AT2_K + 2 * AT2_KB, AT2_WS = AT2_V + 2 * AT_VB, AT2_OST = AT2_WS + 8 * 256, AT2_END = AT2_OST + 8 * 4096;
static_assert(AT2_END <= LDS_BYTES, "attention LDS");
template <bool NOMAX> __device__ __forceinline__ void ph_attention(const Ctx& C, const Params& P, int vcu) {
    const bf16* Q = (const bf16*)(P.ws + AR_QRAW); const bf16* KF = (const bf16*)(P.ws + AR_KF); const bf16* KV = (const bf16*)(P.ws + AR_KVRAW); bf16* CAT = (bf16*)(P.ws + AR_CAT);
    const int lane = C.lane, wid = C.wave, r32 = lane & 31, hi = lane >> 5;
    LAS unsigned char* lds = C.lds;
    LAS float* wsf = (LAS float*)(lds + AT2_WS) + wid * 64;
    const int vrd = ((lane >> 4) & 1) * 32 + (lane & 3) * 8 + (4 * hi + ((lane & 15) >> 2)) * 64;
    int kro[6];
#pragma unroll
    for (int d0 = 0; d0 < 6; ++d0) kro[d0] = r32 * 256 + (((2 * d0 + hi) ^ (r32 & 15)) << 4);
    constexpr int NTILE = (SEQ + CTXL) / 64;
    constexpr float THR = 8.0f;
#define SB() __builtin_amdgcn_sched_barrier(0)
#define AT_ROW0(j) (((j) < 64) ? ((size_t)b * SEQ + (size_t)(j) * 64) : ((size_t)T + (size_t)b * CTXL + (size_t)((j) - 64) * 64))
#define AT_DMAK(j, buf) do { const bf16* kb_ = KF + AT_ROW0(j) * 768 + hd * 96; _Pragma("unroll") for (int q_ = 0; q_ < 2; ++q_) { \
        const int row_ = 4 * (2 * wid + q_) + (lane >> 4); int c_ = (lane & 15) ^ (row_ & 15); c_ = c_ < 12 ? c_ : c_ - 12;     \
        __builtin_amdgcn_global_load_lds((const unsigned*)(kb_ + row_ * 768 + c_ * 8), (LAS unsigned*)(lds + AT2_K + (buf) * AT2_KB + (2 * wid + q_) * 1024), 16, 0, 0); } } while (0)
#define AT_DMAV(j, buf) do { const bf16* vb_ = KV + AT_ROW0(j) * 1024 + hd * 128; \
        __builtin_amdgcn_global_load_lds((const unsigned*)(vb_ + (16 * (wid & 3) + (lane >> 2)) * 1024 + 64 + ((wid >> 2) * 4 + (lane & 3)) * 8), (LAS unsigned*)(lds + AT2_V + (buf) * AT_VB + wid * 1024), 16, 0, 0); } while (0)
#define AT_KFRAG(Kb, d0, h) (*(const LAS bf16x8*)((Kb) + (h) * 32 * 256 + kro[d0]))
    for (int i = 0;; ++i) {
        const int un = i * C.G + vcu; if (un >= NB * NHEAD * 16) break;
        const int bh = un >> 4, qb = un & 15, b = bh >> 3, hd = bh & 7;
        const size_t qrow = (size_t)b * SEQ + qb * 256 + wid * 32 + r32;
        bf16x8 qr[6];
#pragma unroll
        for (int d0 = 0; d0 < 6; ++d0) qr[d0] = *(const bf16x8*)(Q + qrow * 768 + hd * 96 + d0 * 16 + hi * 8);
        f32x16 o0 = {}, o1 = {}; float m = NOMAX ? 0.f : -1e30f, l = 0.f;
        AT_DMAK(0, 0); AT_DMAV(0, 0); AT_DMAK(1, 1);
        __syncthreads();
        f32x16 pc0 = {}, pc1 = {};
        { const LAS unsigned char* Kb = lds + AT2_K;
#pragma unroll
          for (int d0 = 0; d0 < 6; ++d0) { pc0 = __builtin_amdgcn_mfma_f32_32x32x16_bf16(AT_KFRAG(Kb, d0, 0), qr[d0], pc0, 0, 0, 0); pc1 = __builtin_amdgcn_mfma_f32_32x32x16_bf16(AT_KFRAG(Kb, d0, 1), qr[d0], pc1, 0, 0, 0); } }
        for (int j = 0; j < NTILE; ++j) {
            const int buf = j & 1; const bool more = j + 1 < NTILE;
            if (j + 2 < NTILE) AT_DMAK(j + 2, buf);
            if (more) AT_DMAV(j + 1, buf ^ 1);
            const LAS unsigned char* Kn = lds + AT2_K + (buf ^ 1) * AT2_KB;
            f32x16 pn0 = {}, pn1 = {};
            bf16x8 ka = AT_KFRAG(Kn, 0, 0), kb = AT_KFRAG(Kn, 0, 1), kc = AT_KFRAG(Kn, 1, 0), kd = AT_KFRAG(Kn, 1, 1);
            if (more) { pn0 = __builtin_amdgcn_mfma_f32_32x32x16_bf16(ka, qr[0], pn0, 0, 0, 0); pn1 = __builtin_amdgcn_mfma_f32_32x32x16_bf16(kb, qr[0], pn1, 0, 0, 0); }
            float mt = 0.f, mu = 0.f;
            if constexpr (!NOMAX) { mt = max3f(pc0[0], pc0[1], pc1[0]); mu = max3f(pc0[2], pc0[3], pc1[1]);
            mt = max3f(mt, pc1[2], pc1[3]);
#pragma unroll
            for (int r = 4; r < 16; r += 4) { mt = max3f(mt, pc0[r], pc0[r + 1]); mu = max3f(mu, pc0[r + 2], pc0[r + 3]); mt = max3f(mt, pc1[r], pc1[r + 1]); mu = max3f(mu, pc1[r + 2], pc1[r + 3]); } }
            if (more) { pn0 = __builtin_amdgcn_mfma_f32_32x32x16_bf16(kc, qr[1], pn0, 0, 0, 0); pn1 = __builtin_amdgcn_mfma_f32_32x32x16_bf16(kd, qr[1], pn1, 0, 0, 0); }
            ka = AT_KFRAG(Kn, 2, 0); kb = AT_KFRAG(Kn, 2, 1); kc = AT_KFRAG(Kn, 3, 0); kd = AT_KFRAG(Kn, 3, 1);
            if constexpr (!NOMAX) mt = xhalf_max(fmaxf(mt, mu));
            if (!NOMAX && __any(mt > m + THR)) {
                const float mn = fmaxf(m, mt), alpha = __builtin_amdgcn_exp2f(m - mn); m = mn; l *= alpha;
                if (hi == 0) wsf[r32] = alpha;
                LDS_WAIT();
#pragma unroll
                for (int r = 0; r < 16; ++r) { const float a = wsf[crow(r, hi)]; o0[r] *= a; o1[r] *= a; }
            }
            SB();
            if (more) { pn0 = __builtin_amdgcn_mfma_f32_32x32x16_bf16(ka, qr[2], pn0, 0, 0, 0); pn1 = __builtin_amdgcn_mfma_f32_32x32x16_bf16(kb, qr[2], pn1, 0, 0, 0); }
            float ls = 0.f;
#pragma unroll
            for (int r = 0; r < 8; ++r) { pc0[r] = __builtin_amdgcn_exp2f(NOMAX ? pc0[r] : pc0[r] - m); ls += pc0[r]; }
            SB();
            if (more) { pn0 = __builtin_amdgcn_mfma_f32_32x32x16_bf16(kc, qr[3], pn0, 0, 0, 0); pn1 = __builtin_amdgcn_mfma_f32_32x32x16_bf16(kd, qr[3], pn1, 0, 0, 0); }
            ka = AT_KFRAG(Kn, 4, 0); kb = AT_KFRAG(Kn, 4, 1); kc = AT_KFRAG(Kn, 5, 0); kd = AT_KFRAG(Kn, 5, 1);
#pragma unroll
            for (int r = 8; r < 16; ++r) { pc0[r] = __builtin_amdgcn_exp2f(NOMAX ? pc0[r] : pc0[r] - m); ls += pc0[r]; }
            SB();
            if (more) { pn0 = __builtin_amdgcn_mfma_f32_32x32x16_bf16(ka, qr[4], pn0, 0, 0, 0); pn1 = __builtin_amdgcn_mfma_f32_32x32x16_bf16(kb, qr[4], pn1, 0, 0, 0); }
#pragma unroll
            for (int r = 0; r < 8; ++r) { pc1[r] = __builtin_amdgcn_exp2f(NOMAX ? pc1[r] : pc1[r] - m); ls += pc1[r]; }
            SB();
            if (more) { pn0 = __builtin_amdgcn_mfma_f32_32x32x16_bf16(kc, qr[5], pn0, 0, 0, 0); pn1 = __builtin_amdgcn_mfma_f32_32x32x16_bf16(kd, qr[5], pn1, 0, 0, 0); }
#pragma unroll
            for (int r = 8; r < 16; ++r) { pc1[r] = __builtin_amdgcn_exp2f(NOMAX ? pc1[r] : pc1[r] - m); ls += pc1[r]; }
            l += ls;
            SB();
            const LAS unsigned char* Vb = lds + AT2_V + buf * AT_VB + vrd;
            s16x4 l0 = vtr(Vb), h0 = vtr(Vb + 512), l1 = vtr(Vb + 4096), h1 = vtr(Vb + 4096 + 512);
#pragma unroll
            for (int ks = 0; ks < 4; ++ks) {
                u32x4 w;
#pragma unroll
                for (int q = 0; q < 4; ++q) { const int r = (ks & 1) * 8 + 2 * q; w[q] = (ks < 2) ? pg8::cvt_pk_bf16(pc0[r], pc0[r + 1]) : pg8::cvt_pk_bf16(pc1[r], pc1[r + 1]); }
                const bf16x8 pw = __builtin_bit_cast(bf16x8, w);
                const bf16x8 v0 = (bf16x8){l0[0], l0[1], l0[2], l0[3], h0[0], h0[1], h0[2], h0[3]}, v1 = (bf16x8){l1[0], l1[1], l1[2], l1[3], h1[0], h1[1], h1[2], h1[3]};
                if (ks < 3) { l0 = vtr(Vb + (ks + 1) * 1024); h0 = vtr(Vb + (ks + 1) * 1024 + 512); l1 = vtr(Vb + 4096 + (ks + 1) * 1024); h1 = vtr(Vb + 4096 + (ks + 1) * 1024 + 512); }
                o0 = __builtin_amdgcn_mfma_f32_32x32x16_bf16(pw, v0, o0, 0, 0, 0); o1 = __builtin_amdgcn_mfma_f32_32x32x16_bf16(pw, v1, o1, 0, 0, 0);
                SB();
            }
            pc0 = pn0; pc1 = pn1;
            __syncthreads();
        }
        l = xhalf_sum(l);
        if (hi == 0) wsf[32 + r32] = l;
        LDS_WAIT();
        LAS bf16* stl = (LAS bf16*)(lds + AT2_OST + wid * 4096);
#pragma unroll
        for (int r = 0; r < 16; ++r) { const int orow = crow(r, hi); const float rl = 1.0f / wsf[32 + orow];
            stl[orow * 64 + r32] = (bf16)f2bf(o0[r] * rl); stl[orow * 64 + 32 + r32] = (bf16)f2bf(o1[r] * rl); }
        LDS_WAIT();
        const size_t orow0 = (size_t)b * SEQ + qb * 256 + wid * 32;
#pragma unroll
        for (int q = 0; q < 4; ++q) { const int row = q * 8 + (lane >> 3), ch = lane & 7; const u32x4 v = *(const LAS u32x4*)(stl + row * 64 + ch * 8); *(u32x4*)(CAT + (orow0 + row) * 1024 + hd * 64 + ch * 8) = v; }
        __syncthreads();
    }
#undef SB
#undef AT_ROW0
#undef AT_DMAK
#undef AT_DMAV
#undef AT_KFRAG
}

constexpr int LC_BLKSTART = 128, LC_CNT = 704, LC_BLK2HE = 1216;
constexpr int RT_XH = RING_OFF, RT_XL = RT_XH + 16 * 1032 * 2, RT_LG = RT_XL + 16 * 1032 * 2, RT_MS = RT_LG + 2 * 16 * 64 * 4, RT_KEYS = RT_MS + 2 * 1024 * 4, RT_LCNT = RT_KEYS + 16 * 64 * 4, RT_GBASE = RT_LCNT + 64 * 4  , RT_ST = RT_GBASE + 512  , RT_END = RT_ST + 16 * 1024 * 4;
static_assert(RT_END <= LDS_BYTES && RT_ST % 16 == 0, "router LDS");

__device__ __forceinline__ void ph_router(const Ctx& C, const Params& P, const float* xin, int li, int cset) {
    LAS bf16* XH = (LAS bf16*)(C.lds + RT_XH); LAS bf16* XL = (LAS bf16*)(C.lds + RT_XL); LAS float* LG = (LAS float*)(C.lds + RT_LG);
    LAS float* MS = (LAS float*)(C.lds + RT_MS);
    LAS int* lcnt = (LAS int*)(C.lds + RT_LCNT); LAS int* gbase = (LAS int*)(C.lds + RT_GBASE);
    bf16* H = (bf16*)(P.ws + WS_H); const float* mod = (const float*)(P.ws + WS_MOD); float* TOPW = (float*)(P.ws + WS_TOPW); int* TOK = (int*)(P.ws + WS_TOK);
    unsigned* gcnt = (unsigned*)(P.ws + WS_CTL) + CW_CNT + (cset * 2) * 64 * 16;
    const float* RW = P.router_w + (size_t)li * 1024 * 64; const float* RB = P.router_b + li * 64;
    const int lane = C.lane, w = C.wave, eq = w & 3, kh = w >> 2, fi = lane & 15, fk = lane >> 4;
    constexpr int NT = T / 16;
    const int per = (NT + C.G - 1) / C.G, tbeg = C.bid * per, tend = (tbeg + per < NT) ? tbeg + per : NT;
    if (tbeg >= NT) return;
    bf16x8 bh[16], bl[16];
#pragma unroll
    for (int ks = 0; ks < 16; ++ks) { u32x4 wh, wl;
#pragma unroll
        for (int q = 0; q < 4; ++q) { const int k = kh * 512 + ks * 32 + 8 * fk + 2 * q; const float w0 = RW[(size_t)k * 64 + eq * 16 + fi], w1 = RW[(size_t)(k + 1) * 64 + eq * 16 + fi];
            const unsigned h0 = f2bf(w0), h1 = f2bf(w1); wh[q] = h0 | (h1 << 16); wl[q] = pk2(w0 - bf2f((unsigned short)h0), w1 - bf2f((unsigned short)h1)); }
        bh[ks] = __builtin_bit_cast(bf16x8, wh); bl[ks] = __builtin_bit_cast(bf16x8, wl);
        if ((ks & 3) == 3) asm volatile("" ::: "memory"); }
    const float rb = RB[lane];
    if (C.tid < 64) lcnt[C.tid] = 0;
    LAS float* ST = (LAS float*)(C.lds + RT_ST);
#define RT_LOADROWS(tile_) do { _Pragma("unroll") for (int rr = 0; rr < 2; ++rr) { const float* xr = xin + (size_t)((tile_) * 16 + 2 * w + rr) * 1024; \
        _Pragma("unroll") for (int j = 0; j < 4; ++j) __builtin_amdgcn_global_load_lds((const unsigned*)(xr + 256 * j + 4 * lane), (LAS unsigned*)(ST + (2 * w + rr) * 1024 + 256 * j), 16, 0, 0); } } while (0)
    RT_LOADROWS(tbeg);
    int plr[2] = {0, 0}, ptok[2] = {-1, -1}, phf = 0;
    int qlr[2] = {0, 0}, qtok[2] = {-1, -1}, qhf = 0;
    int gbv = 0, npend = 0, it = 0, bcur = -1;
    for (int tile = tbeg; tile < tend; ++tile) {
        const int t0 = tile * 16, hf = t0 >= HALF_T ? 1 : 0;
        if ((t0 >> 12) != bcur) { bcur = t0 >> 12; const float* m = mod + (size_t)(li * 8 + bcur) * 6144;
            __syncthreads();
            for (int i = C.tid; i < 1024; i += 512) { MS[i] = m[4096 + i] + 1.0f; MS[1024 + i] = m[3072 + i]; }
            __syncthreads(); }
        TACC_B(C, 1);
        f32x4 v[2][4];
        asm volatile("s_waitcnt vmcnt(0)" ::: "memory");
#pragma unroll
        for (int rr = 0; rr < 2; ++rr)
#pragma unroll
            for (int j = 0; j < 4; ++j) v[rr][j] = *(const LAS f32x4*)(ST + (2 * w + rr) * 1024 + 256 * j + 4 * lane);
        LDS_WAIT();
        if (tile + 1 < tend) RT_LOADROWS(tile + 1);
        float ss[2];
#pragma unroll
        for (int rr = 0; rr < 2; ++rr) { float s = 0.f;
#pragma unroll
            for (int j = 0; j < 4; ++j) s += (v[rr][j].x * v[rr][j].x + v[rr][j].y * v[rr][j].y) + (v[rr][j].z * v[rr][j].z + v[rr][j].w * v[rr][j].w);
            ss[rr] = s; }
#pragma unroll
        for (int o = 1; o < 64; o <<= 1) {
#pragma unroll
            for (int rr = 0; rr < 2; ++rr) ss[rr] += __shfl_xor(ss[rr], o); }
#pragma unroll
        for (int j = 0; j < 4; ++j) { const f32x4 a = *(const LAS f32x4*)(MS + 256 * j + 4 * lane), b = *(const LAS f32x4*)(MS + 1024 + 256 * j + 4 * lane);
#pragma unroll
            for (int rr = 0; rr < 2; ++rr) { const int i = 2 * w + rr; const float rstd = 1.0f / sqrtf(ss[rr] * (1.0f / 1024.0f) + EPS);
                const f32x4 y = v[rr][j] * rstd * a + b; u32x2 o; o.x = pk2(y.x, y.y); o.y = pk2(y.z, y.w);
                *(u32x2*)(H + (size_t)(t0 + i) * 1024 + 256 * j + 4 * lane) = o; *(LAS u32x2*)(XH + i * 1032 + 256 * j + 4 * lane) = o;
                u32x2 lo; lo.x = pk2(y.x - bflo(o.x), y.y - bfhi(o.x)); lo.y = pk2(y.z - bflo(o.y), y.w - bfhi(o.y)); *(LAS u32x2*)(XL + i * 1032 + 256 * j + 4 * lane) = lo; } }
        TACC_E(C, 1); TACC_B(C, 4);
        LBAR();
        TACC_E(C, 4); TACC_B(C, 2);
        if (npend == 2) {
#pragma unroll
            for (int rr = 0; rr < 2; ++rr) if (qtok[rr] >= 0) TOK[(size_t)(qhf * 64 + lane) * MOE_CAP + gbase[(it & 1) * 64 + lane] + qlr[rr]] = qtok[rr]; }
        { f32x4 acc0 = {0.f, 0.f, 0.f, 0.f}, acc1 = {0.f, 0.f, 0.f, 0.f}, acc2 = {0.f, 0.f, 0.f, 0.f};
#pragma unroll
          for (int ks = 0; ks < 16; ++ks) { const int ko = fi * 1032 + kh * 512 + ks * 32 + 8 * fk; const bf16x8 ah = *(const LAS bf16x8*)(XH + ko), al = *(const LAS bf16x8*)(XL + ko);
              acc0 = __builtin_amdgcn_mfma_f32_16x16x32_bf16(ah, bh[ks], acc0, 0, 0, 0); acc1 = __builtin_amdgcn_mfma_f32_16x16x32_bf16(ah, bl[ks], acc1, 0, 0, 0); acc2 = __builtin_amdgcn_mfma_f32_16x16x32_bf16(al, bh[ks], acc2, 0, 0, 0);
              if ((ks & 3) == 3) asm volatile("" ::: "memory"); }
          const f32x4 acc = acc0 + (acc1 + acc2);
#pragma unroll
          for (int r = 0; r < 4; ++r) LG[(kh * 16 + 4 * fk + r) * 64 + eq * 16 + fi] = acc[r]; }
        TACC_E(C, 2); TACC_B(C, 4);
        LBAR();
        TACC_E(C, 4); TACC_B(C, 3);
        if (npend >= 1) { if (C.tid < 64) gbase[((it - 1) & 1) * 64 + C.tid] = gbv;
#pragma unroll
            for (int rr = 0; rr < 2; ++rr) { qlr[rr] = plr[rr]; qtok[rr] = ptok[rr]; } qhf = phf; }
        float sc[2], wsum[2]; int rank[2];
#pragma unroll
        for (int rr = 0; rr < 2; ++rr) { const int i = 2 * w + rr; sc[rr] = sigmf(LG[i * 64 + lane] + LG[(16 + i) * 64 + lane]);
            const unsigned key = (__builtin_bit_cast(unsigned, sc[rr] + rb + 1.0f) & ~63u) | (unsigned)(63 - lane);
            unsigned thr = 0u;
#pragma unroll
            for (int bit = 31; bit >= 0; --bit) { const unsigned cand = thr | (1u << bit); if (__popcll(__ballot(key >= cand)) >= TOPK) thr = cand; }
            unsigned long long selm = __ballot(key >= thr); int rk = 0; float ws = 0.f;
#pragma unroll
            for (int k = 0; k < TOPK; ++k) { const int jl = __ffsll((long long)selm) - 1; selm &= selm - 1;
                const unsigned kj = (unsigned)__builtin_amdgcn_readlane((int)key, jl); ws += __builtin_bit_cast(float, __builtin_amdgcn_readlane(__builtin_bit_cast(int, sc[rr]), jl)); rk += (kj > key) ? 1 : 0; }
            rank[rr] = (key >= thr) ? rk : 64; wsum[rr] = ws; }
#pragma unroll
        for (int rr = 0; rr < 2; ++rr) { const int i = 2 * w + rr; ptok[rr] = -1;
            if (rank[rr] < TOPK) { TOPW[(size_t)(t0 + i) * 8 + rank[rr]] = sc[rr] / wsum[rr] * 2.5f; ptok[rr] = (t0 + i) * 8 + rank[rr];
                plr[rr] = __hip_atomic_fetch_add(&lcnt[lane], 1, __ATOMIC_RELAXED, __HIP_MEMORY_SCOPE_WORKGROUP); } }
        phf = hf; npend = npend < 2 ? npend + 1 : 2;
        TACC_E(C, 3); TACC_B(C, 4);
        LBAR();
        TACC_E(C, 4);
        if (C.tid < 64) { const int n = lcnt[C.tid]; lcnt[C.tid] = 0; gbv = n > 0 ? (int)__hip_atomic_fetch_add(gcnt + (hf * 64 + C.tid) * 16, (unsigned)n, RLX_AGENT) : 0; }
        ++it;
    }
    __syncthreads();
    if (npend == 2) {
#pragma unroll
        for (int rr = 0; rr < 2; ++rr) if (qtok[rr] >= 0) TOK[(size_t)(qhf * 64 + lane) * MOE_CAP + gbase[(it & 1) * 64 + lane] + qlr[rr]] = qtok[rr]; }
    if (npend >= 1 && C.tid < 64) gbase[((it - 1) & 1) * 64 + C.tid] = gbv;
    __syncthreads();
    if (npend >= 1) {
#pragma unroll
        for (int rr = 0; rr < 2; ++rr) if (ptok[rr] >= 0) TOK[(size_t)(phf * 64 + lane) * MOE_CAP + gbase[((it - 1) & 1) * 64 + lane] + plr[rr]] = ptok[rr]; }
    __syncthreads();
#undef RT_LOADROWS
}

__device__ __forceinline__ int moe_tables(const Ctx& C, const Params& P, int li) {
    LAS int* blkstart = (LAS int*)(C.lds + LC_BLKSTART); LAS int* cnt = (LAS int*)(C.lds + LC_CNT); LAS unsigned short* blk2he = (LAS unsigned short*)(C.lds + LC_BLK2HE);
    const unsigned* gcnt = (const unsigned*)(P.ws + WS_CTL) + CW_CNT + (li * 2) * 64 * 16;
    __syncthreads();
    if (C.tid < 128) { int n = (int)__hip_atomic_load(gcnt + C.tid * 16, RLX_AGENT); n = n < 0 ? 0 : (n > MOE_CAP ? MOE_CAP : n); cnt[C.tid] = n; }
    __syncthreads();
    if (C.tid == 0) { int s = 0; for (int i = 0; i < 128; ++i) { blkstart[i] = s; s += (cnt[i] + 255) >> 8; } blkstart[128] = s; }
    __syncthreads();
    const int nblk = blkstart[128];
    if (C.tid < 128) { const int b0 = blkstart[C.tid], b1 = blkstart[C.tid + 1]; for (int b = b0; b < b1 && b < MAXBLK; ++b) blk2he[b] = (unsigned short)C.tid; }
    __syncthreads();
    return nblk < MAXBLK ? nblk : MAXBLK;
}
struct SchedMoE1 {
    const char* H; const char* W1; const int* TOK; const LAS int* blkstart; const LAS unsigned short* blk2he; int nblk, G, c;
    __device__ __forceinline__ bool next(int i, Unit& u) const { int L = i * G + c;
        if (L < 2 * nblk) { const int blk = L >> 1, pn = L & 1, he = blk2he[blk], bi = blk - blkstart[he], e = he & 63; u.A = H; u.rows = TOK + (size_t)he * MOE_CAP + bi * 256;
            u.B = W1 + ((size_t)e * 512 + pn * 256) * 2048; u.pm = blk; u.pn = pn; u.z = 0; return true; }
        L -= 2 * nblk; if (L >= 256) return false; u.pm = L >> 1; u.pn = L & 1; u.z = 1; u.A = H + (size_t)u.pm * 256 * 2048; u.rows = nullptr; u.B = W1 + ((size_t)64 * 512 + u.pn * 256) * 2048; return true; }
};
struct EpiMoE1 {
    static constexpr bool PERM = true; bf16* HID; bf16* HIDS;
    __device__ __forceinline__ void operator()(EPI_ARGS) const { bf16* O = u.z ? HIDS : HID;
#pragma unroll
        for (int ai = 0; ai < 2; ++ai)
#pragma unroll
            for (int m = 0; m < 4; ++m) { const size_t row = (size_t)u.pm * 256 + ai * 128 + wr * 64 + m * 16 + fr; f32x4 v0, v1;
#pragma unroll
                for (int j = 0; j < 4; ++j) { v0[j] = siluf(acc[ai][0][m][0][j]) * acc[ai][1][m][0][j]; v1[j] = siluf(acc[ai][0][m][1][j]) * acc[ai][1][m][1][j]; }
                *(u32x4*)(O + row * 256 + u.pn * 128 + wc * 32 + 8 * fq) = pack8(v0, v1); }
    }
};
struct SchedMoE2 {
    const char* HID; const char* W2; const LAS unsigned short* blk2he; int b0, b1, G, c;
    __device__ __forceinline__ bool next(int i, Unit& u) const { const int L = i * G + c; if (L >= (b1 - b0) * 4) return false; const int blk = b0 + (L >> 2), pn = L & 3, he = blk2he[blk], e = he & 63;
        u.A = HID + (size_t)blk * 256 * 512; u.rows = nullptr; u.B = W2 + ((size_t)e * 1024 + pn * 256) * 512; u.pm = blk; u.pn = pn; u.z = he; return true; }
};
struct EpiMoE2 {
    static constexpr bool PERM = true; bf16* YBUF; const int* TOK; const LAS int* blkstart; const LAS int* cnt; int hf;
    __device__ __forceinline__ void operator()(EPI_ARGS) const { const int he = u.z, bi = u.pm - blkstart[he], n = cnt[he]; const bool odd = fr & 1;
        int tvE[2][4], tvO[2][4];
#pragma unroll
        for (int ai = 0; ai < 2; ++ai)
#pragma unroll
            for (int m = 0; m < 4; ++m) { const int r0 = bi * 256 + ai * 128 + wr * 64 + m * 16 + (fr & ~1); tvE[ai][m] = TOK[(size_t)he * MOE_CAP + r0]; tvO[ai][m] = TOK[(size_t)he * MOE_CAP + r0 + 1]; }
#pragma unroll
        for (int ai = 0; ai < 2; ++ai)
#pragma unroll
            for (int m = 0; m < 4; ++m) { const int r0 = bi * 256 + ai * 128 + wr * 64 + m * 16 + (fr & ~1);
                u32x4 A, B; widen_pair(pack8(acc[ai][0][m][0], acc[ai][0][m][1]), pack8(acc[ai][1][m][0], acc[ai][1][m][1]), odd, A, B);
                const int coff = u.pn * 256 + wc * 64 + (odd ? 32 : 0) + 8 * fq;
                if (r0 < n) { const int v = tvE[ai][m]; *(u32x4*)(YBUF + ((size_t)((v >> 3) - hf * HALF_T) * 6 + (v & 7)) * 1024 + coff) = A; }
                if (r0 + 1 < n) { const int v = tvO[ai][m]; *(u32x4*)(YBUF + ((size_t)((v >> 3) - hf * HALF_T) * 6 + (v & 7)) * 1024 + coff) = B; } }
    }
};
struct EpiNull {
    static constexpr bool PERM = true;
    __device__ __forceinline__ void operator()(EPI_ARGS) const {
#pragma unroll
        for (int ai = 0; ai < 2; ++ai)
#pragma unroll
            for (int m = 0; m < 4; ++m)
#pragma unroll
                for (int bj = 0; bj < 2; ++bj) { asm volatile("" :: "v"(acc[ai][bj][m][0]), "v"(acc[ai][bj][m][1])); }
    }
};
template <bool FUSE> struct EpiCombine {
    static constexpr bool PERM = true; const bf16* YBUF; const float* TOPW; float* X; const float* gate; int hf; float* XO;
    bf16* HS; float* SSP; const float* scl; LAS float* red;
    __device__ __forceinline__ void operator()(EPI_ARGS) const { const bool odd = fr & 1;
#pragma unroll
        for (int ai = 0; ai < 2; ++ai)
#pragma unroll
            for (int m = 0; m < 4; ++m) { const int th = u.pm * 256 + ai * 128 + wr * 64 + m * 16 + fr, token = hf * HALF_T + th;
                const f32x4 w03 = *(const f32x4*)(TOPW + (size_t)token * 8), w47 = *(const f32x4*)(TOPW + (size_t)token * 8 + 4); const float wk[6] = {w03.x, w03.y, w03.z, w03.w, w47.x, w47.y};
                float ssq = 0.f;
#pragma unroll
                for (int bj = 0; bj < 2; ++bj) { const int col0 = u.pn * 256 + wc * 64 + bj * 32 + 8 * fq; f32x4 v0 = acc[ai][bj][m][0], v1 = acc[ai][bj][m][1];
#pragma unroll
                    for (int k = 0; k < 6; ++k) { const u32x4 y = *(const u32x4*)(YBUF + ((size_t)th * 6 + k) * 1024 + col0);
                        v0[0] += wk[k] * bflo(y.x); v0[1] += wk[k] * bfhi(y.x); v0[2] += wk[k] * bflo(y.y); v0[3] += wk[k] * bfhi(y.y);
                        v1[0] += wk[k] * bflo(y.z); v1[1] += wk[k] * bfhi(y.z); v1[2] += wk[k] * bflo(y.w); v1[3] += wk[k] * bfhi(y.w); }
                    const float* gp = gate + (size_t)(token >> 12) * 6144 + col0; float* xp = X + (size_t)token * 1024 + col0;
                    const f32x4 g0 = *(const f32x4*)gp, g1 = *(const f32x4*)(gp + 4), x0 = *(const f32x4*)xp, x1 = *(const f32x4*)(xp + 4);
                    const f32x4 n0 = x0 + g0 * v0, n1 = x1 + g1 * v1;
                    float* xo = XO + (size_t)token * 1024 + col0; *(f32x4*)xo = n0; *(f32x4*)(xo + 4) = n1;
                    if constexpr (FUSE) { const float* sp = scl + (size_t)(token >> 12) * 6144 + col0; const f32x4 a0 = *(const f32x4*)sp + 1.0f, a1 = *(const f32x4*)(sp + 4) + 1.0f;
                        ssq += (n0[0] * n0[0] + n0[1] * n0[1]) + (n0[2] * n0[2] + n0[3] * n0[3]) + (n1[0] * n1[0] + n1[1] * n1[1]) + (n1[2] * n1[2] + n1[3] * n1[3]);
                        *(u32x4*)(HS + (size_t)token * 1024 + col0) = pack8(n0 * a0, n1 * a1); } }
                if constexpr (FUSE) { (void)odd;
                    ssq += __shfl_xor(ssq, 16); ssq += __shfl_xor(ssq, 32); red[(ai * 128 + wr * 64 + m * 16 + fr) * 4 + wc] = ssq; } }
        if constexpr (FUSE) {
            asm volatile("s_waitcnt lgkmcnt(0)" ::: "memory"); __builtin_amdgcn_s_barrier(); asm volatile("" ::: "memory");
            if (threadIdx.x < 256) { const f32x4 r4 = *(const LAS f32x4*)(red + threadIdx.x * 4); SSP[(size_t)u.pn * T + hf * HALF_T + u.pm * 256 + threadIdx.x] = (r4[0] + r4[1]) + (r4[2] + r4[3]); }
            asm volatile("s_waitcnt lgkmcnt(0)" ::: "memory"); __builtin_amdgcn_s_barrier(); asm volatile("" ::: "memory");
        }
    }
};
struct EpiHyIn {
    static constexpr bool PERM = true; bf16* O; const float* SSP; const float* SHW;
    __device__ __forceinline__ void operator()(EPI_ARGS) const { const bool odd = fr & 1;
        float rs[2][4]; f32x4 bw[2][2];
        { const float* bp = SHW + (size_t)((u.pm * 256) >> 12) * 3072 + u.pn * 256 + wc * 64 + 8 * fq;
#pragma unroll
          for (int bj = 0; bj < 2; ++bj) { bw[bj][0] = *(const f32x4*)(bp + bj * 32); bw[bj][1] = *(const f32x4*)(bp + bj * 32 + 4); } }
#pragma unroll
        for (int ai = 0; ai < 2; ++ai)
#pragma unroll
            for (int m = 0; m < 4; ++m) { const size_t row = (size_t)u.pm * 256 + ai * 128 + wr * 64 + m * 16 + fr;
                rs[ai][m] = (SSP[row] + SSP[T + row]) + (SSP[2 * (size_t)T + row] + SSP[3 * (size_t)T + row]); }
#pragma unroll
        for (int ai = 0; ai < 2; ++ai)
#pragma unroll
            for (int m = 0; m < 4; ++m) { const size_t row = (size_t)u.pm * 256 + ai * 128 + wr * 64 + m * 16 + fr; const float r = 1.0f / sqrtf(rs[ai][m] * (1.0f / 1024.0f) + EPS); u32x4 d[2];
#pragma unroll
                for (int bj = 0; bj < 2; ++bj) d[bj] = pack8(acc[ai][bj][m][0] * r + bw[bj][0], acc[ai][bj][m][1] * r + bw[bj][1]);
                u32x4 A, B; widen_pair(d[0], d[1], odd, A, B);
                bf16* op = O + (row & ~(size_t)1) * 3072 + u.pn * 256 + wc * 64 + (odd ? 32 : 0) + 8 * fq; *(u32x4*)op = A; *(u32x4*)(op + 3072) = B; }
    }
};
__device__ __forceinline__ void ph_shw(const Ctx& C, const Params& P, int item0, int istride) {
    LAS float* sc = (LAS float*)(C.lds + RING_OFF);
    LAS float* red = sc + 8 * 1024;
    const float* mod1 = (const float*)(P.ws + WS_MOD) + (size_t)8 * 6144; float* SHW = (float*)(P.ws + WS_SHW);
    if (item0 >= 48) return;
    __syncthreads();
    for (int i = C.tid; i < 8 * 1024; i += 512) sc[i] = mod1[(size_t)(i >> 10) * 6144 + (i & 1023)];
    __syncthreads();
    for (int item = item0; item < 48; item += istride) {
        const int j0 = item * 64, c4 = C.tid & 15, kp = C.tid >> 4;
        f32x4 a[8];
#pragma unroll
        for (int r = 0; r < 8; ++r) a[r] = (f32x4){0.f, 0.f, 0.f, 0.f};
        const float* w = P.hy_w_in + j0 + 4 * c4;
#pragma unroll 8
        for (int k = kp * 32; k < kp * 32 + 32; ++k) { const f32x4 wv = *(const f32x4*)(w + (size_t)k * 3072);
#pragma unroll
            for (int r = 0; r < 8; ++r) a[r] += wv * sc[r * 1024 + k]; }
#pragma unroll
        for (int r = 0; r < 8; ++r) *(LAS f32x4*)(red + (kp * 8 + r) * 64 + 4 * c4) = a[r];
        __syncthreads();
        { const int r = C.tid >> 6, cc = C.tid & 63; float s2 = 0.f;
#pragma unroll 8
          for (int q = 0; q < 32; ++q) s2 += red[(q * 8 + r) * 64 + cc];
          SHW[(size_t)r * 3072 + j0 + cc] = s2; }
        __syncthreads();
    }
}

__device__ __forceinline__ void ph_hy_prep(const Ctx& C, const Params& P) {
    const bf16* PP = (const bf16*)(P.ws + AR_P); bf16* X0 = (bf16*)(P.ws + AR_X0); bf16* ZT = (bf16*)(P.ws + AR_ZT);
    LAS bf16* ZS = (LAS bf16*)(C.lds + RING_OFF);
    const int tl = C.tid >> 3, d8 = (C.tid & 7) * 8;
    if (C.G % 16 != 0) return;
    const int dt = C.bid & 15, d0 = dt * 64, nwg = C.G >> 4;
    float cw[3][3][8], cb[3][8];
#pragma unroll
    for (int sec = 0; sec < 3; ++sec) {
#pragma unroll
        for (int e = 0; e < 8; ++e) { cb[sec][e] = P.hy_conv_b[sec * 1024 + d0 + d8 + e];
#pragma unroll
            for (int j = 0; j < 3; ++j) cw[sec][j][e] = P.hy_conv_w[j * 3072 + sec * 1024 + d0 + d8 + e]; } }
    u32x4 g[3][3];
#define HP_LOAD(step_) do { const int it_ = (step_) >> 1, b_ = 2 * (it_ >> 6) + ((step_) & 1), t_ = (it_ & 63) * 64 + tl; \
        _Pragma("unroll") for (int j = 0; j < 3; ++j) { const int tt = t_ - 1 + j; const bool ok = tt >= 0 && tt < SEQ; const size_t r_ = (size_t)b_ * SEQ + (ok ? tt : t_); \
            _Pragma("unroll") for (int sec = 0; sec < 3; ++sec) { g[sec][j] = *(const u32x4*)(PP + r_ * 3072 + sec * 1024 + d0 + d8); if (!ok) g[sec][j] = (u32x4){0u, 0u, 0u, 0u}; } } } while (0)
    constexpr int NSTEP = 2 * 4 * 64;
    int step = 2 * (C.bid >> 4), par = 0;
    if (step < NSTEP) HP_LOAD(step);
    for (; step < NSTEP; ) {
        const int it = step >> 1, q = step & 1, bp = it >> 6, b = 2 * bp + q, t0 = (it & 63) * 64, t = t0 + tl; const size_t row = (size_t)b * SEQ + t;
        float o[3][8];
#pragma unroll
        for (int sec = 0; sec < 3; ++sec) {
#pragma unroll
            for (int e = 0; e < 8; ++e) o[sec][e] = cb[sec][e];
#pragma unroll
            for (int j = 0; j < 3; ++j) { const u32x4 w = g[sec][j];
                o[sec][0] += bflo(w.x) * cw[sec][j][0]; o[sec][1] += bfhi(w.x) * cw[sec][j][1]; o[sec][2] += bflo(w.y) * cw[sec][j][2]; o[sec][3] += bfhi(w.y) * cw[sec][j][3];
                o[sec][4] += bflo(w.z) * cw[sec][j][4]; o[sec][5] += bfhi(w.z) * cw[sec][j][5]; o[sec][6] += bflo(w.w) * cw[sec][j][6]; o[sec][7] += bfhi(w.w) * cw[sec][j][7]; } }
        const int nstep = q == 0 ? step + 1 : step + 2 * nwg - 1;
        if (nstep < NSTEP) HP_LOAD(nstep);
        { u32x4 w; w.x = pk2(o[0][0], o[0][1]); w.y = pk2(o[0][2], o[0][3]); w.z = pk2(o[0][4], o[0][5]); w.w = pk2(o[0][6], o[0][7]); *(u32x4*)(X0 + row * 1024 + d0 + d8) = w; }
        LAS bf16* zs = ZS + par * (64 * 136);
#pragma unroll
        for (int e = 0; e < 8; ++e) zs[(d8 + e) * 136 + tl * 2 + q] = (bf16)f2bf(o[2][e] * o[1][e]);
        if (q == 1) {
            LBAR();
            { const int dl = C.tid >> 3, tp = (C.tid & 7) * 8; const u32x4 w0 = *(const LAS u32x4*)(zs + dl * 136 + tp * 2), w1 = *(const LAS u32x4*)(zs + dl * 136 + tp * 2 + 8);
              bf16* zo = ZT + (((size_t)(d0 + dl) * 4 + bp) * SEQ + t0 + tp) * 2; *(u32x4*)zo = w0; *(u32x4*)(zo + 8) = w1; }
            par ^= 1;
        }
        step = nstep;
    }
#undef HP_LOAD
    __syncthreads();
}

__device__ __forceinline__ f32x2 cmul(f32x2 a, f32x2 b) { return (f32x2){a.x * b.x - a.y * b.y, a.x * b.y + a.y * b.x}; }
__device__ __forceinline__ f32x2 cmulc(f32x2 a, f32x2 b) { return (f32x2){a.x * b.x + a.y * b.y, a.y * b.x - a.x * b.y}; }
template <bool INV> __device__ __forceinline__ void dft16(f32x2 (&v)[16]) {
    constexpr float WC[10] = {1.f, 0.9238795325112867f, 0.7071067811865476f, 0.3826834323650898f, 0.f, 0.f, -0.7071067811865476f, 0.f, 0.f, -0.9238795325112867f};
    constexpr float WS_[10] = {0.f, 0.3826834323650898f, 0.7071067811865476f, 0.9238795325112867f, 1.f, 0.f, 0.7071067811865476f, 0.f, 0.f, -0.3826834323650898f};
    f32x2 t[16];
#pragma unroll
    for (int b = 0; b < 4; ++b) { const f32x2 x0 = v[b], x1 = v[4 + b], x2 = v[8 + b], x3 = v[12 + b];
        const f32x2 s0 = x0 + x2, s1 = x0 - x2, s2 = x1 + x3, s3 = x1 - x3; const f32x2 is3 = (f32x2){-s3.y, s3.x};
        t[0 * 4 + b] = s0 + s2; t[2 * 4 + b] = s0 - s2; t[1 * 4 + b] = INV ? s1 + is3 : s1 - is3; t[3 * 4 + b] = INV ? s1 - is3 : s1 + is3; }
#pragma unroll
    for (int c = 1; c < 4; ++c)
#pragma unroll
        for (int b = 1; b < 4; ++b) { const int mm = b * c; const f32x2 w = (f32x2){WC[mm], WS_[mm]}; t[c * 4 + b] = INV ? cmul(t[c * 4 + b], w) : cmulc(t[c * 4 + b], w); }
#pragma unroll
    for (int c = 0; c < 4; ++c) { const f32x2 x0 = t[c * 4], x1 = t[c * 4 + 1], x2 = t[c * 4 + 2], x3 = t[c * 4 + 3];
        const f32x2 s0 = x0 + x2, s1 = x0 - x2, s2 = x1 + x3, s3 = x1 - x3; const f32x2 is3 = (f32x2){-s3.y, s3.x};
        v[c] = s0 + s2; v[c + 8] = s0 - s2; v[c + 4] = INV ? s1 + is3 : s1 - is3; v[c + 12] = INV ? s1 - is3 : s1 + is3; }
}
constexpr int FF_TW = RING_OFF, FF_TW2 = FF_TW + 32768, FF_DE = FF_TW2 + 32768, FF_DO = FF_DE + 4352 * 8, FF_RED = FF_DO + 4352 * 8, FF_ZST = FF_RED + 64  , FF_END = FF_ZST + 16384;
static_assert(FF_END <= LDS_BYTES, "FFT LDS");
__device__ __forceinline__ int pidx(int i) { return i + (i >> 4); }
__device__ __forceinline__ void fft_fwd(LAS f32x2* D, const LAS f32x2* TW, int t8, f32x2 (&v)[16]) {
#pragma unroll
    for (int a = 0; a < 16; ++a) v[a] = D[pidx(256 * a + t8)];
    dft16<false>(v);
    { const int n1 = t8 >> 4;
#pragma unroll
      for (int k0 = 0; k0 < 16; ++k0) D[pidx(256 * k0 + t8)] = cmul(v[k0], TW[(16 * n1 * k0) & 4095]); }
    LBAR();
    { const int k0 = t8 >> 4, n0 = t8 & 15;
#pragma unroll
      for (int a = 0; a < 16; ++a) v[a] = D[pidx(256 * k0 + 16 * a + n0)];
      dft16<false>(v);
#pragma unroll
      for (int k1 = 0; k1 < 16; ++k1) D[pidx(256 * k0 + 16 * k1 + n0)] = cmul(v[k1], TW[(n0 * (k0 + 16 * k1)) & 4095]); }
    LBAR();
#pragma unroll
    for (int a = 0; a < 16; ++a) v[a] = D[pidx(16 * t8 + a)];
    dft16<false>(v);
}
__device__ __forceinline__ void fft_inv(LAS f32x2* D, const LAS f32x2* TW, int t8, f32x2 (&v)[16]) {
    dft16<true>(v);
    { const int kk = t8;
      const int kq = (kk >> 4) + 16 * (kk & 15);
#pragma unroll
      for (int n0 = 0; n0 < 16; ++n0) D[pidx(16 * t8 + n0)] = cmulc(v[n0], TW[(n0 * kq) & 4095]); }
    LBAR();
    { const int k0 = t8 >> 4, n0 = t8 & 15;
#pragma unroll
      for (int a = 0; a < 16; ++a) v[a] = D[pidx(256 * k0 + 16 * a + n0)];
      dft16<true>(v);
#pragma unroll
      for (int n1 = 0; n1 < 16; ++n1) D[pidx(256 * k0 + 16 * n1 + n0)] = cmulc(v[n1], TW[(16 * n1 * k0) & 4095]); }
    LBAR();
#pragma unroll
    for (int a = 0; a < 16; ++a) v[a] = D[pidx(256 * a + t8)];
    dft16<true>(v);
#pragma unroll
    for (int a = 0; a < 16; ++a) D[pidx(256 * a + t8)] = v[a];
    LBAR();
}
__device__ __forceinline__ void ph_hy_fft(const Ctx& C, const Params& P) {
    LAS f32x2* TW = (LAS f32x2*)(C.lds + FF_TW); LAS f32x2* TW2 = (LAS f32x2*)(C.lds + FF_TW2); LAS f32x2* DE = (LAS f32x2*)(C.lds + FF_DE); LAS f32x2* DO = (LAS f32x2*)(C.lds + FF_DO); LAS float* RED = (LAS float*)(C.lds + FF_RED);
    const float* HFT = (const float*)(P.ws + WS_HFT); const unsigned* ZT2 = (const unsigned*)(P.ws + AR_ZT); unsigned* YT2 = (unsigned*)(P.ws + AR_YT);
    const int br = C.tid >> 8, t8 = C.tid & 255; LAS f32x2* D = br ? DO : DE;
    LAS unsigned* ZST = (LAS unsigned*)(C.lds + FF_ZST);
#define FF_DMA(bp_) do { _Pragma("unroll") for (int q_ = 0; q_ < 2; ++q_) __builtin_amdgcn_global_load_lds(ZT2 + ((size_t)d * 4 + (bp_)) * SEQ + (C.wave * 2 + q_) * 256 + C.lane * 4, ZST + (C.wave * 2 + q_) * 256, 16, 0, 0); } while (0)
    for (int i = C.tid; i < 4096; i += 512) { float s, c; sincosf(6.283185307179586f * (float)i / 4096.0f, &s, &c); TW[i] = (f32x2){c, -s}; sincosf(6.283185307179586f * (float)i / 8192.0f, &s, &c); TW2[i] = (f32x2){c, -s}; }
    __syncthreads();
    for (int d = C.bid; d < 1024; d += C.G) {
        const float* hf = HFT + (size_t)d * 2 * 4096; const float* hb = hf + 4096;
        FF_DMA(0);
        float ss = 0.f;
#pragma unroll
        for (int a = 0; a < 16; ++a) { const int n = 256 * a + t8; const float f = hf[n], g = hb[n == 0 ? 0 : 4096 - n]; ss += f * f + g * g;
            D[pidx(n)] = br == 0 ? (f32x2){f + g, 0.f} : (n == 0 ? (f32x2){f + g, 0.f} : (f32x2){(f - g) * TW2[n].x, (f - g) * TW2[n].y}); }
        ss = wave_sum(ss); if (C.lane == 0) RED[C.wave] = ss;
        __syncthreads();
        const float scale = 1.0f / sqrtf(RED[0] + RED[1] + RED[2] + RED[3] + EPS);
        f32x2 v[16]; const float bias = P.hy_bias[d];
        fft_fwd(D, TW, t8, v);
        f32x2* HSP = (f32x2*)(P.ws + AR_HSP) + (size_t)C.bid * 8192 + br * 4096 + t8;
#pragma unroll
        for (int a = 0; a < 16; ++a) { f32x2 hv = v[a] * scale; hv.x += bias; HSP[a * 256] = hv; }
        for (int bp = 0; bp < 4; ++bp) {
            __syncthreads();
#pragma unroll
            for (int a = 0; a < 16; ++a) { const int n = 256 * a + t8; const unsigned zw = ZST[n]; const f32x2 zc = (f32x2){bflo(zw), bfhi(zw)}; D[pidx(n)] = br == 0 ? zc : cmul(zc, TW2[n]); }
            LBAR();
            if (bp < 3) FF_DMA(bp + 1);
            fft_fwd(D, TW, t8, v);
#pragma unroll
            for (int a = 0; a < 16; ++a) v[a] = cmul(v[a], HSP[a * 256]);
            fft_inv(D, TW, t8, v);
            unsigned* yo = YT2 + ((size_t)d * 4 + bp) * SEQ;
#pragma unroll
            for (int j = 0; j < 8; ++j) { const int n = C.tid + 512 * j; const f32x2 ye = DE[pidx(n)], yo2 = DO[pidx(n)]; const f32x2 y = (ye + cmulc(yo2, TW2[n])) * (1.0f / 8192.0f);
                yo[n] = pk2(y.x, y.y); }
        }
        __syncthreads();
    }
#undef FF_DMA
}
__device__ __forceinline__ void ph_hy_gate(const Ctx& C, const Params& P) {
    const bf16* X0 = (const bf16*)(P.ws + AR_X0); const bf16* YT = (const bf16*)(P.ws + AR_YT); bf16* AO = (bf16*)(P.ws + WS_H);
    LAS bf16* TS = (LAS bf16*)(C.lds + RING_OFF);
    const int dl = C.tid >> 3, tp = (C.tid & 7) * 8;
    const int tl = C.tid >> 3, d8 = (C.tid & 7) * 8;
    constexpr int NIT = 4 * 64 * 16;
    u32x4 gy0, gy1, gx0, gx1;
#define HG_LOAD(item_) do { const int dt_ = (item_) & 15, it_ = (item_) >> 4, bp_ = it_ >> 6, t0_ = (it_ & 63) * 64, d0_ = dt_ * 64; \
        const bf16* yp_ = YT + (((size_t)(d0_ + dl) * 4 + bp_) * SEQ + t0_ + tp) * 2; gy0 = *(const u32x4*)yp_; gy1 = *(const u32x4*)(yp_ + 8); \
        gx0 = *(const u32x4*)(X0 + ((size_t)(2 * bp_) * SEQ + t0_ + tl) * 1024 + d0_ + d8); gx1 = *(const u32x4*)(X0 + ((size_t)(2 * bp_ + 1) * SEQ + t0_ + tl) * 1024 + d0_ + d8); } while (0)
    int item = C.bid, par = 0;
    if (item < NIT) HG_LOAD(item);
    for (; item < NIT; item += C.G) {
        const int dt = item & 15, it = item >> 4, bp = it >> 6, t0 = (it & 63) * 64, d0 = dt * 64;
        LAS bf16* ts = TS + par * (2 * 64 * 72);
        { const unsigned w[8] = {gy0.x, gy0.y, gy0.z, gy0.w, gy1.x, gy1.y, gy1.z, gy1.w};
#pragma unroll
          for (int e = 0; e < 8; ++e) { ts[(tp + e) * 72 + dl] = (bf16)(w[e] & 0xffff); ts[64 * 72 + (tp + e) * 72 + dl] = (bf16)(w[e] >> 16); } }
        const u32x4 x0 = gx0, x1 = gx1;
        if (item + C.G < NIT) HG_LOAD(item + C.G);
        LBAR();
#pragma unroll
        for (int q = 0; q < 2; ++q) { const u32x4 x = q ? x1 : x0; const size_t o = ((size_t)(2 * bp + q) * SEQ + t0 + tl) * 1024 + d0 + d8; const u32x4 y = *(const LAS u32x4*)(ts + q * 64 * 72 + tl * 72 + d8);
          u32x4 w; w.x = pk2(bflo(x.x) * bflo(y.x), bfhi(x.x) * bfhi(y.x)); w.y = pk2(bflo(x.y) * bflo(y.y), bfhi(x.y) * bfhi(y.y)); w.z = pk2(bflo(x.z) * bflo(y.z), bfhi(x.z) * bfhi(y.z)); w.w = pk2(bflo(x.w) * bflo(y.w), bfhi(x.w) * bfhi(y.w));
          *(u32x4*)(AO + o) = w; }
        par ^= 1;
    }
#undef HG_LOAD
    __syncthreads();
}
struct EpiStoreBf16 {
    static constexpr bool PERM = true; bf16* O; int ldc;
    __device__ __forceinline__ void operator()(EPI_ARGS) const { const bool odd = fr & 1;
#pragma unroll
        for (int ai = 0; ai < 2; ++ai)
#pragma unroll
            for (int m = 0; m < 4; ++m) { const size_t rowE = (size_t)u.pm * 256 + ai * 128 + wr * 64 + m * 16 + (fr & ~1); u32x4 A, B; widen_pair(pack8(acc[ai][0][m][0], acc[ai][0][m][1]), pack8(acc[ai][1][m][0], acc[ai][1][m][1]), odd, A, B);
                bf16* op = O + rowE * ldc + u.pn * 256 + wc * 64 + (odd ? 32 : 0) + 8 * fq; *(u32x4*)op = A; *(u32x4*)(op + ldc) = B; }
    }
};

__global__ void __launch_bounds__(512, 2) fwd_kernel(Params P) {
    extern __shared__ __attribute__((aligned(16))) unsigned char lds_raw[];
    Ctx C; C.tacc = 0; C.tbeg = 0; C.lds = (LAS unsigned char*)lds_raw; C.tid = threadIdx.x; C.lane = C.tid & 63; C.wave = __builtin_amdgcn_readfirstlane(C.tid >> 6); C.G = gridDim.x; C.bid = blockIdx.x;
    const int vcu = (C.G % 8 == 0) ? (C.bid % 8) * (C.G / 8) + C.bid / 8 : C.bid;
    for (int i = C.tid; i < LDS_CTL_BYTES / 4; i += 512) ((LAS unsigned*)C.lds)[i] = 0u;
    __syncthreads();
    unsigned char* ws = P.ws;
#if N_LAUNCH_MODE == 1
    XcdBarrier bar = xcd_barrier_post((unsigned*)(ws + WS_CTL) + CW_BAR, (volatile LAS unsigned*)(C.lds + 32));
#define SEAM(k) do { if (IN(k) && IN((k) + 1)) xcd_barrier(bar); EVT((k) + 1); } while (0)
#else
#define SEAM(k) do { EVT((k) + 1); } while (0)
#endif
#ifndef DUP_ID
#define DUP_ID -1
#endif
#ifndef DUP_MASK
#define DUP_MASK 0u
#endif
#define DUP(id, ...) do { __VA_ARGS__; if (DUP_ID == (id) || ((DUP_MASK >> (id)) & 1u)) { __syncthreads(); __VA_ARGS__; } } while (0)
#define TS_AMP 8
    unsigned long long tsA = 0, tsB = 0;
#define EVT(id) do { if (TS_FROM == (id)) tsA = wall_clock64(); if (TS_TO == (id)) tsB = wall_clock64(); } while (0)
    EVT(0);
    const int lo = P.ph_lo, hi = P.ph_hi;
#ifndef PH_MASK
#define PH_MASK 0xffffffffu
#endif
#define IN(k) (((PH_MASK >> (k)) & 1u) && lo <= (k) && (k) < hi)
    LAS unsigned char* ring = C.lds + RING_OFF;
    const float* mod = (const float*)(ws + WS_MOD);

    if (IN(0)) { ph_mod(C, P); __syncthreads(); EVT(100); ph_conv_l0(C, P); __syncthreads(); ph_s5_tables(C, P, C.G - 1 - C.bid, C.G); } SEAM(0);
    if (IN(1)) { DUP(1, ph_norm(C, P, P.x, 0, 0, true)); } SEAM(1);
    if (IN(2)) { SchedDense S{(const char*)(ws + WS_H), (const char*)(ws + WS_WIN), 2048u, 2048u, TA / 256, 4, C.G, vcu}; EpiInProj E{(bf16*)(ws + AR_PROJ), (bf16*)(ws + AR_U)};
        pg8::gemm_phase(ring, 1024, 2048u, 2048u, S, E);
        const int nfree = C.G - (TA / 256 * 4 - 2 * C.G);
        if (C.G == 256 && vcu >= C.G - nfree) { const int r = vcu - (C.G - nfree); ph_conv_l0b(C, P, r * 8 + C.wave, nfree * 8); }
        else if (C.G != 256) { ph_conv_l0b(C, P, C.bid * 8 + C.wave, C.G * 8); } } SEAM(2);
    if (IN(3)) { ph_rownorm1(C, P); EVT(103);
        SchedBatched S{(const char*)(ws + AR_U), (const char*)(ws + WS_SOUT), 1536u, 1024u, (size_t)S5ROWS * 1536, (size_t)256 * 1024, S5G, 5, 1, C.G, vcu}; EpiF32Batched E{(float*)(ws + AR_SRAW), S5ROWS, 256};
        DUP(3, pg8::gemm_phase(ring, 512, 1536u, 1024u, S, E)); } SEAM(3);
    if (IN(4)) { SchedUp S{(const char*)(ws + AR_QN), (const char*)(ws + WS_WUQ), (const char*)(ws + AR_CKV), (const char*)(ws + WS_WUKV), C.G, vcu}; EpiUp E{(bf16*)(ws + AR_QRAW), (bf16*)(ws + AR_KVRAW)};
        DUP(4, pg8::gemm_phase(ring, 256, 512u, 512u, S, E); ph_s5_scan(C, P)); } SEAM(4);
    if (IN(5)) { ph_qkfinal(C, P); EVT(105);
        SchedBatched S{(const char*)(ws + AR_U), (const char*)(ws + WS_WG), 1536u, 1536u, (size_t)S5ROWS * 1536, (size_t)512 * 1536, S5G, 4, 2, C.G, vcu}; EpiS5C E{(bf16*)(ws + AR_Z)};
        DUP(5, pg8::gemm_phase(ring, 768, 1536u, 1536u, S, E)); } SEAM(5);
    if (IN(6)) { float gqm = 0.f, gkm = 0.f;
        for (int j = 0; j < QKH; ++j) { gqm = fmaxf(gqm, fabsf(P.q_qk[j])); gkm = fmaxf(gkm, fabsf(P.k_qk[j])); }
        const float sbound = 96.0f * gqm * gkm * (0.10206207261596577f * 1.4426950408889634f) * 1.02f;
        if (sbound < 90.0f) ph_attention<true>(C, P, vcu); else ph_attention<false>(C, P, vcu);
        EVT(106);
        SchedDense S{(const char*)(ws + AR_Z), (const char*)(ws + WS_WGLU), 1024u, 1024u, T / 256, 2, C.G, vcu}; EpiGlu E{(const bf16*)(ws + AR_Z), P.glu_b, (bf16*)(ws + AR_CAT)};
        DUP(26, pg8::gemm_phase(ring, 512, 1024u, 1024u, S, E)); } SEAM(6);
    if (IN(7)) { SchedDense S{(const char*)(ws + AR_CAT), (const char*)(ws + WS_WOUT), 2048u, 2048u, T / 256, 4, C.G, vcu}; EpiResid E{P.x, P.out, mod + 2048};
        pg8::gemm_phase(ring, 1024, 2048u, 2048u, S, E); } SEAM(7);
#define MOE_LAYER(li, pb) do { \
        if (IN(pb)) { ph_conv_moe(C, P, li); __syncthreads(); EVT(110 + li); ph_router(C, P, P.out, li, li); if ((DUP_MASK >> 27) & 1u) { __syncthreads(); ph_router(C, P, P.out, li, 2 + li); } } SEAM(pb); \
        if (IN(pb + 1)) { const int nblk = moe_tables(C, P, li); \
            SchedMoE1 S{(const char*)(ws + WS_H), (const char*)(ws + AR_W1), (const int*)(ws + WS_TOK), (const LAS int*)(C.lds + LC_BLKSTART), (const LAS unsigned short*)(C.lds + LC_BLK2HE), nblk, C.G, vcu}; \
            EpiMoE1 E{(bf16*)(ws + AR_HID), (bf16*)(ws + AR_HIDS)}; \
            DUP(pb + 1, pg8::gemm_phase(ring, 1024, 2048u, 2048u, S, E)); \
            if (TS_FROM == 210 && li == 0) { __syncthreads(); EVT(210); EpiNull EN{}; pg8::gemm_phase(ring, 1024, 2048u, 2048u, S, EN); EVT(211); } \
            if (TS_FROM == 212 && li == 0) { __syncthreads(); EVT(212); pg8::gemm_phase(ring, 1024, 2048u, 2048u, S, E); EVT(213); } \
            if (li == 0) {   \
                const int total = 2 * nblk + 256, rem = total % C.G, nshort = rem == 0 ? C.G : C.G - rem, r = rem == 0 ? vcu : vcu - rem; \
                if (r >= 0) { ph_shw(C, P, r, nshort); ph_hy_filter(C, P, r, nshort); ph_conv_l1(C, P, r * 8 + C.wave, nshort * 8); } } \
            } SEAM(pb + 1); \
        MOE_HALF(li, pb, 0); MOE_HALF(li, pb, 1); } while (0)
#define MOE_HALF(li, pb, hf) do { \
            if (IN(pb + 2 + 2 * hf)) { (void)moe_tables(C, P, li); const LAS int* bs = (const LAS int*)(C.lds + LC_BLKSTART); \
                SchedMoE2 S{(const char*)(ws + AR_HID), (const char*)(ws + AR_W2), (const LAS unsigned short*)(C.lds + LC_BLK2HE), bs[hf * 64], bs[hf * 64 + 64], C.G, vcu}; \
                EpiMoE2 E{(bf16*)(ws + AR_YBUF), (const int*)(ws + WS_TOK), bs, (const LAS int*)(C.lds + LC_CNT), hf}; \
                pg8::gemm_phase(ring, 256, 512u, 512u, S, E); } SEAM(pb + 2 + 2 * hf); \
            if (IN(pb + 3 + 2 * hf)) { SchedDense S{(const char*)(ws + AR_HIDS) + (size_t)hf * HALF_T * 512, (const char*)(ws + AR_W2) + (size_t)64 * 1024 * 512, 512u, 512u, HALF_T / 256, 4, C.G, vcu}; \
                EpiCombine<li == 0> E{(const bf16*)(ws + AR_YBUF), (const float*)(ws + WS_TOPW), P.out, mod + (size_t)li * 8 * 6144 + 5120, hf, P.out, (bf16*)(ws + WS_H), (float*)(ws + WS_SSP), mod + (size_t)8 * 6144 + 1024, (LAS float*)(C.lds + RING_OFF + pg8::STAGE_BYTES)}; \
                pg8::gemm_phase(ring, 256, 512u, 512u, S, E); \
                } SEAM(pb + 3 + 2 * hf); } while (0)
    MOE_LAYER(0, 8);
    if (IN(15)) { SchedDense S{(const char*)(ws + WS_H), (const char*)(ws + WS_WHIN), 2048u, 2048u, T / 256, 12, C.G, vcu}; EpiHyIn E{(bf16*)(ws + AR_P), (const float*)(ws + WS_SSP), (const float*)(ws + WS_SHW)};
        DUP(15, pg8::gemm_phase(ring, 1024, 2048u, 2048u, S, E)); } SEAM(15);
    if (IN(16)) { DUP(16, ph_hy_prep(C, P)); } SEAM(16);
    if (IN(17)) { DUP(17, ph_hy_fft(C, P)); } SEAM(17);
    if (IN(18)) { DUP(18, ph_hy_gate(C, P)); } SEAM(18);
    if (IN(19)) { SchedDense S{(const char*)(ws + WS_H), (const char*)(ws + WS_WHOUT), 2048u, 2048u, T / 256, 4, C.G, vcu}; EpiResid E{P.out, P.out, mod + (size_t)8 * 6144 + 2048};
        pg8::gemm_phase(ring, 1024, 2048u, 2048u, S, E); } SEAM(19);
    MOE_LAYER(1, 20);
    if ((TS_FROM >= 0 || TS_ACC >= 0) && C.bid == 0 && C.tid == 0) { const unsigned long long t0 = wall_clock64(), need = (TS_ACC >= 0 ? C.tacc : (tsB - tsA)) * TS_AMP; while (wall_clock64() - t0 < need) __builtin_amdgcn_s_sleep(8); }
#undef IN
#undef SEAM
}

extern "C" void kernel_launch(void* const* d_in, const int* in_sizes, int n_in, void* d_out, int out_size, void* d_ws, size_t ws_size, hipStream_t stream) {
    static int grid = 0;
    if (grid == 0) {
        if (n_in != 43 || out_size != T * DM || ws_size < WS_END) { fprintf(stderr, "kernel_launch: unexpected shapes (n_in %d, out %d, ws %zu, need %zu)\n", n_in, out_size, ws_size, (size_t)WS_END); grid = -1; return; }
        int dev = 0, cus = 0, per_cu = 0;
        if (hipGetDevice(&dev) != hipSuccess || hipDeviceGetAttribute(&cus, hipDeviceAttributeMultiprocessorCount, dev) != hipSuccess) { grid = -1; return; }
        if (hipFuncSetAttribute((const void*)fwd_kernel, hipFuncAttributeMaxDynamicSharedMemorySize, LDS_BYTES) != hipSuccess) { fprintf(stderr, "kernel_launch: hipFuncSetAttribute failed\n"); grid = -1; return; }
        if (hipOccupancyMaxActiveBlocksPerMultiprocessor(&per_cu, (const void*)fwd_kernel, 512, LDS_BYTES) != hipSuccess || per_cu < 1) fprintf(stderr, "kernel_launch: occupancy query says %d\n", per_cu);
        (void)hipGetLastError();
        grid = cus;
    }
    if (grid < 0) return;
    (void)hipMemsetAsync((char*)d_ws + WS_CTL, 0, CTL_ZERO_BYTES, stream);
    Params p{};
    const float** pp = (const float**)&p;
    for (int i = 0; i < 43; ++i) pp[i] = (const float*)d_in[i];
    p.out = (float*)d_out; p.ws = (unsigned char*)d_ws;
#if N_LAUNCH_MODE == 1
    p.ph_lo = 0; p.ph_hi = NPHASE;
    hipLaunchKernelGGL(fwd_kernel, dim3(grid), dim3(512), LDS_BYTES, stream, p);
#else
    static const int order[NPHASE] = {0, 1, 2, 3, 4, 5, 6, 7, 8, 9, 10, 11, 12, 13, 14, 15, 16, 17, 18, 19, 20, 21, 22, 23, 24, 25};
    for (int k = 0; k < NPHASE; ++k) { p.ph_lo = order[k]; p.ph_hi = order[k] + 1; hipLaunchKernelGGL(fwd_kernel, dim3(grid), dim3(512), LDS_BYTES, stream, p); }
#endif
}
```

```cpp
#include <hip/hip_runtime.h>
#include <cstdio>
#include <cstdint>
#include <cmath>

#define TS_FROM -1
#define TS_TO -1
#ifndef N_LAUNCH_MODE
#define N_LAUNCH_MODE 1
#endif

#define GAS __attribute__((address_space(1)))
#define LAS __attribute__((address_space(3)))
typedef unsigned short bf16;
typedef short bf16x8 __attribute__((ext_vector_type(8)));
typedef short s16x4 __attribute__((ext_vector_type(4)));
typedef float f32x4 __attribute__((ext_vector_type(4)));
typedef float f32x2 __attribute__((ext_vector_type(2)));
typedef float f32x16 __attribute__((ext_vector_type(16)));
typedef unsigned u32x4 __attribute__((ext_vector_type(4)));
typedef unsigned u32x2 __attribute__((ext_vector_type(2)));
typedef GAS unsigned gu32;
#define RLX_AGENT __ATOMIC_RELAXED, __HIP_MEMORY_SCOPE_AGENT
#define LDS_WAIT() asm volatile("s_waitcnt lgkmcnt(0)" ::: "memory")
#define VM_WAIT() asm volatile("s_waitcnt vmcnt(0)" ::: "memory")
#define LBAR() do { asm volatile("s_waitcnt lgkmcnt(0)" ::: "memory"); __builtin_amdgcn_s_barrier(); asm volatile("" ::: "memory"); } while (0)

constexpr int DM = 1024, NB = 8, SEQ = 4096, CTXL = 256, T = NB * SEQ  , TC = NB * CTXL  , TA = T + TC  ;
constexpr int NHEAD = 8, QKH = 96, VH = 64, QLORA = 256, KVLORA = 128, QKROPE = 32, QKNOPE = 64;
constexpr int S5W = 512, S5G = 32, S5H = 16, S5P = 64, S5TC = 32  , S5NCH = SEQ / S5TC  , S5NCC = CTXL / S5TC  ;
constexpr int S5ROWS = 1280  , S5K = 768  ;
constexpr int EVEN_IN = 928, UOFF = 416;
constexpr int NEXP = 64, TOPK = 6, EFF = 256;
constexpr float EPS = 1e-6f;
constexpr int HALF_T = T / 2;
constexpr int MOE_CAP = HALF_T;
constexpr int MAXBLK = 2 * ((HALF_T * TOPK) / 256 + NEXP);

__device__ __forceinline__ unsigned f2bf(float f) { unsigned u = __builtin_bit_cast(unsigned, f); return (u + 0x7fffu + ((u >> 16) & 1u)) >> 16; }
__device__ __forceinline__ unsigned pk2(float lo, float hi) { return f2bf(lo) | (f2bf(hi) << 16); }
__device__ __forceinline__ float bf2f(unsigned short b) { return __builtin_bit_cast(float, ((unsigned)b) << 16); }
__device__ __forceinline__ float bflo(unsigned w) { return __builtin_bit_cast(float, w << 16); }
__device__ __forceinline__ float bfhi(unsigned w) { return __builtin_bit_cast(float, w & 0xffff0000u); }
__device__ __forceinline__ float wave_sum(float v) {
#pragma unroll
    for (int o = 1; o < 64; o <<= 1) v += __shfl_xor(v, o);
    return v;
}
__device__ __forceinline__ float siluf(float x) { return x / (1.0f + __expf(-x)); }
__device__ __forceinline__ float sigmf(float x) { return 1.0f / (1.0f + __expf(-x)); }
__device__ __forceinline__ float gelu_tanh(float x) { const float u = 0.7978845608028654f * (x + 0.044715f * x * x * x); const float e = __expf(2.0f * u); return x * (1.0f - 1.0f / (e + 1.0f)); }

namespace pg8 {
constexpr int BM = 256, BK = 64, HALF = 128, HTB = HALF * BK * 2  , STAGE_BYTES = 8 * HTB;
__host__ __device__ __forceinline__ int lds_byte(int r, int c) { const int st = (r >> 4) * 2 + (c >> 5), rr = r & 15, cc = c & 31, ob = rr * 64 + cc * 2; return st * 1024 + (ob ^ (((ob >> 9) & 1) << 5)); }
__host__ __device__ __forceinline__ void stage_rc(int b, int& R, int& C) { const int st = b / 1024, sb = b % 1024, swz = sb ^ (((sb >> 9) & 1) << 5); R = (st >> 1) * 16 + swz / 64; C = (st & 1) * 32 + (swz % 64) / 2; }
__host__ __device__ __forceinline__ int perm32(int rho) { const int n = rho >> 4, i = rho & 15; return 8 * (i >> 2) + 4 * n + (i & 3); }

struct Unit { const char* A; const char* B; const int* rows; int pm, pn, z; };

__device__ __forceinline__ unsigned cvt_pk_bf16(float lo, float hi) { unsigned r; asm volatile("v_cvt_pk_bf16_f32 %0, %1, %2" : "=v"(r) : "v"(lo), "v"(hi)); return r; }

template <bool ALIGN_EPI = true, class Epi, class Sched>
__device__ __forceinline__ void gemm_phase(LAS unsigned char* lds, const int K, const unsigned lda, const unsigned ldb, const Sched& S, const Epi& E) {
    const int tid = threadIdx.x, wid = __builtin_amdgcn_readfirstlane(tid >> 6), lane = tid & 63, wr = wid >> 2, wc = wid & 3, fr = lane & 15, fq = lane >> 4;
    const int nt = K / BK;
    int Ri[2], Ci[2]; unsigned voffB[2][2];
#pragma unroll
    for (int i = 0; i < 2; ++i) { int R, C; stage_rc(tid * 16 + i * 8192, R, C); Ri[i] = R; Ci[i] = C;
        const int Rb0 = Epi::PERM ? (64 * (R >> 5) + perm32(R & 31)) : R, Rb1 = Epi::PERM ? (Rb0 + 32) : (R + HALF);
        voffB[0][i] = (unsigned)Rb0 * ldb + (unsigned)C * 2u; voffB[1][i] = (unsigned)Rb1 * ldb + (unsigned)C * 2u; }
    const size_t kstep = (size_t)(BK * 2);
    const unsigned ldsw = (unsigned)wid * 1024u;
    const int aoff = lds_byte(wr * 64 + fr, fq * 8), boff = lds_byte(wc * 32 + fr, fq * 8);
#define PG8_SA(b, h) (((b) * 2 + (h)) * HTB)
#define PG8_SB(b, h) ((4 + (b) * 2 + (h)) * HTB)
#define PG8_STAGE(bufoff, gbase, voff) do { _Pragma("unroll") for (int _i = 0; _i < 2; ++_i) \
        __builtin_amdgcn_global_load_lds((const unsigned*)((const char*)(gbase) + (voff)[_i]), (LAS unsigned*)(lds + (bufoff) + ldsw + _i * 8192), 16, 0, 0); } while (0)
#define PG8_LDA(dst, b, h) do { _Pragma("unroll") for (int m = 0; m < 4; ++m) _Pragma("unroll") for (int k = 0; k < 2; ++k) dst[m][k] = *(const LAS bf16x8*)(lds + PG8_SA(b, h) + aoff + m * 2048 + k * 1024); } while (0)
#define PG8_LDB(dst, b, h) do { _Pragma("unroll") for (int n = 0; n < 2; ++n) _Pragma("unroll") for (int k = 0; k < 2; ++k) dst[n][k] = *(const LAS bf16x8*)(lds + PG8_SB(b, h) + boff + n * 2048 + k * 1024); } while (0)
#define PG8_MMA(ai, bj, At, Bt) do { __builtin_amdgcn_s_setprio(1); _Pragma("unroll") for (int m = 0; m < 4; ++m) _Pragma("unroll") for (int n = 0; n < 2; ++n) _Pragma("unroll") for (int k = 0; k < 2; ++k) \
        acc[ai][bj][m][n] = __builtin_amdgcn_mfma_f32_16x16x32_bf16(Bt[n][k], At[m][k], acc[ai][bj][m][n], 0, 0, 0); __builtin_amdgcn_s_setprio(0); } while (0)
#define PG8_WAIT_V(n) asm volatile("s_waitcnt vmcnt(" #n ")" ::: "memory")
#define PG8_WAIT_L(n) asm volatile("s_waitcnt lgkmcnt(" #n ")" ::: "memory")
#define PG8_BAR __builtin_amdgcn_s_barrier()
#define PG8_SCHED __builtin_amdgcn_sched_barrier(0)
#define PG8_AOFF(dst, u) do { if ((u).rows) { _Pragma("unroll") for (int _h = 0; _h < 2; ++_h) _Pragma("unroll") for (int _i = 0; _i < 2; ++_i) \
            { unsigned _t = (unsigned)(u).rows[_h * HALF + Ri[_i]] >> 3; _t = _t < (unsigned)(T - 1) ? _t : (unsigned)(T - 1); dst[_h][_i] = _t * lda + (unsigned)Ci[_i] * 2u; } } \
        else { _Pragma("unroll") for (int _h = 0; _h < 2; ++_h) _Pragma("unroll") for (int _i = 0; _i < 2; ++_i) dst[_h][_i] = (unsigned)(_h * HALF + Ri[_i]) * lda + (unsigned)Ci[_i] * 2u; } } while (0)
    Unit cur, nxt; int ui = 0;
    if (!S.next(0, cur)) return;
    f32x4 acc[2][2][4][2];
#pragma unroll
    for (int a = 0; a < 2; ++a)
#pragma unroll
        for (int b = 0; b < 2; ++b)
#pragma unroll
            for (int m = 0; m < 4; ++m)
#pragma unroll
                for (int n = 0; n < 2; ++n) acc[a][b][m][n] = (f32x4){0.f, 0.f, 0.f, 0.f};
    bf16x8 At[4][2], B0[2][2], B1[2][2];
    unsigned vA[2][2], vN[2][2];
    PG8_AOFF(vA, cur);
    const char* cA = cur.A; const char* cB = cur.B;
    PG8_STAGE(PG8_SB(0, 0), cB, voffB[0]); PG8_STAGE(PG8_SB(0, 1), cB, voffB[1]); PG8_STAGE(PG8_SA(0, 0), cA, vA[0]); PG8_STAGE(PG8_SA(0, 1), cA, vA[1]);
    if (wr == 1) PG8_BAR;
    PG8_WAIT_V(2); PG8_BAR;
    PG8_STAGE(PG8_SB(1, 0), cB + kstep, voffB[0]); PG8_STAGE(PG8_SA(1, 0), cA + kstep, vA[0]); PG8_STAGE(PG8_SB(1, 1), cB + kstep, voffB[1]);
    PG8_WAIT_V(6); PG8_BAR;
    for (;;) {
        const bool has_next = S.next(ui + 1, nxt);
        if (has_next) { PG8_AOFF(vN, nxt); } else {
#pragma unroll
            for (int _h = 0; _h < 2; ++_h)
#pragma unroll
                for (int _i = 0; _i < 2; ++_i) vN[_h][_i] = vA[_h][_i]; }
        const char* nA = has_next ? nxt.A : cA; const char* nB = has_next ? nxt.B : cB;
#pragma nounroll
        for (int t = 0; t < nt; t += 2) {
            const bool last = (t == nt - 2);
            const char* a1 = cA + (size_t)(t + 1) * kstep;
            const char* a2 = last ? nA : cA + (size_t)(t + 2) * kstep; const char* b2 = last ? nB : cB + (size_t)(t + 2) * kstep;
            const char* a3 = a2 + kstep; const char* b3 = b2 + kstep;
            unsigned v2[2][2];
#pragma unroll
            for (int _h = 0; _h < 2; ++_h)
#pragma unroll
                for (int _i = 0; _i < 2; ++_i) v2[_h][_i] = last ? vN[_h][_i] : vA[_h][_i];
            PG8_LDB(B0, 0, 0); PG8_LDB(B1, 0, 1); PG8_SCHED; PG8_LDA(At, 0, 0); PG8_STAGE(PG8_SA(1, 1), a1, vA[1]);
            PG8_WAIT_V(8); PG8_WAIT_L(0); PG8_BAR; PG8_MMA(0, 0, At, B0); PG8_MMA(0, 1, At, B1); PG8_BAR; PG8_SCHED;
            PG8_LDA(At, 0, 1); PG8_STAGE(PG8_SB(0, 0), b2, voffB[0]); PG8_STAGE(PG8_SB(0, 1), b2, voffB[1]); PG8_STAGE(PG8_SA(0, 0), a2, v2[0]);
            PG8_WAIT_V(8); PG8_WAIT_L(0); PG8_BAR; PG8_MMA(1, 0, At, B0); PG8_MMA(1, 1, At, B1); PG8_BAR; PG8_SCHED;
            PG8_LDB(B0, 1, 0); PG8_LDB(B1, 1, 1); PG8_SCHED; PG8_LDA(At, 1, 0); PG8_STAGE(PG8_SA(0, 1), a2, v2[1]);
            PG8_WAIT_V(8); PG8_WAIT_L(0); PG8_BAR; PG8_MMA(0, 0, At, B0); PG8_MMA(0, 1, At, B1); PG8_BAR; PG8_SCHED;
            PG8_LDA(At, 1, 1); PG8_STAGE(PG8_SB(1, 0), b3, voffB[0]); PG8_STAGE(PG8_SB(1, 1), b3, voffB[1]); PG8_STAGE(PG8_SA(1, 0), a3, v2[0]);
            PG8_WAIT_V(8); PG8_WAIT_L(0); PG8_BAR; PG8_MMA(1, 0, At, B0); PG8_MMA(1, 1, At, B1); PG8_BAR; PG8_SCHED;
        }
        if constexpr (ALIGN_EPI) { if (wr == 0) PG8_BAR; }
        E(acc, cur, wr, wc, fr, fq);
        if (!has_next) break;
#pragma unroll
        for (int a = 0; a < 2; ++a)
#pragma unroll
            for (int b = 0; b < 2; ++b)
#pragma unroll
                for (int m = 0; m < 4; ++m)
#pragma unroll
                    for (int n = 0; n < 2; ++n) acc[a][b][m][n] = (f32x4){0.f, 0.f, 0.f, 0.f};
        cur = nxt; cA = nA; cB = nB; ++ui;
#pragma unroll
        for (int _h = 0; _h < 2; ++_h)
#pragma unroll
            for (int _i = 0; _i < 2; ++_i) vA[_h][_i] = vN[_h][_i];
        if constexpr (ALIGN_EPI) { if (wr == 1) PG8_BAR; }
    }
    PG8_WAIT_V(0);
    if constexpr (!ALIGN_EPI) { if (wr == 0) PG8_BAR; }
    PG8_BAR;
#undef PG8_SA
#undef PG8_SB
#undef PG8_STAGE
#undef PG8_LDA
#undef PG8_LDB
#undef PG8_MMA
#undef PG8_WAIT_V
#undef PG8_WAIT_L
#undef PG8_BAR
#undef PG8_SCHED
#undef PG8_AOFF
}
}

constexpr size_t MiB = 1u << 20;
constexpr size_t WS_CTL = 0, CTL_ZERO_BYTES = 1 * MiB;
constexpr size_t WS_MOD = 1 * MiB;
constexpr size_t WS_MODCTX = WS_MOD + 512 * 1024;
constexpr size_t WS_TOPW = 2 * MiB;
constexpr size_t WS_LAMT = 3 * MiB;
constexpr size_t WS_SSP = 12 * MiB;
constexpr size_t WS_SHW = 3 * MiB + 256 * 1024;
constexpr size_t WS_TOK = 4 * MiB;
constexpr size_t WS_H = 16 * MiB;
constexpr size_t WS_WS = 84 * MiB;
constexpr size_t WS_AR = 128 * MiB;
constexpr size_t WS_WIN = WS_WS, WS_WUQ = WS_WS + 2 * MiB, WS_WUKV = WS_WS + 2 * MiB + 512 * 1024, WS_WGLU = WS_WS + 3 * MiB, WS_WOUT = WS_WS + 4 * MiB;
constexpr size_t WS_SOUT = WS_WS + 6 * MiB;
constexpr size_t WS_WG = WS_WS + 14 * MiB;
constexpr size_t WS_WHIN = WS_WS, WS_WHOUT = WS_WS + 6 * MiB, WS_HFT = WS_WS + 8 * MiB;
constexpr size_t AR_PROJ = WS_AR, AR_U = WS_AR + 34 * MiB, AR_QN = WS_AR + 94 * MiB, AR_CKV = WS_AR + 110 * MiB, AR_QRAW = WS_AR + 127 * MiB,
                 AR_KVRAW = WS_AR + 175 * MiB, AR_KF = WS_AR + 243 * MiB, AR_SRAW = WS_AR + 294 * MiB, AR_Z = WS_AR + 334 * MiB, AR_CAT = WS_AR + 366 * MiB;
constexpr size_t AR_W1 = WS_AR, AR_W2 = WS_AR + 65 * MiB, AR_HID = WS_AR + 98 * MiB, AR_HIDS = WS_AR + 210 * MiB, AR_YBUF = WS_AR + 226 * MiB;
constexpr size_t AR_P = WS_AR, AR_X0 = WS_AR + 192 * MiB, AR_ZT = WS_AR + 256 * MiB, AR_YT = WS_AR + 320 * MiB;
constexpr size_t AR_HSP = WS_AR + 384 * MiB;
constexpr size_t WS_END = WS_AR + 430 * MiB;
static_assert(AR_U + (size_t)S5G * S5ROWS * S5K * 2 <= AR_QN && AR_QRAW + (size_t)T * 768 * 2 <= AR_KVRAW && AR_KVRAW + (size_t)TA * 1024 * 2 <= AR_KF && AR_KF + (size_t)TA * 768 * 2 <= AR_SRAW &&
              AR_SRAW + (size_t)S5G * S5ROWS * 256 * 4 <= AR_Z && AR_CAT + (size_t)T * 1024 * 2 <= WS_END && AR_CKV + (size_t)TA * 256 * 2 <= AR_QRAW && AR_PROJ + (size_t)TA * 512 * 2 <= AR_U, "arena L0");
static_assert(AR_W2 + (size_t)65 * 1024 * 256 * 2 <= AR_HID && AR_HID + (size_t)MAXBLK * 256 * 256 * 2 <= AR_HIDS && AR_HIDS + (size_t)T * 256 * 2 <= AR_YBUF && AR_YBUF + (size_t)HALF_T * 6 * 1024 * 2 <= WS_END, "arena MoE");
static_assert(WS_END <= 600 * MiB, "workspace budget");
constexpr int CW_TMO = 0, CW_CODE = 1;
constexpr int CW_BAR = 4096;
constexpr int CW_CNT = 32768;
constexpr int LDS_CTL_BYTES = 4096, RING_OFF = LDS_CTL_BYTES, LDS_BYTES = 160 * 1024;
constexpr int NPHASE = 26;

struct Params {
    const float *x, *c, *ctx, *c_ctx, *ada_w, *ada_b, *ev_w_in, *q_norm, *w_uq, *kv_norm, *w_ukv, *q_qk, *k_qk,
        *lam_re, *lam_im, *log_step, *b_re, *b_im, *c_re, *c_im, *s5_d, *glu_w, *glu_b, *ev_w_out,
        *hy_w_in, *hy_conv_w, *hy_conv_b, *f_w1, *f_b1, *f_w2, *f_b2, *f_w3, *f_freq, *hy_bias, *hy_w_out,
        *router_w, *router_b, *w_gate, *w_up, *w_down, *sh_gate, *sh_up, *sh_down;
    float* out; unsigned char* ws; int ph_lo, ph_hi;
};

#define XB_TMO      128
#define XB_XCNT(j)  (256  + 64 * (j))
#define XB_XSUB(j)  (1280 + 64 * (j))
#define XB_XGEN(j)  (2304 + 64 * (j))
#define XB_TOP      3328
#define XB_TOPGEN   3392
#define XCD_BAR_WORDS 3456
#define XB_SPIN_CAP (1u << 18)

__device__ __forceinline__ unsigned xb_ld(unsigned* p)              { return __hip_atomic_load(p, __ATOMIC_RELAXED, __HIP_MEMORY_SCOPE_AGENT); }
__device__ __forceinline__ unsigned xb_add(unsigned* p, unsigned v) { return __hip_atomic_fetch_add(p, v, __ATOMIC_RELAXED, __HIP_MEMORY_SCOPE_AGENT); }
__device__ __forceinline__ unsigned xb_xcc_id() { return (unsigned)__builtin_amdgcn_s_getreg((3 << 11) | 20) & 0xFu; }
#define XB_SPIN(cond, bar) do { unsigned _sp = 0; while (cond) { __builtin_amdgcn_s_sleep(1); \
    if ((++_sp & 255u) == 0u) { if (xb_ld(&(bar)[XB_TMO])) break; if (_sp > XB_SPIN_CAP) { atomicAdd(&(bar)[XB_TMO], 1u); break; } } } } while (0)

struct XcdBarrier {
    unsigned* bar; unsigned x;
    volatile LAS unsigned* st;
};

__device__ __forceinline__ XcdBarrier xcd_barrier_post(unsigned* bar, volatile LAS unsigned* st) {
    XcdBarrier b; b.bar = bar; b.x = xb_xcc_id(); b.st = st;
    if (threadIdx.x == 0) (void)xb_add(&bar[XB_XCNT(b.x)], 1u);
    return b;
}
__device__ __forceinline__ void xcd_barrier_complete(unsigned* bar, unsigned x, unsigned& nloc, unsigned& nx) {
    const unsigned G = gridDim.x * gridDim.y * gridDim.z;
    unsigned sum, cnt, mine, sp = 0u;
    for (;;) {
        sum = 0u; cnt = 0u; mine = 0u;
#pragma unroll
        for (unsigned j = 0; j < 16; ++j) { const unsigned c = xb_ld(&bar[XB_XCNT(j)]); sum += c; cnt += (c > 0u) ? 1u : 0u; mine = (j == x) ? c : mine; }
        if (sum == G) break;
        __builtin_amdgcn_s_sleep(1);
        if ((++sp & 255u) == 0u) { if (xb_ld(&bar[XB_TMO])) break; if (sp > XB_SPIN_CAP) { atomicAdd(&bar[XB_TMO], 1u); break; } }
    }
    nloc = mine > 0u ? mine : 1u; nx = cnt > 0u ? cnt : 1u;
}

__device__ __forceinline__ void xcd_barrier(const XcdBarrier& b) {
    asm volatile("s_waitcnt vmcnt(0)" ::: "memory");
    __syncthreads();
    if (threadIdx.x == 0) {
        unsigned* bar = b.bar;
        __builtin_amdgcn_s_waitcnt(0);
        unsigned nloc = b.st[0], nx = b.st[1];
        if (nloc == 0u) { xcd_barrier_complete(bar, b.x, nloc, nx); b.st[0] = nloc; b.st[1] = nx; }
        const unsigned old = xb_add(&bar[XB_XSUB(b.x)], 1u);
        const unsigned gen = old / nloc;
        if (old + 1u == (gen + 1u) * nloc) {
            __builtin_amdgcn_fence(__ATOMIC_RELEASE, "agent");
            asm volatile("s_waitcnt vmcnt(0)" ::: "memory");
            const unsigned og = xb_add(&bar[XB_TOP], 1u);
            const unsigned tg = og / nx;
            if (og + 1u == (tg + 1u) * nx) xb_add(&bar[XB_TOPGEN], 1u);
            else XB_SPIN(xb_ld(&bar[XB_TOPGEN]) == tg, bar);
            __builtin_amdgcn_fence(__ATOMIC_ACQUIRE, "agent");
            xb_add(&bar[XB_XGEN(b.x)], 1u);
            asm volatile("s_waitcnt vmcnt(0)" ::: "memory");
        } else {
            XB_SPIN(xb_ld(&bar[XB_XGEN(b.x)]) == gen, bar);
            __builtin_amdgcn_fence(__ATOMIC_ACQUIRE, "agent");
            asm volatile("s_waitcnt vmcnt(0)" ::: "memory");
        }
    }
    __syncthreads();
}

struct Ctx { LAS unsigned char* lds; int tid, lane, wave, G, bid; mutable unsigned long long tacc, tbeg; };
#define TS_ACC -1
#define TACC_B(C, id) do { if (TS_ACC == (id)) (C).tbeg = wall_clock64(); } while (0)
#define TACC_E(C, id) do { if (TS_ACC == (id)) (C).tacc += wall_clock64() - (C).tbeg; } while (0)

__device__ __forceinline__ void ph_mod(const Ctx& C, const Params& P) {
    if (C.bid >= 192) return;
    LAS float* sc = (LAS float*)(C.lds + RING_OFF);
    LAS float* red = sc + 9 * 1024;
    float* mod = (float*)(P.ws + WS_MOD); float* modctx = (float*)(P.ws + WS_MODCTX);
    for (int i = C.tid; i < 9 * 1024; i += 512) { const float v = (i < 8192) ? P.c[i] : P.c_ctx[i - 8192]; sc[i] = siluf(v); }
    __syncthreads();
    for (int item = C.bid; item < 192; item += C.G) {
        const int li = item / 96, j0 = (item % 96) * 64, c4 = C.tid & 15, kp = C.tid >> 4;
        f32x4 a[9];
#pragma unroll
        for (int r = 0; r < 9; ++r) a[r] = (f32x4){0.f, 0.f, 0.f, 0.f};
        const float* w = P.ada_w + (size_t)li * 1024 * 6144 + j0 + 4 * c4;
#pragma unroll 8
        for (int k = kp * 32; k < kp * 32 + 32; ++k) { const f32x4 wv = *(const f32x4*)(w + (size_t)k * 6144);
#pragma unroll
            for (int r = 0; r < 9; ++r) a[r] += wv * sc[r * 1024 + k]; }
#pragma unroll
        for (int r = 0; r < 9; ++r) *(LAS f32x4*)(red + (kp * 9 + r) * 64 + 4 * c4) = a[r];
        __syncthreads();
        for (int o = C.tid; o < 9 * 64; o += 512) { const int r = o >> 6, cc = o & 63; float s = P.ada_b[li * 6144 + j0 + cc];
#pragma unroll 8
            for (int q = 0; q < 32; ++q) s += red[(q * 9 + r) * 64 + cc];
            if (r < 8) mod[(size_t)(li * 8 + r) * 6144 + j0 + cc] = s; else if (li == 0 && j0 + cc < 2048) modctx[j0 + cc] = s; }
        __syncthreads();
    }
}

__device__ __forceinline__ void tr_item(const float* W, int ldw, bf16* WT, int ldt, int k0, int n0, int drow0, const float* gk, LAS float* scr, int lane) {
    f32x4 v[8]; const int c4 = (lane & 7) * 4;
#pragma unroll
    for (int j = 0; j < 8; ++j) v[j] = __builtin_nontemporal_load((const f32x4*)(W + (size_t)(k0 + 8 * j + (lane >> 3)) * ldw + n0 + c4));
#pragma unroll
    for (int j = 0; j < 8; ++j) { const int kk = 8 * j + (lane >> 3); const float g = gk ? gk[k0 + kk] : 1.0f; LAS float* d = scr + kk * 33 + c4; d[0] = v[j].x * g; d[1] = v[j].y * g; d[2] = v[j].z * g; d[3] = v[j].w * g; }
    LDS_WAIT(); asm volatile("" ::: "memory");
    const int c = lane & 7;
#pragma unroll
    for (int j = 0; j < 4; ++j) { const int n = (lane >> 3) + 8 * j; const LAS float* s = scr + (8 * c) * 33 + n;
        u32x4 o; o.x = pk2(s[0 * 33], s[1 * 33]); o.y = pk2(s[2 * 33], s[3 * 33]); o.z = pk2(s[4 * 33], s[5 * 33]); o.w = pk2(s[6 * 33], s[7 * 33]);
        *(u32x4*)(WT + (size_t)(drow0 + n) * ldt + k0 + 8 * c) = o; }
    LDS_WAIT(); asm volatile("" ::: "memory");
}
__device__ __forceinline__ void tr_matrix(const Ctx& C, const float* W, int K, int N, int ldw, bf16* WT, int ldt, int row_off, const float* gk, int gw, int NGW) {
    LAS float* scr = (LAS float*)(C.lds + RING_OFF + C.wave * 8448);
    const int nblk = N / 32, nit = (K / 64) * nblk;
    for (int it = gw; it < nit; it += NGW) { const int kb = it / nblk, nb = it % nblk; tr_item(W, ldw, WT, ldt, 64 * kb, 32 * nb, row_off + 32 * nb, gk, scr, C.lane); }
}
__device__ __forceinline__ void zero_bf16(bf16* p, size_t n, int gt, int NGT) { for (size_t i = (size_t)gt * 8; i < n; i += (size_t)NGT * 8) *(u32x4*)(p + i) = (u32x4){0u, 0u, 0u, 0u}; }

__device__ __forceinline__ void ph_conv_l0(const Ctx& C, const Params& P) {
    const int gw = C.bid * 8 + C.wave, NGW = C.G * 8, gt = C.bid * 512 + C.tid, NGT = C.G * 512;
    unsigned char* ws = P.ws;
    tr_matrix(C, P.ev_w_in, 1024, EVEN_IN, EVEN_IN, (bf16*)(ws + WS_WIN), 1024, 0, nullptr, gw, NGW);
    zero_bf16((bf16*)(ws + WS_WIN) + (size_t)EVEN_IN * 1024, (size_t)(1024 - EVEN_IN) * 1024, gt, NGT);
}
__device__ __forceinline__ void ph_conv_l0b(const Ctx& C, const Params& P, int gw, int NGW) {
    const int gt = gw * 64 + C.lane, NGT = NGW * 64; unsigned char* ws = P.ws;
    tr_matrix(C, P.w_uq, 256, 768, 768, (bf16*)(ws + WS_WUQ), 256, 0, P.q_norm, gw, NGW);
    tr_matrix(C, P.w_ukv, 128, 1024, 1024, (bf16*)(ws + WS_WUKV), 256, 0, P.kv_norm, gw, NGW);
    { bf16* w = (bf16*)(ws + WS_WUKV); for (int i = gt; i < 1024 * 16; i += NGT) { const int r = i >> 4, cq = i & 15; *(u32x4*)(w + (size_t)r * 256 + 128 + cq * 8) = (u32x4){0u, 0u, 0u, 0u}; } }
    tr_matrix(C, P.glu_w, 512, 512, 512, (bf16*)(ws + WS_WGLU), 512, 0, nullptr, gw, NGW);
    tr_matrix(C, P.ev_w_out, 1024, 1024, 1024, (bf16*)(ws + WS_WOUT), 1024, 0, nullptr, gw, NGW);
}
__device__ __forceinline__ void ph_conv_l1(const Ctx& C, const Params& P, int gw, int NGW) {
    tr_matrix(C, P.hy_w_in, 1024, 3072, 3072, (bf16*)(P.ws + WS_WHIN), 1024, 0, nullptr, gw, NGW);
    tr_matrix(C, P.hy_w_out, 1024, 1024, 1024, (bf16*)(P.ws + WS_WHOUT), 1024, 0, nullptr, gw, NGW);
}
__device__ __forceinline__ void ph_conv_moe(const Ctx& C, const Params& P, int li) {
    const int gw = C.bid * 8 + C.wave, NGW = C.G * 8;
    LAS float* scr = (LAS float*)(C.lds + RING_OFF + C.wave * 8448);
    bf16* W1 = (bf16*)(P.ws + AR_W1); bf16* W2 = (bf16*)(P.ws + AR_W2);
    for (int it = gw; it < 65 * 384; it += NGW) {
        const int e = it / 384, r = it % 384, kind = r >> 7, idx = r & 127;
        if (kind < 2) { const float* W = (e < 64) ? ((kind == 0 ? P.w_gate : P.w_up) + ((size_t)li * 64 + e) * 1024 * 256) : ((kind == 0 ? P.sh_gate : P.sh_up) + (size_t)li * 1024 * 256);
            const int kb = idx >> 3, nb = idx & 7, n0 = 32 * nb; const int drow0 = (n0 >> 7) * 256 + ((n0 >> 5) & 3) * 64 + kind * 32;
            tr_item(W, 256, W1 + (size_t)e * 512 * 1024, 1024, 64 * kb, n0, drow0, nullptr, scr, C.lane); }
        else { const float* W = (e < 64) ? (P.w_down + ((size_t)li * 64 + e) * 256 * 1024) : (P.sh_down + (size_t)li * 256 * 1024);
            const int kb = idx >> 5, nb = idx & 31;
            tr_item(W, 1024, W2 + (size_t)e * 1024 * 256, 256, 64 * kb, 32 * nb, 32 * nb, nullptr, scr, C.lane); }
    }
}

__device__ __forceinline__ void ph_s5_tables(const Ctx& C, const Params& P, int job0, int jstride) {
    LAS float* LST = (LAS float*)(C.lds + RING_OFF);
    LAS float* BB = LST + 256;
    LAS float* CC = BB + 4096;
    LAS float* LP = CC + 4096;
    LAS float* KT = LP + 8448;
    bf16* SOUT = (bf16*)(P.ws + WS_SOUT); bf16* WG = (bf16*)(P.ws + WS_WG); float* LAMT = (float*)(P.ws + WS_LAMT);
    for (int job = job0; job < S5G * 8; job += jstride) {
        const int g = job >> 3, part = job & 7;
        __syncthreads();
        if (C.tid < 128) { const int dir = C.tid >> 6, p = C.tid & 63, gi = dir * 32 + g;
            const float lr = fminf(P.lam_re[gi * 64 + p], -1e-4f), li = P.lam_im[gi * 64 + p], step = expf(P.log_step[gi]);
            const float a = lr * step, b = li * step; LST[(dir * 64 + p) * 2] = a; LST[(dir * 64 + p) * 2 + 1] = b;
            const float ea = expf(a), lbr = ea * cosf(b), lbi = ea * sinf(b);
            const float nr = lbr - 1.0f, ni = lbi, den = lr * lr + li * li;
            const float qr = (nr * lr + ni * li) / den, qi = (ni * lr - nr * li) / den;
#pragma unroll
            for (int h = 0; h < 16; ++h) { const float br = P.b_re[((size_t)gi * 64 + p) * 16 + h], bi = P.b_im[((size_t)gi * 64 + p) * 16 + h];
                BB[((dir * 64 + p) * 16 + h) * 2] = qr * br - qi * bi; BB[((dir * 64 + p) * 16 + h) * 2 + 1] = qr * bi + qi * br; } }
        for (int i = C.tid; i < 2048; i += 512) { const int dir = i >> 10, r = i & 1023; const size_t gi = (size_t)(dir * 32 + g) * 1024 + r; CC[i * 2] = P.c_re[gi]; CC[i * 2 + 1] = P.c_im[gi]; }
        __syncthreads();
        for (int i = C.tid; i < 2 * 33 * 64; i += 512) { const int dir = i / (33 * 64), r = i % (33 * 64), tau = r >> 6, p = r & 63;
            const float a = LST[(dir * 64 + p) * 2] * (float)tau, b = LST[(dir * 64 + p) * 2 + 1] * (float)tau; const float ea = expf(a);
            LP[i * 2] = ea * cosf(b); LP[i * 2 + 1] = ea * sinf(b); }
        __syncthreads();
        for (int i2 = C.tid; i2 < 2 * 32 * 32; i2 += 512) { const int dir = i2 >> 10, tau = (i2 >> 5) & 31, hp = 2 * part + ((i2 >> 4) & 1), h = i2 & 15; const int i = ((dir * 32 + tau) * 16 + hp) * 16 + h;
            float s = 0.f;
#pragma unroll 8
            for (int p = 0; p < 64; ++p) { const f32x2 c2 = *(const LAS f32x2*)(CC + ((dir * 16 + hp) * 64 + p) * 2), l2 = *(const LAS f32x2*)(LP + ((dir * 33 + tau) * 64 + p) * 2), b2 = *(const LAS f32x2*)(BB + ((dir * 64 + p) * 16 + h) * 2);
                const float xr = c2.x * l2.x - c2.y * l2.y, xi = c2.x * l2.y + c2.y * l2.x;
                s += xr * b2.x - xi * b2.y; }
            KT[i] = s; }
        __syncthreads();
        for (int i = C.tid; i < 64 * 96; i += 512) { const int nn = i / 96, k0 = (i % 96) * 8, t = nn >> 1, hp = 2 * part + (nn & 1), n = t * 16 + hp; float v[8];
#pragma unroll
            for (int j = 0; j < 8; ++j) { const int k = k0 + j;
                if (k < 512) { const int s = k >> 4, h = k & 15;
                    if (t > s) v[j] = KT[((0 * 32 + (t - s)) * 16 + hp) * 16 + h];
                    else if (t < s) v[j] = KT[((1 * 32 + (s - t)) * 16 + hp) * 16 + h];
                    else v[j] = KT[((0 * 32) * 16 + hp) * 16 + h] + KT[((1 * 32) * 16 + hp) * 16 + h] + (hp == h ? P.s5_d[g * 16 + h] : 0.f); }
                else { const int q = k - 512, dir = q >> 7, ri = (q >> 6) & 1, p = q & 63, tau = dir == 0 ? t + 1 : 32 - t;
                    const float cr = CC[((dir * 16 + hp) * 64 + p) * 2], ci = CC[((dir * 16 + hp) * 64 + p) * 2 + 1];
                    const float lr = LP[((dir * 33 + tau) * 64 + p) * 2], li = LP[((dir * 33 + tau) * 64 + p) * 2 + 1];
                    v[j] = ri == 0 ? (cr * lr - ci * li) : -(cr * li + ci * lr); } }
            u32x4 o; o.x = pk2(v[0], v[1]); o.y = pk2(v[2], v[3]); o.z = pk2(v[4], v[5]); o.w = pk2(v[6], v[7]);
            *(u32x4*)(WG + ((size_t)g * 512 + n) * 768 + k0) = o; }
        for (int i = C.tid; i < 32 * 64; i += 512) { const int q = 32 * part + (i >> 6), k0 = (i & 63) * 8, dir = q >> 7, ri = (q >> 6) & 1, p = q & 63; float v[8];
#pragma unroll
            for (int j = 0; j < 8; ++j) { const int k = k0 + j, s = k >> 4, h = k & 15, e = dir == 0 ? 31 - s : s;
                const float lr = LP[((dir * 33 + e) * 64 + p) * 2], li = LP[((dir * 33 + e) * 64 + p) * 2 + 1];
                const float br = BB[((dir * 64 + p) * 16 + h) * 2], bi = BB[((dir * 64 + p) * 16 + h) * 2 + 1];
                v[j] = ri == 0 ? (lr * br - li * bi) : (lr * bi + li * br); }
            u32x4 o; o.x = pk2(v[0], v[1]); o.y = pk2(v[2], v[3]); o.z = pk2(v[4], v[5]); o.w = pk2(v[6], v[7]);
            *(u32x4*)(SOUT + ((size_t)g * 256 + q) * 512 + k0) = o; }
        if (part == 0 && C.tid < 128) { const int dir = C.tid >> 6, p = C.tid & 63; LAMT[((g * 2 + dir) * 64 + p) * 2] = LP[((dir * 33 + 32) * 64 + p) * 2]; LAMT[((g * 2 + dir) * 64 + p) * 2 + 1] = LP[((dir * 33 + 32) * 64 + p) * 2 + 1]; }
    }
    __syncthreads();
}

__device__ __forceinline__ void ph_hy_filter(const Ctx& C, const Params& P, int item0, int istride) {
    LAS float* Z = (LAS float*)(C.lds + RING_OFF);
    LAS float* H1 = Z + 32 * 33 + 32;
    LAS float* H2 = H1 + 2048;
    float* HFT = (float*)(P.ws + WS_HFT);
    constexpr float PI2 = 6.283185307179586f;
    for (int item = item0; item < SEQ / 32; item += istride) {
        const int n0 = item * 32;
        __syncthreads();
        for (int i = C.tid; i < 32 * 33; i += 512) { const int p = i / 33, j = i % 33, n = n0 + p; const float tn = (float)n / 4095.0f, ang = PI2 * (float)n / 4096.0f; float v;
            if (j == 0) v = tn; else { const int bi = (j - 1) & 15; const float band = 1e-4f + (float)bi * ((15.0f - 1e-4f) / 15.0f); v = (j <= 16) ? cosf(band * ang) : -sinf(band * ang); }
            Z[p * 33 + j] = v; }
        __syncthreads();
        for (int i = C.tid; i < 2048; i += 512) { const int p = i >> 6, u = i & 63; float s = P.f_b1[u];
#pragma unroll
            for (int j = 0; j < 33; ++j) s += Z[p * 33 + j] * P.f_w1[j * 64 + u];
            H1[p * 64 + u] = sinf(P.f_freq[u] * s); }
        __syncthreads();
        for (int i = C.tid; i < 2048; i += 512) { const int p = i >> 6, u = i & 63; float s = P.f_b2[u];
#pragma unroll 16
            for (int k = 0; k < 64; ++k) s += H1[p * 64 + k] * P.f_w2[k * 64 + u];
            H2[p * 65 + u] = sinf(P.f_freq[u] * s); }
        __syncthreads();
        for (int ct = C.wave; ct < 64; ct += 8) { const int col = ct * 32 + (C.lane & 31), dir = col >> 10, d = col & 1023, kh = C.lane >> 5;
            f32x16 acc = {};
#pragma unroll 8
            for (int sk = 0; sk < 32; ++sk) { const float a = H2[(C.lane & 31) * 65 + 2 * sk + kh], b = P.f_w3[(size_t)(2 * sk + kh) * 2048 + col]; acc = __builtin_amdgcn_mfma_f32_32x32x2f32(a, b, acc, 0, 0, 0); }
            const float delta = 3.0701134573253945f + (float)d * ((15.350567286626972f - 3.0701134573253945f) / 1023.0f);
            float* o = HFT + ((size_t)d * 2 + dir) * 4096 + n0;
#pragma unroll
            for (int r4 = 0; r4 < 4; ++r4) { const int p0 = 8 * r4 + 4 * kh; f32x4 v;
                v.x = acc[4 * r4] * expf(-((float)(n0 + p0) / 4095.0f) * delta); v.y = acc[4 * r4 + 1] * expf(-((float)(n0 + p0 + 1) / 4095.0f) * delta);
                v.z = acc[4 * r4 + 2] * expf(-((float)(n0 + p0 + 2) / 4095.0f) * delta); v.w = acc[4 * r4 + 3] * expf(-((float)(n0 + p0 + 3) / 4095.0f) * delta);
                *(f32x4*)(o + p0) = v; } }
    }
    __syncthreads();
}

__device__ __forceinline__ void ph_norm(const Ctx& C, const Params& P, const float* xin, int li, int sh_idx, bool with_ctx) {
    const int gw = C.bid * 8 + C.wave, NGW = C.G * 8; bf16* H = (bf16*)(P.ws + WS_H);
    const float* mod = (const float*)(P.ws + WS_MOD); const float* modctx = (const float*)(P.ws + WS_MODCTX);
    const int nrows = with_ctx ? TA : T;
    for (int row0 = gw; row0 < nrows; row0 += 4 * NGW) {
        f32x4 v[4][4]; float s[4]; const float* shp[4]; const float* scp[4]; bool ok[4];
#pragma unroll
        for (int q = 0; q < 4; ++q) { const int row = row0 + q * NGW; ok[q] = row < nrows; const int rr = ok[q] ? row : row0; const float* xr;
            if (rr < T) { xr = xin + (size_t)rr * 1024; const float* m = mod + (size_t)(li * 8 + (rr >> 12)) * 6144; shp[q] = m + sh_idx * 1024; scp[q] = m + (sh_idx + 1) * 1024; }
            else { xr = P.ctx + (size_t)(rr - T) * 1024; shp[q] = modctx; scp[q] = modctx + 1024; }
            s[q] = 0.f;
#pragma unroll
            for (int j = 0; j < 4; ++j) { v[q][j] = *(const f32x4*)(xr + 256 * j + 4 * C.lane); } }
#pragma unroll
        for (int q = 0; q < 4; ++q) {
#pragma unroll
            for (int j = 0; j < 4; ++j) s[q] += (v[q][j].x * v[q][j].x + v[q][j].y * v[q][j].y) + (v[q][j].z * v[q][j].z + v[q][j].w * v[q][j].w);
            const float rstd = 1.0f / sqrtf(wave_sum(s[q]) * (1.0f / 1024.0f) + EPS);
            if (ok[q]) { const int row = row0 + q * NGW;
#pragma unroll
                for (int j = 0; j < 4; ++j) { const f32x4 a = *(const f32x4*)(scp[q] + 256 * j + 4 * C.lane), b = *(const f32x4*)(shp[q] + 256 * j + 4 * C.lane);
                    const f32x4 y = v[q][j] * rstd * (a + 1.0f) + b; u32x2 o; o.x = pk2(y.x, y.y); o.y = pk2(y.z, y.w);
                    *(u32x2*)(H + (size_t)row * 1024 + 256 * j + 4 * C.lane) = o; } } }
    }
}

__device__ __forceinline__ void ph_rownorm1(const Ctx& C, const Params& P) {
    const int gw = C.bid * 8 + C.wave, NGW = C.G * 8; const bf16* PROJ = (const bf16*)(P.ws + AR_PROJ); bf16* QN = (bf16*)(P.ws + AR_QN); bf16* CKV = (bf16*)(P.ws + AR_CKV);
    for (int row0 = gw; row0 < TA; row0 += 4 * NGW) {
        u32x2 q[4]; unsigned kv[4];
#pragma unroll
        for (int r = 0; r < 4; ++r) { const int row = (row0 + r * NGW < TA) ? row0 + r * NGW : row0; q[r] = *(const u32x2*)(PROJ + (size_t)row * 512 + 4 * C.lane); kv[r] = *(const unsigned*)(PROJ + (size_t)row * 512 + 256 + 2 * C.lane); }
        float sq[4], sk[4];
#pragma unroll
        for (int r = 0; r < 4; ++r) { const float q0 = bflo(q[r].x), q1 = bfhi(q[r].x), q2 = bflo(q[r].y), q3 = bfhi(q[r].y), k0 = bflo(kv[r]), k1 = bfhi(kv[r]); sq[r] = (q0 * q0 + q1 * q1) + (q2 * q2 + q3 * q3); sk[r] = k0 * k0 + k1 * k1; }
#pragma unroll
        for (int o = 1; o < 64; o <<= 1) {
#pragma unroll
            for (int r = 0; r < 4; ++r) { sq[r] += __shfl_xor(sq[r], o); sk[r] += __shfl_xor(sk[r], o); } }
#pragma unroll
        for (int r = 0; r < 4; ++r) { const int row = row0 + r * NGW; if (row < TA) {
            const float q0 = bflo(q[r].x), q1 = bfhi(q[r].x), q2 = bflo(q[r].y), q3 = bfhi(q[r].y), k0 = bflo(kv[r]), k1 = bfhi(kv[r]);
            const float rq = 1.0f / sqrtf(sq[r] * (1.0f / 256.0f) + EPS), rk = 1.0f / sqrtf(sk[r] * (1.0f / 128.0f) + EPS);
            if (row < T) { u32x2 o; o.x = pk2(q0 * rq, q1 * rq); o.y = pk2(q2 * rq, q3 * rq); *(u32x2*)(QN + (size_t)row * 256 + 4 * C.lane) = o; }
            *(unsigned*)(CKV + (size_t)row * 256 + 2 * C.lane) = pk2(k0 * rk, k1 * rk);
            *(unsigned*)(CKV + (size_t)row * 256 + 128 + 2 * C.lane) = 0u; } }
    }
}

__device__ __forceinline__ void ph_qkfinal(const Ctx& C, const Params& P) {
    const int gw = C.bid * 8 + C.wave, NGW = C.G * 8;
    const bf16* PROJ = (const bf16*)(P.ws + AR_PROJ); const bf16* KVRAW = (const bf16*)(P.ws + AR_KVRAW); bf16* KF = (bf16*)(P.ws + AR_KF); bf16* Q = (bf16*)(P.ws + AR_QRAW);
    const int hd = C.lane >> 3, sub = C.lane & 7, j0 = 12 * sub;
    constexpr float QSCALE = 0.10206207261596577f * 1.4426950408889634f;
    float gq[12], gk[12];
#pragma unroll
    for (int i = 0; i < 12; ++i) { gq[i] = P.q_qk[j0 + i]; gk[i] = P.k_qk[j0 + i]; }
    for (int row0 = gw; row0 < TA; row0 += 2 * NGW) {
        u32x2 kw[2][3];
#pragma unroll
        for (int rr = 0; rr < 2; ++rr) { const int row = (row0 + rr * NGW < TA) ? row0 + rr * NGW : row0;
#pragma unroll
            for (int i = 0; i < 3; ++i) { const int j = j0 + 4 * i; const bf16* src = (j < 64) ? (KVRAW + (size_t)row * 1024 + hd * 128 + j) : (PROJ + (size_t)row * 512 + 384 + (j - 64));
                kw[rr][i] = *(const u32x2*)src; } }
#pragma unroll
        for (int rr = 0; rr < 2; ++rr) { const int row = row0 + rr * NGW; if (row >= TA) continue;
        const bool lat = row < T; const int pos = row & 4095;
        float cs[6], sn[6];
#pragma unroll
        for (int i = 0; i < 6; ++i) { const int j = j0 + 2 * i; cs[i] = 1.f; sn[i] = 0.f;
            if (j >= 64 && lat) { const int pi = (j - 64) >> 1; const float inv = exp2f(-(float)(pi & 7) * (13.287712379549449f / 8.0f)); const float ang = (float)(pi < 8 ? (pos >> 6) : (pos & 63)) * inv; cs[i] = cosf(ang); sn[i] = sinf(ang); } }
        { float x[12];
#pragma unroll
          for (int i = 0; i < 3; ++i) { const u32x2 w = kw[rr][i]; x[4 * i] = bflo(w.x); x[4 * i + 1] = bfhi(w.x); x[4 * i + 2] = bflo(w.y); x[4 * i + 3] = bfhi(w.y); }
          float s = 0.f;
#pragma unroll
          for (int i = 0; i < 12; ++i) s += x[i] * x[i];
          s += __shfl_xor(s, 1); s += __shfl_xor(s, 2); s += __shfl_xor(s, 4);
          const float r = 1.0f / sqrtf(s * (1.0f / 96.0f) + EPS);
#pragma unroll
          for (int i = 0; i < 12; ++i) x[i] = x[i] * r * gk[i];
#pragma unroll
          for (int i = 0; i < 6; ++i) { const float a = x[2 * i], b = x[2 * i + 1]; x[2 * i] = a * cs[i] - b * sn[i]; x[2 * i + 1] = a * sn[i] + b * cs[i]; }
#pragma unroll
          for (int i = 0; i < 3; ++i) { u32x2 o; o.x = pk2(x[4 * i], x[4 * i + 1]); o.y = pk2(x[4 * i + 2], x[4 * i + 3]); *(u32x2*)(KF + (size_t)row * 768 + hd * 96 + j0 + 4 * i) = o; } }
        if (lat) { float x[12];
#pragma unroll
          for (int i = 0; i < 3; ++i) { const u32x2 w = *(const u32x2*)(Q + (size_t)row * 768 + hd * 96 + j0 + 4 * i); x[4 * i] = bflo(w.x); x[4 * i + 1] = bfhi(w.x); x[4 * i + 2] = bflo(w.y); x[4 * i + 3] = bfhi(w.y); }
          float s = 0.f;
#pragma unroll
          for (int i = 0; i < 12; ++i) s += x[i] * x[i];
          s += __shfl_xor(s, 1); s += __shfl_xor(s, 2); s += __shfl_xor(s, 4);
          const float r = 1.0f / sqrtf(s * (1.0f / 96.0f) + EPS);
#pragma unroll
          for (int i = 0; i < 12; ++i) x[i] = x[i] * r * gq[i];
#pragma unroll
          for (int i = 0; i < 6; ++i) { const float a = x[2 * i], b = x[2 * i + 1]; x[2 * i] = (a * cs[i] - b * sn[i]) * QSCALE; x[2 * i + 1] = (a * sn[i] + b * cs[i]) * QSCALE; }
#pragma unroll
          for (int i = 0; i < 3; ++i) { u32x2 o; o.x = pk2(x[4 * i], x[4 * i + 1]); o.y = pk2(x[4 * i + 2], x[4 * i + 3]); *(u32x2*)(Q + (size_t)row * 768 + hd * 96 + j0 + 4 * i) = o; } }
        }
    }
}

using pg8::Unit;
#define EPI_ARGS const f32x4 (&acc)[2][2][4][2], const Unit& u, int wr, int wc, int fr, int fq
__device__ __forceinline__ u32x4 pack8(const f32x4 a, const f32x4 b) { u32x4 w; w.x = pg8::cvt_pk_bf16(a[0], a[1]); w.y = pg8::cvt_pk_bf16(a[2], a[3]); w.z = pg8::cvt_pk_bf16(b[0], b[1]); w.w = pg8::cvt_pk_bf16(b[2], b[3]); return w; }

__device__ __forceinline__ void widen_pair(const u32x4 d0, const u32x4 d1, bool odd, u32x4& A, u32x4& B) {
    u32x4 send, recv;
#pragma unroll
    for (int q = 0; q < 4; ++q) { send[q] = odd ? d0[q] : d1[q]; recv[q] = (unsigned)__builtin_amdgcn_update_dpp(0, (int)send[q], 0xB1, 0xf, 0xf, false); }
#pragma unroll
    for (int q = 0; q < 4; ++q) { A[q] = odd ? recv[q] : d0[q]; B[q] = odd ? d1[q] : recv[q]; }
}
struct SchedDense {
    const char* A; const char* B; unsigned lda, ldb; int nM, nN, G, c;
    __device__ __forceinline__ bool next(int i, Unit& u) const { const int L = i * G + c; if (L >= nM * nN) return false; const int pm = L / nN, pn = L % nN;
        u.A = A + (size_t)pm * 256 * lda; u.B = B + (size_t)pn * 256 * ldb; u.rows = nullptr; u.pm = pm; u.pn = pn; u.z = 0; return true; }
};
struct SchedBatched {
    const char* A; const char* B; unsigned lda, ldb; size_t sA, sB; int nZ, nM, nN, G, c;
    __device__ __forceinline__ bool next(int i, Unit& u) const { const int L = i * G + c; if (L >= nZ * nM * nN) return false; const int z = L / (nM * nN), r = L % (nM * nN), pm = r / nN, pn = r % nN;
        u.A = A + (size_t)z * sA + (size_t)pm * 256 * lda; u.B = B + (size_t)z * sB + (size_t)pn * 256 * ldb; u.rows = nullptr; u.pm = pm; u.pn = pn; u.z = z; return true; }
};
struct SchedUp {
    const char *QN, *WUQ, *CKV, *WUKV; int G, c;
    __device__ __forceinline__ bool next(int i, Unit& u) const { int L = i * G + c; u.rows = nullptr;
        if (L < 384) { u.pm = L / 3; u.pn = L % 3; u.z = 0; u.A = QN + (size_t)u.pm * 256 * 512; u.B = WUQ + (size_t)u.pn * 256 * 512; return true; }
        L -= 384; if (L >= 544) return false; u.pm = L >> 2; u.pn = L & 3; u.z = 1; u.A = CKV + (size_t)u.pm * 256 * 512; u.B = WUKV + (size_t)u.pn * 256 * 512; return true; }
};

struct EpiInProj {
    static constexpr bool PERM = true; bf16* PROJ; bf16* U;
    __device__ __forceinline__ void operator()(EPI_ARGS) const {
#pragma unroll
        for (int ai = 0; ai < 2; ++ai)
#pragma unroll
            for (int m = 0; m < 4; ++m) { const int row = u.pm * 256 + ai * 128 + wr * 64 + m * 16 + fr; int urow, s;
                if (row < T) { const int b = row >> 12, pos = row & 4095; urow = (pos >> 5) * 8 + b; s = pos & 31; } else { const int rr = row - T, b = rr >> 8, pos = rr & 255; urow = 1024 + (pos >> 5) * 8 + b; s = pos & 31; }
#pragma unroll
                for (int bj = 0; bj < 2; ++bj) { const int col0 = u.pn * 256 + wc * 64 + bj * 32 + 8 * fq; const u32x4 w = pack8(acc[ai][bj][m][0], acc[ai][bj][m][1]);
                    if (col0 < UOFF) *(u32x4*)(PROJ + (size_t)row * 512 + col0) = w;
                    else if (col0 < EVEN_IN) { const int gc = col0 - UOFF, g = gc >> 4, h0 = gc & 15; *(u32x4*)(U + ((size_t)(g * S5ROWS + urow) * S5K + s * 16 + h0)) = w; } } }
    }
};
struct EpiUp {
    static constexpr bool PERM = true; bf16* QRAW; bf16* KVRAW;
    __device__ __forceinline__ void operator()(EPI_ARGS) const { bf16* O = u.z ? KVRAW : QRAW; const int ldc = u.z ? 1024 : 768; const bool odd = fr & 1;
#pragma unroll
        for (int ai = 0; ai < 2; ++ai)
#pragma unroll
            for (int m = 0; m < 4; ++m) { const int rowE = u.pm * 256 + ai * 128 + wr * 64 + m * 16 + (fr & ~1); u32x4 A, B; widen_pair(pack8(acc[ai][0][m][0], acc[ai][0][m][1]), pack8(acc[ai][1][m][0], acc[ai][1][m][1]), odd, A, B);
                bf16* op = O + (size_t)rowE * ldc + u.pn * 256 + wc * 64 + (odd ? 32 : 0) + 8 * fq; *(u32x4*)op = A; *(u32x4*)(op + ldc) = B; }
    }
};
struct EpiF32Batched {
    static constexpr bool PERM = false; float* O; int rows_per_z, ldc;
    __device__ __forceinline__ void operator()(EPI_ARGS) const {
#pragma unroll
        for (int ai = 0; ai < 2; ++ai)
#pragma unroll
            for (int m = 0; m < 4; ++m) { const int row = u.pm * 256 + ai * 128 + wr * 64 + m * 16 + fr; float* rp = O + ((size_t)u.z * rows_per_z + row) * ldc + u.pn * 256 + wc * 32 + 4 * fq;
#pragma unroll
                for (int bj = 0; bj < 2; ++bj)
#pragma unroll
                    for (int n = 0; n < 2; ++n) *(f32x4*)(rp + bj * 128 + n * 16) = acc[ai][bj][m][n]; }
    }
};
struct EpiS5C {
    static constexpr bool PERM = true; bf16* Z;
    __device__ __forceinline__ void operator()(EPI_ARGS) const {
#pragma unroll
        for (int ai = 0; ai < 2; ++ai)
#pragma unroll
            for (int m = 0; m < 4; ++m) { const int rr = u.pm * 256 + ai * 128 + wr * 64 + m * 16 + fr, c = rr >> 3, b = rr & 7;
#pragma unroll
                for (int bj = 0; bj < 2; ++bj) { const int cc = u.pn * 256 + wc * 64 + bj * 32 + 8 * fq, t = cc >> 4, h0 = cc & 15; f32x4 v0 = acc[ai][bj][m][0], v1 = acc[ai][bj][m][1];
#pragma unroll
                    for (int j = 0; j < 4; ++j) { v0[j] = gelu_tanh(v0[j]); v1[j] = gelu_tanh(v1[j]); }
                    *(u32x4*)(Z + ((size_t)(b * 4096 + c * 32 + t) * 512 + u.z * 16 + h0)) = pack8(v0, v1); } }
    }
};
struct EpiGlu {
    static constexpr bool PERM = true; const bf16* Z; const float* gb; bf16* CAT;
    __device__ __forceinline__ void operator()(EPI_ARGS) const {
#pragma unroll
        for (int ai = 0; ai < 2; ++ai)
#pragma unroll
            for (int m = 0; m < 4; ++m) { const int row = u.pm * 256 + ai * 128 + wr * 64 + m * 16 + fr;
#pragma unroll
                for (int bj = 0; bj < 2; ++bj) { const int col0 = u.pn * 256 + wc * 64 + bj * 32 + 8 * fq; const u32x4 zw = *(const u32x4*)(Z + (size_t)row * 512 + col0);
                    const f32x4 b0 = *(const f32x4*)(gb + col0), b1 = *(const f32x4*)(gb + col0 + 4); f32x4 v0 = acc[ai][bj][m][0] + b0, v1 = acc[ai][bj][m][1] + b1;
                    v0[0] = bflo(zw.x) * sigmf(v0[0]); v0[1] = bfhi(zw.x) * sigmf(v0[1]); v0[2] = bflo(zw.y) * sigmf(v0[2]); v0[3] = bfhi(zw.y) * sigmf(v0[3]);
                    v1[0] = bflo(zw.z) * sigmf(v1[0]); v1[1] = bfhi(zw.z) * sigmf(v1[1]); v1[2] = bflo(zw.w) * sigmf(v1[2]); v1[3] = bfhi(zw.w) * sigmf(v1[3]);
                    *(u32x4*)(CAT + (size_t)row * 1024 + 512 + col0) = pack8(v0, v1); } }
    }
};
struct EpiResid {
    static constexpr bool PERM = false; const float* xin; float* xout; const float* gate;
    __device__ __forceinline__ void operator()(EPI_ARGS) const { const int col0 = u.pn * 256 + wc * 32 + 4 * fq;
        f32x4 gv[2][2];
        { const float* gp = gate + (size_t)((u.pm * 256) >> 12) * 6144 + col0;
#pragma unroll
          for (int bj = 0; bj < 2; ++bj)
#pragma unroll
              for (int n = 0; n < 2; ++n) gv[bj][n] = *(const f32x4*)(gp + bj * 128 + n * 16); }
#pragma unroll
        for (int ai = 0; ai < 2; ++ai)
#pragma unroll
            for (int mp = 0; mp < 2; ++mp) { f32x4 xv[2][2][2];
#pragma unroll
                for (int mq = 0; mq < 2; ++mq) { const int row = u.pm * 256 + ai * 128 + wr * 64 + (2 * mp + mq) * 16 + fr;
#pragma unroll
                    for (int bj = 0; bj < 2; ++bj)
#pragma unroll
                        for (int n = 0; n < 2; ++n) xv[mq][bj][n] = *(const f32x4*)(xin + (size_t)row * 1024 + col0 + bj * 128 + n * 16); }
#pragma unroll
                for (int mq = 0; mq < 2; ++mq) { const int m = 2 * mp + mq, row = u.pm * 256 + ai * 128 + wr * 64 + m * 16 + fr;
#pragma unroll
                    for (int bj = 0; bj < 2; ++bj)
#pragma unroll
                        for (int n = 0; n < 2; ++n) *(f32x4*)(xout + (size_t)row * 1024 + col0 + bj * 128 + n * 16) = xv[mq][bj][n] + gv[bj][n] * acc[ai][bj][m][n]; } }
    }
};

__device__ __forceinline__ void ph_s5_scan(const Ctx& C, const Params& P) {
    const int gt = C.bid * 512 + C.tid; if (gt >= S5G * NB * 128) return;
    const int p = gt & 63, dir = (gt >> 6) & 1, b = (gt >> 7) & 7, g = gt >> 10;
    const float* LAMT = (const float*)(P.ws + WS_LAMT); const float lr = LAMT[((g * 2 + dir) * 64 + p) * 2], li = LAMT[((g * 2 + dir) * 64 + p) * 2 + 1];
    const float* S = (const float*)(P.ws + AR_SRAW) + (size_t)g * S5ROWS * 256 + dir * 128 + p;
    bf16* Ug = (bf16*)(P.ws + AR_U) + (size_t)g * S5ROWS * S5K + 512 + dir * 128 + p;
    float sr = 0.f, si = 0.f;
    if (dir == 0) {
#pragma unroll
        for (int j = 0; j < S5NCC; ++j) { const int row = 1024 + j * 8 + b; const float ar = S[(size_t)row * 256], ai = S[(size_t)row * 256 + 64]; const float nr = lr * sr - li * si + ar, ni = lr * si + li * sr + ai; sr = nr; si = ni; }
#pragma unroll 8
        for (int c = 0; c < S5NCH; ++c) { const int row = c * 8 + b; const float ar = S[(size_t)row * 256], ai = S[(size_t)row * 256 + 64];
            Ug[(size_t)row * S5K] = (bf16)f2bf(sr); Ug[(size_t)row * S5K + 64] = (bf16)f2bf(si);
            const float nr = lr * sr - li * si + ar, ni = lr * si + li * sr + ai; sr = nr; si = ni; }
    } else {
#pragma unroll
        for (int j = S5NCC - 1; j >= 0; --j) { const int row = 1024 + j * 8 + b; const float ar = S[(size_t)row * 256], ai = S[(size_t)row * 256 + 64]; const float nr = lr * sr - li * si + ar, ni = lr * si + li * sr + ai; sr = nr; si = ni; }
#pragma unroll 8
        for (int c = S5NCH - 1; c >= 0; --c) { const int row = c * 8 + b; const float ar = S[(size_t)row * 256], ai = S[(size_t)row * 256 + 64];
            Ug[(size_t)row * S5K] = (bf16)f2bf(sr); Ug[(size_t)row * S5K + 64] = (bf16)f2bf(si);
            const float nr = lr * sr - li * si + ar, ni = lr * si + li * sr + ai; sr = nr; si = ni; }
    }
}

constexpr int AT_KROW = 208, AT_KB = 64 * AT_KROW  , AT_VB = 8192;
constexpr int AT_K = RING_OFF, AT_V = AT_K + 2 * AT_KB, AT_WS = AT_V + 2 * AT_VB, AT_OST = AT_WS + 8 * 256, AT_END = AT_OST + 8 * 4096;
__device__ __forceinline__ int crow(int r, int hi) { return (r & 3) + 8 * (r >> 2) + 4 * hi; }
typedef short v4i16_t __attribute__((ext_vector_type(4)));
__device__ __forceinline__ s16x4 vtr(const LAS unsigned char* p) { return __builtin_bit_cast(s16x4, __builtin_amdgcn_ds_read_tr16_b64_v4i16((LAS v4i16_t*)p)); }
__device__ __forceinline__ float xhalf_max(float m) { auto rr = __builtin_amdgcn_permlane32_swap(__float_as_uint(m), __float_as_uint(m), false, false); return fmaxf(__uint_as_float(rr[0]), __uint_as_float(rr[1])); }
__device__ __forceinline__ float xhalf_sum(float m) { auto rr = __builtin_amdgcn_permlane32_swap(__float_as_uint(m), __float_as_uint(m), false, false); return __uint_as_float(rr[0]) + __uint_as_float(rr[1]); }

__device__ __forceinline__ float max3f(float a, float b, float c) { return fmaxf(fmaxf(a, b), c); }
constexpr int AT2_KB = 64 * 256, AT2_K = RING_OFF, AT2_V = AT2_K + 2 * AT2_KB, AT2_WS = AT2_V + 2 * AT_VB, AT2_OST = AT2_WS + 8 * 256, AT2_END = AT2_OST + 8 * 4096;
static_assert(AT2_END <= LDS_BYTES, "attention LDS");
template <bool NOMAX> __device__ __forceinline__ void ph_attention(const Ctx& C, const Params& P, int vcu) {
    const bf16* Q = (const bf16*)(P.ws + AR_QRAW); const bf16* KF = (const bf16*)(P.ws + AR_KF); const bf16* KV = (const bf16*)(P.ws + AR_KVRAW); bf16* CAT = (bf16*)(P.ws + AR_CAT);
    const int lane = C.lane, wid = C.wave, r32 = lane & 31, hi = lane >> 5;
    LAS unsigned char* lds = C.lds;
    LAS float* wsf = (LAS float*)(lds + AT2_WS) + wid * 64;
    const int vrd = ((lane >> 4) & 1) * 32 + (lane & 3) * 8 + (4 * hi + ((lane & 15) >> 2)) * 64;
    int kro[6];
#pragma unroll
    for (int d0 = 0; d0 < 6; ++d0) kro[d0] = r32 * 256 + (((2 * d0 + hi) ^ (r32 & 15)) << 4);
    constexpr int NTILE = (SEQ + CTXL) / 64;
    constexpr float THR = 8.0f;
#define SB() __builtin_amdgcn_sched_barrier(0)
#define AT_ROW0(j) (((j) < 64) ? ((size_t)b * SEQ + (size_t)(j) * 64) : ((size_t)T + (size_t)b * CTXL + (size_t)((j) - 64) * 64))
#define AT_DMAK(j, buf) do { const bf16* kb_ = KF + AT_ROW0(j) * 768 + hd * 96; _Pragma("unroll") for (int q_ = 0; q_ < 2; ++q_) { \
        const int row_ = 4 * (2 * wid + q_) + (lane >> 4); int c_ = (lane & 15) ^ (row_ & 15); c_ = c_ < 12 ? c_ : c_ - 12;     \
        __builtin_amdgcn_global_load_lds((const unsigned*)(kb_ + row_ * 768 + c_ * 8), (LAS unsigned*)(lds + AT2_K + (buf) * AT2_KB + (2 * wid + q_) * 1024), 16, 0, 0); } } while (0)
#define AT_DMAV(j, buf) do { const bf16* vb_ = KV + AT_ROW0(j) * 1024 + hd * 128; \
        __builtin_amdgcn_global_load_lds((const unsigned*)(vb_ + (16 * (wid & 3) + (lane >> 2)) * 1024 + 64 + ((wid >> 2) * 4 + (lane & 3)) * 8), (LAS unsigned*)(lds + AT2_V + (buf) * AT_VB + wid * 1024), 16, 0, 0); } while (0)
#define AT_KFRAG(Kb, d0, h) (*(const LAS bf16x8*)((Kb) + (h) * 32 * 256 + kro[d0]))
    for (int i = 0;; ++i) {
        const int un = i * C.G + vcu; if (un >= NB * NHEAD * 16) break;
        const int bh = un >> 4, qb = un & 15, b = bh >> 3, hd = bh & 7;
        const size_t qrow = (size_t)b * SEQ + qb * 256 + wid * 32 + r32;
        bf16x8 qr[6];
#pragma unroll
        for (int d0 = 0; d0 < 6; ++d0) qr[d0] = *(const bf16x8*)(Q + qrow * 768 + hd * 96 + d0 * 16 + hi * 8);
        f32x16 o0 = {}, o1 = {}; float m = NOMAX ? 0.f : -1e30f, l = 0.f;
        AT_DMAK(0, 0); AT_DMAV(0, 0); AT_DMAK(1, 1);
        __syncthreads();
        f32x16 pc0 = {}, pc1 = {};
        { const LAS unsigned char* Kb = lds + AT2_K;
#pragma unroll
          for (int d0 = 0; d0 < 6; ++d0) { pc0 = __builtin_amdgcn_mfma_f32_32x32x16_bf16(AT_KFRAG(Kb, d0, 0), qr[d0], pc0, 0, 0, 0); pc1 = __builtin_amdgcn_mfma_f32_32x32x16_bf16(AT_KFRAG(Kb, d0, 1), qr[d0], pc1, 0, 0, 0); } }
        for (int j = 0; j < NTILE; ++j) {
            const int buf = j & 1; const bool more = j + 1 < NTILE;
            if (j + 2 < NTILE) AT_DMAK(j + 2, buf);
            if (more) AT_DMAV(j + 1, buf ^ 1);
            const LAS unsigned char* Kn = lds + AT2_K + (buf ^ 1) * AT2_KB;
            f32x16 pn0 = {}, pn1 = {};
            bf16x8 ka = AT_KFRAG(Kn, 0, 0), kb = AT_KFRAG(Kn, 0, 1), kc = AT_KFRAG(Kn, 1, 0), kd = AT_KFRAG(Kn, 1, 1);
            if (more) { pn0 = __builtin_amdgcn_mfma_f32_32x32x16_bf16(ka, qr[0], pn0, 0, 0, 0); pn1 = __builtin_amdgcn_mfma_f32_32x32x16_bf16(kb, qr[0], pn1, 0, 0, 0); }
            float mt = 0.f, mu = 0.f;
            if constexpr (!NOMAX) { mt = max3f(pc0[0], pc0[1], pc1[0]); mu = max3f(pc0[2], pc0[3], pc1[1]);
            mt = max3f(mt, pc1[2], pc1[3]);
#pragma unroll
            for (int r = 4; r < 16; r += 4) { mt = max3f(mt, pc0[r], pc0[r + 1]); mu = max3f(mu, pc0[r + 2], pc0[r + 3]); mt = max3f(mt, pc1[r], pc1[r + 1]); mu = max3f(mu, pc1[r + 2], pc1[r + 3]); } }
            if (more) { pn0 = __builtin_amdgcn_mfma_f32_32x32x16_bf16(kc, qr[1], pn0, 0, 0, 0); pn1 = __builtin_amdgcn_mfma_f32_32x32x16_bf16(kd, qr[1], pn1, 0, 0, 0); }
            ka = AT_KFRAG(Kn, 2, 0); kb = AT_KFRAG(Kn, 2, 1); kc = AT_KFRAG(Kn, 3, 0); kd = AT_KFRAG(Kn, 3, 1);
            if constexpr (!NOMAX) mt = xhalf_max(fmaxf(mt, mu));
            if (!NOMAX && __any(mt > m + THR)) {
                const float mn = fmaxf(m, mt), alpha = __builtin_amdgcn_exp2f(m - mn); m = mn; l *= alpha;
                if (hi == 0) wsf[r32] = alpha;
                LDS_WAIT();
#pragma unroll
                for (int r = 0; r < 16; ++r) { const float a = wsf[crow(r, hi)]; o0[r] *= a; o1[r] *= a; }
            }
            SB();
            if (more) { pn0 = __builtin_amdgcn_mfma_f32_32x32x16_bf16(ka, qr[2], pn0, 0, 0, 0); pn1 = __builtin_amdgcn_mfma_f32_32x32x16_bf16(kb, qr[2], pn1, 0, 0, 0); }
            float ls = 0.f;
#pragma unroll
            for (int r = 0; r < 8; ++r) { pc0[r] = __builtin_amdgcn_exp2f(NOMAX ? pc0[r] : pc0[r] - m); ls += pc0[r]; }
            SB();
            if (more) { pn0 = __builtin_amdgcn_mfma_f32_32x32x16_bf16(kc, qr[3], pn0, 0, 0, 0); pn1 = __builtin_amdgcn_mfma_f32_32x32x16_bf16(kd, qr[3], pn1, 0, 0, 0); }
            ka = AT_KFRAG(Kn, 4, 0); kb = AT_KFRAG(Kn, 4, 1); kc = AT_KFRAG(Kn, 5, 0); kd = AT_KFRAG(Kn, 5, 1);
#pragma unroll
            for (int r = 8; r < 16; ++r) { pc0[r] = __builtin_amdgcn_exp2f(NOMAX ? pc0[r] : pc0[r] - m); ls += pc0[r]; }
            SB();
            if (more) { pn0 = __builtin_amdgcn_mfma_f32_32x32x16_bf16(ka, qr[4], pn0, 0, 0, 0); pn1 = __builtin_amdgcn_mfma_f32_32x32x16_bf16(kb, qr[4], pn1, 0, 0, 0); }
#pragma unroll
            for (int r = 0; r < 8; ++r) { pc1[r] = __builtin_amdgcn_exp2f(NOMAX ? pc1[r] : pc1[r] - m); ls += pc1[r]; }
            SB();
            if (more) { pn0 = __builtin_amdgcn_mfma_f32_32x32x16_bf16(kc, qr[5], pn0, 0, 0, 0); pn1 = __builtin_amdgcn_mfma_f32_32x32x16_bf16(kd, qr[5], pn1, 0, 0, 0); }
#pragma unroll
            for (int r = 8; r < 16; ++r) { pc1[r] = __builtin_amdgcn_exp2f(NOMAX ? pc1[r] : pc1[r] - m); ls += pc1[r]; }
            l += ls;
            SB();
            const LAS unsigned char* Vb = lds + AT2_V + buf * AT_VB + vrd;
            s16x4 l0 = vtr(Vb), h0 = vtr(Vb + 512), l1 = vtr(Vb + 4096), h1 = vtr(Vb + 4096 + 512);
#pragma unroll
            for (int ks = 0; ks < 4; ++ks) {
                u32x4 w;
#pragma unroll
                for (int q = 0; q < 4; ++q) { const int r = (ks & 1) * 8 + 2 * q; w[q] = (ks < 2) ? pg8::cvt_pk_bf16(pc0[r], pc0[r + 1]) : pg8::cvt_pk_bf16(pc1[r], pc1[r + 1]); }
                const bf16x8 pw = __builtin_bit_cast(bf16x8, w);
                const bf16x8 v0 = (bf16x8){l0[0], l0[1], l0[2], l0[3], h0[0], h0[1], h0[2], h0[3]}, v1 = (bf16x8){l1[0], l1[1], l1[2], l1[3], h1[0], h1[1], h1[2], h1[3]};
                if (ks < 3) { l0 = vtr(Vb + (ks + 1) * 1024); h0 = vtr(Vb + (ks + 1) * 1024 + 512); l1 = vtr(Vb + 4096 + (ks + 1) * 1024); h1 = vtr(Vb + 4096 + (ks + 1) * 1024 + 512); }
                o0 = __builtin_amdgcn_mfma_f32_32x32x16_bf16(pw, v0, o0, 0, 0, 0); o1 = __builtin_amdgcn_mfma_f32_32x32x16_bf16(pw, v1, o1, 0, 0, 0);
                SB();
            }
            pc0 = pn0; pc1 = pn1;
            __syncthreads();
        }
        l = xhalf_sum(l);
        if (hi == 0) wsf[32 + r32] = l;
        LDS_WAIT();
        LAS bf16* stl = (LAS bf16*)(lds + AT2_OST + wid * 4096);
#pragma unroll
        for (int r = 0; r < 16; ++r) { const int orow = crow(r, hi); const float rl = 1.0f / wsf[32 + orow];
            stl[orow * 64 + r32] = (bf16)f2bf(o0[r] * rl); stl[orow * 64 + 32 + r32] = (bf16)f2bf(o1[r] * rl); }
        LDS_WAIT();
        const size_t orow0 = (size_t)b * SEQ + qb * 256 + wid * 32;
#pragma unroll
        for (int q = 0; q < 4; ++q) { const int row = q * 8 + (lane >> 3), ch = lane & 7; const u32x4 v = *(const LAS u32x4*)(stl + row * 64 + ch * 8); *(u32x4*)(CAT + (orow0 + row) * 1024 + hd * 64 + ch * 8) = v; }
        __syncthreads();
    }
#undef SB
#undef AT_ROW0
#undef AT_DMAK
#undef AT_DMAV
#undef AT_KFRAG
}

constexpr int LC_BLKSTART = 128, LC_CNT = 704, LC_BLK2HE = 1216;
constexpr int RT_XH = RING_OFF, RT_XL = RT_XH + 16 * 1032 * 2, RT_LG = RT_XL + 16 * 1032 * 2, RT_MS = RT_LG + 2 * 16 * 64 * 4, RT_KEYS = RT_MS + 2 * 1024 * 4, RT_LCNT = RT_KEYS + 16 * 64 * 4, RT_GBASE = RT_LCNT + 64 * 4  , RT_ST = RT_GBASE + 512  , RT_END = RT_ST + 16 * 1024 * 4;
static_assert(RT_END <= LDS_BYTES && RT_ST % 16 == 0, "router LDS");

__device__ __forceinline__ void ph_router(const Ctx& C, const Params& P, const float* xin, int li, int cset) {
    LAS bf16* XH = (LAS bf16*)(C.lds + RT_XH); LAS bf16* XL = (LAS bf16*)(C.lds + RT_XL); LAS float* LG = (LAS float*)(C.lds + RT_LG);
    LAS float* MS = (LAS float*)(C.lds + RT_MS);
    LAS int* lcnt = (LAS int*)(C.lds + RT_LCNT); LAS int* gbase = (LAS int*)(C.lds + RT_GBASE);
    bf16* H = (bf16*)(P.ws + WS_H); const float* mod = (const float*)(P.ws + WS_MOD); float* TOPW = (float*)(P.ws + WS_TOPW); int* TOK = (int*)(P.ws + WS_TOK);
    unsigned* gcnt = (unsigned*)(P.ws + WS_CTL) + CW_CNT + (cset * 2) * 64 * 16;
    const float* RW = P.router_w + (size_t)li * 1024 * 64; const float* RB = P.router_b + li * 64;
    const int lane = C.lane, w = C.wave, eq = w & 3, kh = w >> 2, fi = lane & 15, fk = lane >> 4;
    constexpr int NT = T / 16;
    const int per = (NT + C.G - 1) / C.G, tbeg = C.bid * per, tend = (tbeg + per < NT) ? tbeg + per : NT;
    if (tbeg >= NT) return;
    bf16x8 bh[16], bl[16];
#pragma unroll
    for (int ks = 0; ks < 16; ++ks) { u32x4 wh, wl;
#pragma unroll
        for (int q = 0; q < 4; ++q) { const int k = kh * 512 + ks * 32 + 8 * fk + 2 * q; const float w0 = RW[(size_t)k * 64 + eq * 16 + fi], w1 = RW[(size_t)(k + 1) * 64 + eq * 16 + fi];
            const unsigned h0 = f2bf(w0), h1 = f2bf(w1); wh[q] = h0 | (h1 << 16); wl[q] = pk2(w0 - bf2f((unsigned short)h0), w1 - bf2f((unsigned short)h1)); }
        bh[ks] = __builtin_bit_cast(bf16x8, wh); bl[ks] = __builtin_bit_cast(bf16x8, wl);
        if ((ks & 3) == 3) asm volatile("" ::: "memory"); }
    const float rb = RB[lane];
    if (C.tid < 64) lcnt[C.tid] = 0;
    LAS float* ST = (LAS float*)(C.lds + RT_ST);
#define RT_LOADROWS(tile_) do { _Pragma("unroll") for (int rr = 0; rr < 2; ++rr) { const float* xr = xin + (size_t)((tile_) * 16 + 2 * w + rr) * 1024; \
        _Pragma("unroll") for (int j = 0; j < 4; ++j) __builtin_amdgcn_global_load_lds((const unsigned*)(xr + 256 * j + 4 * lane), (LAS unsigned*)(ST + (2 * w + rr) * 1024 + 256 * j), 16, 0, 0); } } while (0)
    RT_LOADROWS(tbeg);
    int plr[2] = {0, 0}, ptok[2] = {-1, -1}, phf = 0;
    int qlr[2] = {0, 0}, qtok[2] = {-1, -1}, qhf = 0;
    int gbv = 0, npend = 0, it = 0, bcur = -1;
    for (int tile = tbeg; tile < tend; ++tile) {
        const int t0 = tile * 16, hf = t0 >= HALF_T ? 1 : 0;
        if ((t0 >> 12) != bcur) { bcur = t0 >> 12; const float* m = mod + (size_t)(li * 8 + bcur) * 6144;
            __syncthreads();
            for (int i = C.tid; i < 1024; i += 512) { MS[i] = m[4096 + i] + 1.0f; MS[1024 + i] = m[3072 + i]; }
            __syncthreads(); }
        TACC_B(C, 1);
        f32x4 v[2][4];
        asm volatile("s_waitcnt vmcnt(0)" ::: "memory");
#pragma unroll
        for (int rr = 0; rr < 2; ++rr)
#pragma unroll
            for (int j = 0; j < 4; ++j) v[rr][j] = *(const LAS f32x4*)(ST + (2 * w + rr) * 1024 + 256 * j + 4 * lane);
        LDS_WAIT();
        if (tile + 1 < tend) RT_LOADROWS(tile + 1);
        float ss[2];
#pragma unroll
        for (int rr = 0; rr < 2; ++rr) { float s = 0.f;
#pragma unroll
            for (int j = 0; j < 4; ++j) s += (v[rr][j].x * v[rr][j].x + v[rr][j].y * v[rr][j].y) + (v[rr][j].z * v[rr][j].z + v[rr][j].w * v[rr][j].w);
            ss[rr] = s; }
#pragma unroll
        for (int o = 1; o < 64; o <<= 1) {
#pragma unroll
            for (int rr = 0; rr < 2; ++rr) ss[rr] += __shfl_xor(ss[rr], o); }
#pragma unroll
        for (int j = 0; j < 4; ++j) { const f32x4 a = *(const LAS f32x4*)(MS + 256 * j + 4 * lane), b = *(const LAS f32x4*)(MS + 1024 + 256 * j + 4 * lane);
#pragma unroll
            for (int rr = 0; rr < 2; ++rr) { const int i = 2 * w + rr; const float rstd = 1.0f / sqrtf(ss[rr] * (1.0f / 1024.0f) + EPS);
                const f32x4 y = v[rr][j] * rstd * a + b; u32x2 o; o.x = pk2(y.x, y.y); o.y = pk2(y.z, y.w);
                *(u32x2*)(H + (size_t)(t0 + i) * 1024 + 256 * j + 4 * lane) = o; *(LAS u32x2*)(XH + i * 1032 + 256 * j + 4 * lane) = o;
                u32x2 lo; lo.x = pk2(y.x - bflo(o.x), y.y - bfhi(o.x)); lo.y = pk2(y.z - bflo(o.y), y.w - bfhi(o.y)); *(LAS u32x2*)(XL + i * 1032 + 256 * j + 4 * lane) = lo; } }
        TACC_E(C, 1); TACC_B(C, 4);
        LBAR();
        TACC_E(C, 4); TACC_B(C, 2);
        if (npend == 2) {
#pragma unroll
            for (int rr = 0; rr < 2; ++rr) if (qtok[rr] >= 0) TOK[(size_t)(qhf * 64 + lane) * MOE_CAP + gbase[(it & 1) * 64 + lane] + qlr[rr]] = qtok[rr]; }
        { f32x4 acc0 = {0.f, 0.f, 0.f, 0.f}, acc1 = {0.f, 0.f, 0.f, 0.f}, acc2 = {0.f, 0.f, 0.f, 0.f};
#pragma unroll
          for (int ks = 0; ks < 16; ++ks) { const int ko = fi * 1032 + kh * 512 + ks * 32 + 8 * fk; const bf16x8 ah = *(const LAS bf16x8*)(XH + ko), al = *(const LAS bf16x8*)(XL + ko);
              acc0 = __builtin_amdgcn_mfma_f32_16x16x32_bf16(ah, bh[ks], acc0, 0, 0, 0); acc1 = __builtin_amdgcn_mfma_f32_16x16x32_bf16(ah, bl[ks], acc1, 0, 0, 0); acc2 = __builtin_amdgcn_mfma_f32_16x16x32_bf16(al, bh[ks], acc2, 0, 0, 0);
              if ((ks & 3) == 3) asm volatile("" ::: "memory"); }
          const f32x4 acc = acc0 + (acc1 + acc2);
#pragma unroll
          for (int r = 0; r < 4; ++r) LG[(kh * 16 + 4 * fk + r) * 64 + eq * 16 + fi] = acc[r]; }
        TACC_E(C, 2); TACC_B(C, 4);
        LBAR();
        TACC_E(C, 4); TACC_B(C, 3);
        if (npend >= 1) { if (C.tid < 64) gbase[((it - 1) & 1) * 64 + C.tid] = gbv;
#pragma unroll
            for (int rr = 0; rr < 2; ++rr) { qlr[rr] = plr[rr]; qtok[rr] = ptok[rr]; } qhf = phf; }
        float sc[2], wsum[2]; int rank[2];
#pragma unroll
        for (int rr = 0; rr < 2; ++rr) { const int i = 2 * w + rr; sc[rr] = sigmf(LG[i * 64 + lane] + LG[(16 + i) * 64 + lane]);
            const unsigned key = (__builtin_bit_cast(unsigned, sc[rr] + rb + 1.0f) & ~63u) | (unsigned)(63 - lane);
            unsigned thr = 0u;
#pragma unroll
            for (int bit = 31; bit >= 0; --bit) { const unsigned cand = thr | (1u << bit); if (__popcll(__ballot(key >= cand)) >= TOPK) thr = cand; }
            unsigned long long selm = __ballot(key >= thr); int rk = 0; float ws = 0.f;
#pragma unroll
            for (int k = 0; k < TOPK; ++k) { const int jl = __ffsll((long long)selm) - 1; selm &= selm - 1;
                const unsigned kj = (unsigned)__builtin_amdgcn_readlane((int)key, jl); ws += __builtin_bit_cast(float, __builtin_amdgcn_readlane(__builtin_bit_cast(int, sc[rr]), jl)); rk += (kj > key) ? 1 : 0; }
            rank[rr] = (key >= thr) ? rk : 64; wsum[rr] = ws; }
#pragma unroll
        for (int rr = 0; rr < 2; ++rr) { const int i = 2 * w + rr; ptok[rr] = -1;
            if (rank[rr] < TOPK) { TOPW[(size_t)(t0 + i) * 8 + rank[rr]] = sc[rr] / wsum[rr] * 2.5f; ptok[rr] = (t0 + i) * 8 + rank[rr];
                plr[rr] = __hip_atomic_fetch_add(&lcnt[lane], 1, __ATOMIC_RELAXED, __HIP_MEMORY_SCOPE_WORKGROUP); } }
        phf = hf; npend = npend < 2 ? npend + 1 : 2;
        TACC_E(C, 3); TACC_B(C, 4);
        LBAR();
        TACC_E(C, 4);
        if (C.tid < 64) { const int n = lcnt[C.tid]; lcnt[C.tid] = 0; gbv = n > 0 ? (int)__hip_atomic_fetch_add(gcnt + (hf * 64 + C.tid) * 16, (unsigned)n, RLX_AGENT) : 0; }
        ++it;
    }
    __syncthreads();
    if (npend == 2) {
#pragma unroll
        for (int rr = 0; rr < 2; ++rr) if (qtok[rr] >= 0) TOK[(size_t)(qhf * 64 + lane) * MOE_CAP + gbase[(it & 1) * 64 + lane] + qlr[rr]] = qtok[rr]; }
    if (npend >= 1 && C.tid < 64) gbase[((it - 1) & 1) * 64 + C.tid] = gbv;
    __syncthreads();
    if (npend >= 1) {
#pragma unroll
        for (int rr = 0; rr < 2; ++rr) if (ptok[rr] >= 0) TOK[(size_t)(phf * 64 + lane) * MOE_CAP + gbase[((it - 1) & 1) * 64 + lane] + plr[rr]] = ptok[rr]; }
    __syncthreads();
#undef RT_LOADROWS
}

__device__ __forceinline__ int moe_tables(const Ctx& C, const Params& P, int li) {
    LAS int* blkstart = (LAS int*)(C.lds + LC_BLKSTART); LAS int* cnt = (LAS int*)(C.lds + LC_CNT); LAS unsigned short* blk2he = (LAS unsigned short*)(C.lds + LC_BLK2HE);
    const unsigned* gcnt = (const unsigned*)(P.ws + WS_CTL) + CW_CNT + (li * 2) * 64 * 16;
    __syncthreads();
    if (C.tid < 128) { int n = (int)__hip_atomic_load(gcnt + C.tid * 16, RLX_AGENT); n = n < 0 ? 0 : (n > MOE_CAP ? MOE_CAP : n); cnt[C.tid] = n; }
    __syncthreads();
    if (C.tid == 0) { int s = 0; for (int i = 0; i < 128; ++i) { blkstart[i] = s; s += (cnt[i] + 255) >> 8; } blkstart[128] = s; }
    __syncthreads();
    const int nblk = blkstart[128];
    if (C.tid < 128) { const int b0 = blkstart[C.tid], b1 = blkstart[C.tid + 1]; for (int b = b0; b < b1 && b < MAXBLK; ++b) blk2he[b] = (unsigned short)C.tid; }
    __syncthreads();
    return nblk < MAXBLK ? nblk : MAXBLK;
}
struct SchedMoE1 {
    const char* H; const char* W1; const int* TOK; const LAS int* blkstart; const LAS unsigned short* blk2he; int nblk, G, c;
    __device__ __forceinline__ bool next(int i, Unit& u) const { int L = i * G + c;
        if (L < 2 * nblk) { const int blk = L >> 1, pn = L & 1, he = blk2he[blk], bi = blk - blkstart[he], e = he & 63; u.A = H; u.rows = TOK + (size_t)he * MOE_CAP + bi * 256;
            u.B = W1 + ((size_t)e * 512 + pn * 256) * 2048; u.pm = blk; u.pn = pn; u.z = 0; return true; }
        L -= 2 * nblk; if (L >= 256) return false; u.pm = L >> 1; u.pn = L & 1; u.z = 1; u.A = H + (size_t)u.pm * 256 * 2048; u.rows = nullptr; u.B = W1 + ((size_t)64 * 512 + u.pn * 256) * 2048; return true; }
};
struct EpiMoE1 {
    static constexpr bool PERM = true; bf16* HID; bf16* HIDS;
    __device__ __forceinline__ void operator()(EPI_ARGS) const { bf16* O = u.z ? HIDS : HID;
#pragma unroll
        for (int ai = 0; ai < 2; ++ai)
#pragma unroll
            for (int m = 0; m < 4; ++m) { const size_t row = (size_t)u.pm * 256 + ai * 128 + wr * 64 + m * 16 + fr; f32x4 v0, v1;
#pragma unroll
                for (int j = 0; j < 4; ++j) { v0[j] = siluf(acc[ai][0][m][0][j]) * acc[ai][1][m][0][j]; v1[j] = siluf(acc[ai][0][m][1][j]) * acc[ai][1][m][1][j]; }
                *(u32x4*)(O + row * 256 + u.pn * 128 + wc * 32 + 8 * fq) = pack8(v0, v1); }
    }
};
struct SchedMoE2 {
    const char* HID; const char* W2; const LAS unsigned short* blk2he; int b0, b1, G, c;
    __device__ __forceinline__ bool next(int i, Unit& u) const { const int L = i * G + c; if (L >= (b1 - b0) * 4) return false; const int blk = b0 + (L >> 2), pn = L & 3, he = blk2he[blk], e = he & 63;
        u.A = HID + (size_t)blk * 256 * 512; u.rows = nullptr; u.B = W2 + ((size_t)e * 1024 + pn * 256) * 512; u.pm = blk; u.pn = pn; u.z = he; return true; }
};
struct EpiMoE2 {
    static constexpr bool PERM = true; bf16* YBUF; const int* TOK; const LAS int* blkstart; const LAS int* cnt; int hf;
    __device__ __forceinline__ void operator()(EPI_ARGS) const { const int he = u.z, bi = u.pm - blkstart[he], n = cnt[he]; const bool odd = fr & 1;
        int tvE[2][4], tvO[2][4];
#pragma unroll
        for (int ai = 0; ai < 2; ++ai)
#pragma unroll
            for (int m = 0; m < 4; ++m) { const int r0 = bi * 256 + ai * 128 + wr * 64 + m * 16 + (fr & ~1); tvE[ai][m] = TOK[(size_t)he * MOE_CAP + r0]; tvO[ai][m] = TOK[(size_t)he * MOE_CAP + r0 + 1]; }
#pragma unroll
        for (int ai = 0; ai < 2; ++ai)
#pragma unroll
            for (int m = 0; m < 4; ++m) { const int r0 = bi * 256 + ai * 128 + wr * 64 + m * 16 + (fr & ~1);
                u32x4 A, B; widen_pair(pack8(acc[ai][0][m][0], acc[ai][0][m][1]), pack8(acc[ai][1][m][0], acc[ai][1][m][1]), odd, A, B);
                const int coff = u.pn * 256 + wc * 64 + (odd ? 32 : 0) + 8 * fq;
                if (r0 < n) { const int v = tvE[ai][m]; *(u32x4*)(YBUF + ((size_t)((v >> 3) - hf * HALF_T) * 6 + (v & 7)) * 1024 + coff) = A; }
                if (r0 + 1 < n) { const int v = tvO[ai][m]; *(u32x4*)(YBUF + ((size_t)((v >> 3) - hf * HALF_T) * 6 + (v & 7)) * 1024 + coff) = B; } }
    }
};
struct EpiNull {
    static constexpr bool PERM = true;
    __device__ __forceinline__ void operator()(EPI_ARGS) const {
#pragma unroll
        for (int ai = 0; ai < 2; ++ai)
#pragma unroll
            for (int m = 0; m < 4; ++m)
#pragma unroll
                for (int bj = 0; bj < 2; ++bj) { asm volatile("" :: "v"(acc[ai][bj][m][0]), "v"(acc[ai][bj][m][1])); }
    }
};
template <bool FUSE> struct EpiCombine {
    static constexpr bool PERM = true; const bf16* YBUF; const float* TOPW; float* X; const float* gate; int hf;
    bf16* HS; float* SSP; LAS float* red;
    __device__ __forceinline__ void operator()(EPI_ARGS) const { const bool odd = fr & 1;
        LAS float* tw = red + 1024; LAS float* gs = tw + 2048;
        { const int t = threadIdx.x, token0 = hf * HALF_T + u.pm * 256;
          *(LAS f32x4*)(tw + t * 4) = *(const f32x4*)(TOPW + (size_t)token0 * 8 + t * 4);
          if (t < (FUSE ? 128 : 64)) { const float* src = gate + (size_t)(token0 >> 12) * 6144 + u.pn * 256 + (t & 63) * 4 + (t >= 64 ? (8 * 6144 + 1024 - 5120) : 0);
              f32x4 v = *(const f32x4*)src; if (t >= 64) v = v + 1.0f; *(LAS f32x4*)(gs + t * 4) = v; }
          asm volatile("s_waitcnt vmcnt(0) lgkmcnt(0)" ::: "memory"); __builtin_amdgcn_s_barrier(); asm volatile("" ::: "memory"); }
        int lr0 = wr * 64 + fr, cw = wc * 64 + 8 * fq; asm volatile("" : "+v"(lr0), "+v"(cw));
        const unsigned tk0 = (unsigned)(hf * HALF_T + u.pm * 256 + lr0);
        const unsigned yo0 = (((unsigned)(u.pm * 256 + lr0) * 6u) * 1024u + (unsigned)(u.pn * 256 + cw)) * 2u, xo0 = (tk0 * 1024u + (unsigned)(u.pn * 256 + cw)) * 4u;
        const unsigned ho0 = ((tk0 & ~1u) * 1024u + (unsigned)(u.pn * 256 + wc * 64 + (odd ? 32 : 0) + 8 * fq)) * 2u; (void)ho0;
#pragma unroll
        for (int ai = 0; ai < 2; ++ai)
#pragma unroll
            for (int m = 0; m < 4; ++m) { const int R = ai * 128 + m * 16, lr = R + lr0;
                const f32x4 w03 = *(const LAS f32x4*)(tw + lr * 8), w47 = *(const LAS f32x4*)(tw + lr * 8 + 4); const float wk[6] = {w03[0], w03[1], w03[2], w03[3], w47[0], w47[1]};
                const char* yb = (const char*)YBUF + (size_t)(yo0 + (unsigned)R * 12288u); char* xb = (char*)X + (size_t)(xo0 + (unsigned)R * 4096u);
                float ssq = 0.f; u32x4 hd[2];
#pragma unroll
                for (int bj = 0; bj < 2; ++bj) { u32x4 y[6]; f32x4 n0, n1;
#pragma unroll
                    for (int k = 0; k < 6; ++k) y[k] = *(const u32x4*)(yb + k * 2048 + bj * 64);
                    n0 = *(const f32x4*)(xb + bj * 128); n1 = *(const f32x4*)(xb + bj * 128 + 16);
                    f32x4 v0 = acc[ai][bj][m][0], v1 = acc[ai][bj][m][1];
#pragma unroll
                    for (int k = 0; k < 6; ++k) { const u32x4 yy = y[k];
                        v0[0] += wk[k] * bflo(yy.x); v0[1] += wk[k] * bfhi(yy.x); v0[2] += wk[k] * bflo(yy.y); v0[3] += wk[k] * bfhi(yy.y);
                        v1[0] += wk[k] * bflo(yy.z); v1[1] += wk[k] * bfhi(yy.z); v1[2] += wk[k] * bflo(yy.w); v1[3] += wk[k] * bfhi(yy.w); }
                    const f32x4 g0 = *(const LAS f32x4*)(gs + cw + bj * 32), g1 = *(const LAS f32x4*)(gs + cw + bj * 32 + 4);
                    n0 = n0 + g0 * v0; n1 = n1 + g1 * v1;
                    *(f32x4*)(xb + bj * 128) = n0; *(f32x4*)(xb + bj * 128 + 16) = n1;
                    if constexpr (FUSE) { const f32x4 a0 = *(const LAS f32x4*)(gs + 256 + cw + bj * 32), a1 = *(const LAS f32x4*)(gs + 256 + cw + bj * 32 + 4);
                        ssq += (n0[0] * n0[0] + n0[1] * n0[1]) + (n0[2] * n0[2] + n0[3] * n0[3]) + (n1[0] * n1[0] + n1[1] * n1[1]) + (n1[2] * n1[2] + n1[3] * n1[3]);
                        hd[bj] = pack8(n0 * a0, n1 * a1); } }
                if constexpr (FUSE) {
                    u32x4 A, B; widen_pair(hd[0], hd[1], odd, A, B);
                    char* hp = (char*)HS + (size_t)(ho0 + (unsigned)R * 2048u); *(u32x4*)hp = A; *(u32x4*)(hp + 2048) = B;
                    ssq += __shfl_xor(ssq, 16); ssq += __shfl_xor(ssq, 32); red[lr * 4 + wc] = ssq; } }
        if constexpr (FUSE) {
            asm volatile("s_waitcnt lgkmcnt(0)" ::: "memory"); __builtin_amdgcn_s_barrier(); asm volatile("" ::: "memory");
            if (threadIdx.x < 256) { const f32x4 r4 = *(const LAS f32x4*)(red + threadIdx.x * 4); SSP[(size_t)u.pn * T + hf * HALF_T + u.pm * 256 + threadIdx.x] = (r4[0] + r4[1]) + (r4[2] + r4[3]); }
            asm volatile("s_waitcnt lgkmcnt(0)" ::: "memory"); __builtin_amdgcn_s_barrier(); asm volatile("" ::: "memory");
        }
    }
};
struct EpiHyIn {
    static constexpr bool PERM = true; bf16* O; const float* SSP; const float* SHW;
    __device__ __forceinline__ void operator()(EPI_ARGS) const { const bool odd = fr & 1;
        float rs[2][4]; f32x4 bw[2][2];
        { const float* bp = SHW + (size_t)((u.pm * 256) >> 12) * 3072 + u.pn * 256 + wc * 64 + 8 * fq;
#pragma unroll
          for (int bj = 0; bj < 2; ++bj) { bw[bj][0] = *(const f32x4*)(bp + bj * 32); bw[bj][1] = *(const f32x4*)(bp + bj * 32 + 4); } }
#pragma unroll
        for (int ai = 0; ai < 2; ++ai)
#pragma unroll
            for (int m = 0; m < 4; ++m) { const size_t row = (size_t)u.pm * 256 + ai * 128 + wr * 64 + m * 16 + fr;
                rs[ai][m] = (SSP[row] + SSP[T + row]) + (SSP[2 * (size_t)T + row] + SSP[3 * (size_t)T + row]); }
#pragma unroll
        for (int ai = 0; ai < 2; ++ai)
#pragma unroll
            for (int m = 0; m < 4; ++m) { const size_t row = (size_t)u.pm * 256 + ai * 128 + wr * 64 + m * 16 + fr; const float r = 1.0f / sqrtf(rs[ai][m] * (1.0f / 1024.0f) + EPS); u32x4 d[2];
#pragma unroll
                for (int bj = 0; bj < 2; ++bj) d[bj] = pack8(acc[ai][bj][m][0] * r + bw[bj][0], acc[ai][bj][m][1] * r + bw[bj][1]);
                u32x4 A, B; widen_pair(d[0], d[1], odd, A, B);
                bf16* op = O + (row & ~(size_t)1) * 3072 + u.pn * 256 + wc * 64 + (odd ? 32 : 0) + 8 * fq; *(u32x4*)op = A; *(u32x4*)(op + 3072) = B; }
    }
};
__device__ __forceinline__ void ph_shw(const Ctx& C, const Params& P, int item0, int istride) {
    LAS float* sc = (LAS float*)(C.lds + RING_OFF);
    LAS float* red = sc + 8 * 1024;
    const float* mod1 = (const float*)(P.ws + WS_MOD) + (size_t)8 * 6144; float* SHW = (float*)(P.ws + WS_SHW);
    if (item0 >= 48) return;
    __syncthreads();
    for (int i = C.tid; i < 8 * 1024; i += 512) sc[i] = mod1[(size_t)(i >> 10) * 6144 + (i & 1023)];
    __syncthreads();
    for (int item = item0; item < 48; item += istride) {
        const int j0 = item * 64, c4 = C.tid & 15, kp = C.tid >> 4;
        f32x4 a[8];
#pragma unroll
        for (int r = 0; r < 8; ++r) a[r] = (f32x4){0.f, 0.f, 0.f, 0.f};
        const float* w = P.hy_w_in + j0 + 4 * c4;
#pragma unroll 8
        for (int k = kp * 32; k < kp * 32 + 32; ++k) { const f32x4 wv = *(const f32x4*)(w + (size_t)k * 3072);
#pragma unroll
            for (int r = 0; r < 8; ++r) a[r] += wv * sc[r * 1024 + k]; }
#pragma unroll
        for (int r = 0; r < 8; ++r) *(LAS f32x4*)(red + (kp * 8 + r) * 64 + 4 * c4) = a[r];
        __syncthreads();
        { const int r = C.tid >> 6, cc = C.tid & 63; float s2 = 0.f;
#pragma unroll 8
          for (int q = 0; q < 32; ++q) s2 += red[(q * 8 + r) * 64 + cc];
          SHW[(size_t)r * 3072 + j0 + cc] = s2; }
        __syncthreads();
    }
}

__device__ __forceinline__ void ph_hy_prep(const Ctx& C, const Params& P) {
    const bf16* PP = (const bf16*)(P.ws + AR_P); bf16* X0 = (bf16*)(P.ws + AR_X0); bf16* ZT = (bf16*)(P.ws + AR_ZT);
    LAS bf16* ZS = (LAS bf16*)(C.lds + RING_OFF);
    const int tl = C.tid >> 3, d8 = (C.tid & 7) * 8;
    if (C.G % 16 != 0) return;
    const int dt = C.bid & 15, d0 = dt * 64, nwg = C.G >> 4;
    float cw[3][3][8], cb[3][8];
#pragma unroll
    for (int sec = 0; sec < 3; ++sec) {
#pragma unroll
        for (int e = 0; e < 8; ++e) { cb[sec][e] = P.hy_conv_b[sec * 1024 + d0 + d8 + e];
#pragma unroll
            for (int j = 0; j < 3; ++j) cw[sec][j][e] = P.hy_conv_w[j * 3072 + sec * 1024 + d0 + d8 + e]; } }
    u32x4 g[3][3];
#define HP_LOAD(step_) do { const int it_ = (step_) >> 1, b_ = 2 * (it_ >> 6) + ((step_) & 1), t_ = (it_ & 63) * 64 + tl; \
        _Pragma("unroll") for (int j = 0; j < 3; ++j) { const int tt = t_ - 1 + j; const bool ok = tt >= 0 && tt < SEQ; const size_t r_ = (size_t)b_ * SEQ + (ok ? tt : t_); \
            _Pragma("unroll") for (int sec = 0; sec < 3; ++sec) { g[sec][j] = *(const u32x4*)(PP + r_ * 3072 + sec * 1024 + d0 + d8); if (!ok) g[sec][j] = (u32x4){0u, 0u, 0u, 0u}; } } } while (0)
    constexpr int NSTEP = 2 * 4 * 64;
    int step = 2 * (C.bid >> 4), par = 0;
    if (step < NSTEP) HP_LOAD(step);
    for (; step < NSTEP; ) {
        const int it = step >> 1, q = step & 1, bp = it >> 6, b = 2 * bp + q, t0 = (it & 63) * 64, t = t0 + tl; const size_t row = (size_t)b * SEQ + t;
        float o[3][8];
#pragma unroll
        for (int sec = 0; sec < 3; ++sec) {
#pragma unroll
            for (int e = 0; e < 8; ++e) o[sec][e] = cb[sec][e];
#pragma unroll
            for (int j = 0; j < 3; ++j) { const u32x4 w = g[sec][j];
                o[sec][0] += bflo(w.x) * cw[sec][j][0]; o[sec][1] += bfhi(w.x) * cw[sec][j][1]; o[sec][2] += bflo(w.y) * cw[sec][j][2]; o[sec][3] += bfhi(w.y) * cw[sec][j][3];
                o[sec][4] += bflo(w.z) * cw[sec][j][4]; o[sec][5] += bfhi(w.z) * cw[sec][j][5]; o[sec][6] += bflo(w.w) * cw[sec][j][6]; o[sec][7] += bfhi(w.w) * cw[sec][j][7]; } }
        const int nstep = q == 0 ? step + 1 : step + 2 * nwg - 1;
        if (nstep < NSTEP) HP_LOAD(nstep);
        { u32x4 w; w.x = pk2(o[0][0], o[0][1]); w.y = pk2(o[0][2], o[0][3]); w.z = pk2(o[0][4], o[0][5]); w.w = pk2(o[0][6], o[0][7]); *(u32x4*)(X0 + row * 1024 + d0 + d8) = w; }
        LAS bf16* zs = ZS + par * (64 * 136);
#pragma unroll
        for (int e = 0; e < 8; ++e) zs[(d8 + e) * 136 + tl * 2 + q] = (bf16)f2bf(o[2][e] * o[1][e]);
        if (q == 1) {
            LBAR();
            { const int dl = C.tid >> 3, tp = (C.tid & 7) * 8; const u32x4 w0 = *(const LAS u32x4*)(zs + dl * 136 + tp * 2), w1 = *(const LAS u32x4*)(zs + dl * 136 + tp * 2 + 8);
              bf16* zo = ZT + (((size_t)(d0 + dl) * 4 + bp) * SEQ + t0 + tp) * 2; *(u32x4*)zo = w0; *(u32x4*)(zo + 8) = w1; }
            par ^= 1;
        }
        step = nstep;
    }
#undef HP_LOAD
    __syncthreads();
}

__device__ __forceinline__ f32x2 cmul(f32x2 a, f32x2 b) { return (f32x2){a.x * b.x - a.y * b.y, a.x * b.y + a.y * b.x}; }
__device__ __forceinline__ f32x2 cmulc(f32x2 a, f32x2 b) { return (f32x2){a.x * b.x + a.y * b.y, a.y * b.x - a.x * b.y}; }
template <bool INV> __device__ __forceinline__ void dft16(f32x2 (&v)[16]) {
    constexpr float WC[10] = {1.f, 0.9238795325112867f, 0.7071067811865476f, 0.3826834323650898f, 0.f, 0.f, -0.7071067811865476f, 0.f, 0.f, -0.9238795325112867f};
    constexpr float WS_[10] = {0.f, 0.3826834323650898f, 0.7071067811865476f, 0.9238795325112867f, 1.f, 0.f, 0.7071067811865476f, 0.f, 0.f, -0.3826834323650898f};
    f32x2 t[16];
#pragma unroll
    for (int b = 0; b < 4; ++b) { const f32x2 x0 = v[b], x1 = v[4 + b], x2 = v[8 + b], x3 = v[12 + b];
        const f32x2 s0 = x0 + x2, s1 = x0 - x2, s2 = x1 + x3, s3 = x1 - x3; const f32x2 is3 = (f32x2){-s3.y, s3.x};
        t[0 * 4 + b] = s0 + s2; t[2 * 4 + b] = s0 - s2; t[1 * 4 + b] = INV ? s1 + is3 : s1 - is3; t[3 * 4 + b] = INV ? s1 - is3 : s1 + is3; }
#pragma unroll
    for (int c = 1; c < 4; ++c)
#pragma unroll
        for (int b = 1; b < 4; ++b) { const int mm = b * c; const f32x2 w = (f32x2){WC[mm], WS_[mm]}; t[c * 4 + b] = INV ? cmul(t[c * 4 + b], w) : cmulc(t[c * 4 + b], w); }
#pragma unroll
    for (int c = 0; c < 4; ++c) { const f32x2 x0 = t[c * 4], x1 = t[c * 4 + 1], x2 = t[c * 4 + 2], x3 = t[c * 4 + 3];
        const f32x2 s0 = x0 + x2, s1 = x0 - x2, s2 = x1 + x3, s3 = x1 - x3; const f32x2 is3 = (f32x2){-s3.y, s3.x};
        v[c] = s0 + s2; v[c + 8] = s0 - s2; v[c + 4] = INV ? s1 + is3 : s1 - is3; v[c + 12] = INV ? s1 - is3 : s1 + is3; }
}
constexpr int FF_TW = RING_OFF, FF_TW2 = FF_TW + 32768, FF_DE = FF_TW2 + 32768, FF_DO = FF_DE + 4352 * 8, FF_RED = FF_DO + 4352 * 8, FF_ZST = FF_RED + 64  , FF_END = FF_ZST + 16384;
static_assert(FF_END <= LDS_BYTES, "FFT LDS");
__device__ __forceinline__ int pidx(int i) { return i + (i >> 4); }
__device__ __forceinline__ void fft_fwd(LAS f32x2* D, const LAS f32x2* TW, int t8, f32x2 (&v)[16]) {
#pragma unroll
    for (int a = 0; a < 16; ++a) v[a] = D[pidx(256 * a + t8)];
    dft16<false>(v);
    { const int n1 = t8 >> 4;
#pragma unroll
      for (int k0 = 0; k0 < 16; ++k0) D[pidx(256 * k0 + t8)] = cmul(v[k0], TW[(16 * n1 * k0) & 4095]); }
    LBAR();
    { const int k0 = t8 >> 4, n0 = t8 & 15;
#pragma unroll
      for (int a = 0; a < 16; ++a) v[a] = D[pidx(256 * k0 + 16 * a + n0)];
      dft16<false>(v);
#pragma unroll
      for (int k1 = 0; k1 < 16; ++k1) D[pidx(256 * k0 + 16 * k1 + n0)] = cmul(v[k1], TW[(n0 * (k0 + 16 * k1)) & 4095]); }
    LBAR();
#pragma unroll
    for (int a = 0; a < 16; ++a) v[a] = D[pidx(16 * t8 + a)];
    dft16<false>(v);
}
__device__ __forceinline__ void fft_inv(LAS f32x2* D, const LAS f32x2* TW, int t8, f32x2 (&v)[16]) {
    dft16<true>(v);
    { const int kk = t8;
      const int kq = (kk >> 4) + 16 * (kk & 15);
#pragma unroll
      for (int n0 = 0; n0 < 16; ++n0) D[pidx(16 * t8 + n0)] = cmulc(v[n0], TW[(n0 * kq) & 4095]); }
    LBAR();
    { const int k0 = t8 >> 4, n0 = t8 & 15;
#pragma unroll
      for (int a = 0; a < 16; ++a) v[a] = D[pidx(256 * k0 + 16 * a + n0)];
      dft16<true>(v);
#pragma unroll
      for (int n1 = 0; n1 < 16; ++n1) D[pidx(256 * k0 + 16 * n1 + n0)] = cmulc(v[n1], TW[(16 * n1 * k0) & 4095]); }
    LBAR();
#pragma unroll
    for (int a = 0; a < 16; ++a) v[a] = D[pidx(256 * a + t8)];
    dft16<true>(v);
#pragma unroll
    for (int a = 0; a < 16; ++a) D[pidx(256 * a + t8)] = v[a];
    LBAR();
}
__device__ __forceinline__ void ph_hy_fft(const Ctx& C, const Params& P) {
    LAS f32x2* TW = (LAS f32x2*)(C.lds + FF_TW); LAS f32x2* TW2 = (LAS f32x2*)(C.lds + FF_TW2); LAS f32x2* DE = (LAS f32x2*)(C.lds + FF_DE); LAS f32x2* DO = (LAS f32x2*)(C.lds + FF_DO); LAS float* RED = (LAS float*)(C.lds + FF_RED);
    const float* HFT = (const float*)(P.ws + WS_HFT); const unsigned* ZT2 = (const unsigned*)(P.ws + AR_ZT); unsigned* YT2 = (unsigned*)(P.ws + AR_YT);
    const int br = C.tid >> 8, t8 = C.tid & 255; LAS f32x2* D = br ? DO : DE;
    LAS unsigned* ZST = (LAS unsigned*)(C.lds + FF_ZST);
#define FF_DMA(bp_) do { _Pragma("unroll") for (int q_ = 0; q_ < 2; ++q_) __builtin_amdgcn_global_load_lds(ZT2 + ((size_t)d * 4 + (bp_)) * SEQ + (C.wave * 2 + q_) * 256 + C.lane * 4, ZST + (C.wave * 2 + q_) * 256, 16, 0, 0); } while (0)
    for (int i = C.tid; i < 4096; i += 512) { float s, c; sincosf(6.283185307179586f * (float)i / 4096.0f, &s, &c); TW[i] = (f32x2){c, -s}; sincosf(6.283185307179586f * (float)i / 8192.0f, &s, &c); TW2[i] = (f32x2){c, -s}; }
    __syncthreads();
    for (int d = C.bid; d < 1024; d += C.G) {
        const float* hf = HFT + (size_t)d * 2 * 4096; const float* hb = hf + 4096;
        FF_DMA(0);
        float ss = 0.f;
#pragma unroll
        for (int a = 0; a < 16; ++a) { const int n = 256 * a + t8; const float f = hf[n], g = hb[n == 0 ? 0 : 4096 - n]; ss += f * f + g * g;
            D[pidx(n)] = br == 0 ? (f32x2){f + g, 0.f} : (n == 0 ? (f32x2){f + g, 0.f} : (f32x2){(f - g) * TW2[n].x, (f - g) * TW2[n].y}); }
        ss = wave_sum(ss); if (C.lane == 0) RED[C.wave] = ss;
        __syncthreads();
        const float scale = 1.0f / sqrtf(RED[0] + RED[1] + RED[2] + RED[3] + EPS);
        f32x2 v[16]; const float bias = P.hy_bias[d];
        fft_fwd(D, TW, t8, v);
        f32x2* HSP = (f32x2*)(P.ws + AR_HSP) + (size_t)C.bid * 8192 + br * 4096 + t8;
#pragma unroll
        for (int a = 0; a < 16; ++a) { f32x2 hv = v[a] * scale; hv.x += bias; HSP[a * 256] = hv; }
        for (int bp = 0; bp < 4; ++bp) {
            __syncthreads();
#pragma unroll
            for (int a = 0; a < 16; ++a) { const int n = 256 * a + t8; const unsigned zw = ZST[n]; const f32x2 zc = (f32x2){bflo(zw), bfhi(zw)}; D[pidx(n)] = br == 0 ? zc : cmul(zc, TW2[n]); }
            LBAR();
            if (bp < 3) FF_DMA(bp + 1);
            fft_fwd(D, TW, t8, v);
#pragma unroll
            for (int a = 0; a < 16; ++a) v[a] = cmul(v[a], HSP[a * 256]);
            fft_inv(D, TW, t8, v);
            unsigned* yo = YT2 + ((size_t)d * 4 + bp) * SEQ;
#pragma unroll
            for (int j = 0; j < 8; ++j) { const int n = C.tid + 512 * j; const f32x2 ye = DE[pidx(n)], yo2 = DO[pidx(n)]; const f32x2 y = (ye + cmulc(yo2, TW2[n])) * (1.0f / 8192.0f);
                yo[n] = pk2(y.x, y.y); }
        }
        __syncthreads();
    }
#undef FF_DMA
}
__device__ __forceinline__ void ph_hy_gate(const Ctx& C, const Params& P) {
    const bf16* X0 = (const bf16*)(P.ws + AR_X0); const bf16* YT = (const bf16*)(P.ws + AR_YT); bf16* AO = (bf16*)(P.ws + WS_H);
    LAS bf16* TS = (LAS bf16*)(C.lds + RING_OFF);
    const int dl = C.tid >> 3, tp = (C.tid & 7) * 8;
    const int tl = C.tid >> 3, d8 = (C.tid & 7) * 8;
    constexpr int NIT = 4 * 64 * 16;
    u32x4 gy0, gy1, gx0, gx1;
#define HG_LOAD(item_) do { const int dt_ = (item_) & 15, it_ = (item_) >> 4, bp_ = it_ >> 6, t0_ = (it_ & 63) * 64, d0_ = dt_ * 64; \
        const bf16* yp_ = YT + (((size_t)(d0_ + dl) * 4 + bp_) * SEQ + t0_ + tp) * 2; gy0 = *(const u32x4*)yp_; gy1 = *(const u32x4*)(yp_ + 8); \
        gx0 = *(const u32x4*)(X0 + ((size_t)(2 * bp_) * SEQ + t0_ + tl) * 1024 + d0_ + d8); gx1 = *(const u32x4*)(X0 + ((size_t)(2 * bp_ + 1) * SEQ + t0_ + tl) * 1024 + d0_ + d8); } while (0)
    int item = C.bid, par = 0;
    if (item < NIT) HG_LOAD(item);
    for (; item < NIT; item += C.G) {
        const int dt = item & 15, it = item >> 4, bp = it >> 6, t0 = (it & 63) * 64, d0 = dt * 64;
        LAS bf16* ts = TS + par * (2 * 64 * 72);
        { const unsigned w[8] = {gy0.x, gy0.y, gy0.z, gy0.w, gy1.x, gy1.y, gy1.z, gy1.w};
#pragma unroll
          for (int e = 0; e < 8; ++e) { ts[(tp + e) * 72 + dl] = (bf16)(w[e] & 0xffff); ts[64 * 72 + (tp + e) * 72 + dl] = (bf16)(w[e] >> 16); } }
        const u32x4 x0 = gx0, x1 = gx1;
        if (item + C.G < NIT) HG_LOAD(item + C.G);
        LBAR();
#pragma unroll
        for (int q = 0; q < 2; ++q) { const u32x4 x = q ? x1 : x0; const size_t o = ((size_t)(2 * bp + q) * SEQ + t0 + tl) * 1024 + d0 + d8; const u32x4 y = *(const LAS u32x4*)(ts + q * 64 * 72 + tl * 72 + d8);
          u32x4 w; w.x = pk2(bflo(x.x) * bflo(y.x), bfhi(x.x) * bfhi(y.x)); w.y = pk2(bflo(x.y) * bflo(y.y), bfhi(x.y) * bfhi(y.y)); w.z = pk2(bflo(x.z) * bflo(y.z), bfhi(x.z) * bfhi(y.z)); w.w = pk2(bflo(x.w) * bflo(y.w), bfhi(x.w) * bfhi(y.w));
          *(u32x4*)(AO + o) = w; }
        par ^= 1;
    }
#undef HG_LOAD
    __syncthreads();
}
struct EpiStoreBf16 {
    static constexpr bool PERM = true; bf16* O; int ldc;
    __device__ __forceinline__ void operator()(EPI_ARGS) const { const bool odd = fr & 1;
#pragma unroll
        for (int ai = 0; ai < 2; ++ai)
#pragma unroll
            for (int m = 0; m < 4; ++m) { const size_t rowE = (size_t)u.pm * 256 + ai * 128 + wr * 64 + m * 16 + (fr & ~1); u32x4 A, B; widen_pair(pack8(acc[ai][0][m][0], acc[ai][0][m][1]), pack8(acc[ai][1][m][0], acc[ai][1][m][1]), odd, A, B);
                bf16* op = O + rowE * ldc + u.pn * 256 + wc * 64 + (odd ? 32 : 0) + 8 * fq; *(u32x4*)op = A; *(u32x4*)(op + ldc) = B; }
    }
};

__global__ void __launch_bounds__(512, 2) fwd_kernel(Params P) {
    extern __shared__ __attribute__((aligned(16))) unsigned char lds_raw[];
    Ctx C; C.tacc = 0; C.tbeg = 0; C.lds = (LAS unsigned char*)lds_raw; C.tid = threadIdx.x; C.lane = C.tid & 63; C.wave = __builtin_amdgcn_readfirstlane(C.tid >> 6); C.G = gridDim.x; C.bid = blockIdx.x;
    const int vcu = (C.G % 8 == 0) ? (C.bid % 8) * (C.G / 8) + C.bid / 8 : C.bid;
    for (int i = C.tid; i < LDS_CTL_BYTES / 4; i += 512) ((LAS unsigned*)C.lds)[i] = 0u;
    __syncthreads();
    unsigned char* ws = P.ws;
#if N_LAUNCH_MODE == 1
    XcdBarrier bar = xcd_barrier_post((unsigned*)(ws + WS_CTL) + CW_BAR, (volatile LAS unsigned*)(C.lds + 32));
#define SEAM(k) do { if (IN(k) && IN((k) + 1)) xcd_barrier(bar); EVT((k) + 1); } while (0)
#else
#define SEAM(k) do { EVT((k) + 1); } while (0)
#endif
#ifndef DUP_ID
#define DUP_ID -1
#endif
#ifndef DUP_MASK
#define DUP_MASK 0u
#endif
#define DUP(id, ...) do { __VA_ARGS__; if (DUP_ID == (id) || ((DUP_MASK >> (id)) & 1u)) { __syncthreads(); __VA_ARGS__; } } while (0)
#define TS_AMP 8
    unsigned long long tsA = 0, tsB = 0;
#define EVT(id) do { if (TS_FROM == (id)) tsA = wall_clock64(); if (TS_TO == (id)) tsB = wall_clock64(); } while (0)
    EVT(0);
    const int lo = P.ph_lo, hi = P.ph_hi;
#ifndef PH_MASK
#define PH_MASK 0xffffffffu
#endif
#define IN(k) (((PH_MASK >> (k)) & 1u) && lo <= (k) && (k) < hi)
    LAS unsigned char* ring = C.lds + RING_OFF;
    const float* mod = (const float*)(ws + WS_MOD);

    if (IN(0)) { ph_mod(C, P); __syncthreads(); EVT(100); ph_conv_l0(C, P); __syncthreads(); ph_s5_tables(C, P, C.G - 1 - C.bid, C.G); } SEAM(0);
    if (IN(1)) { DUP(1, ph_norm(C, P, P.x, 0, 0, true)); } SEAM(1);
    if (IN(2)) { SchedDense S{(const char*)(ws + WS_H), (const char*)(ws + WS_WIN), 2048u, 2048u, TA / 256, 4, C.G, vcu}; EpiInProj E{(bf16*)(ws + AR_PROJ), (bf16*)(ws + AR_U)};
        pg8::gemm_phase(ring, 1024, 2048u, 2048u, S, E);
        const int nfree = C.G - (TA / 256 * 4 - 2 * C.G);
        if (C.G == 256 && vcu >= C.G - nfree) { const int r = vcu - (C.G - nfree); ph_conv_l0b(C, P, r * 8 + C.wave, nfree * 8); }
        else if (C.G != 256) { ph_conv_l0b(C, P, C.bid * 8 + C.wave, C.G * 8); } } SEAM(2);
    if (IN(3)) { ph_rownorm1(C, P); EVT(103);
        SchedBatched S{(const char*)(ws + AR_U), (const char*)(ws + WS_SOUT), 1536u, 1024u, (size_t)S5ROWS * 1536, (size_t)256 * 1024, S5G, 5, 1, C.G, vcu}; EpiF32Batched E{(float*)(ws + AR_SRAW), S5ROWS, 256};
        DUP(3, pg8::gemm_phase(ring, 512, 1536u, 1024u, S, E)); } SEAM(3);
    if (IN(4)) { SchedUp S{(const char*)(ws + AR_QN), (const char*)(ws + WS_WUQ), (const char*)(ws + AR_CKV), (const char*)(ws + WS_WUKV), C.G, vcu}; EpiUp E{(bf16*)(ws + AR_QRAW), (bf16*)(ws + AR_KVRAW)};
        DUP(4, pg8::gemm_phase(ring, 256, 512u, 512u, S, E); ph_s5_scan(C, P)); } SEAM(4);
    if (IN(5)) { ph_qkfinal(C, P); EVT(105);
        SchedBatched S{(const char*)(ws + AR_U), (const char*)(ws + WS_WG), 1536u, 1536u, (size_t)S5ROWS * 1536, (size_t)512 * 1536, S5G, 4, 2, C.G, vcu}; EpiS5C E{(bf16*)(ws + AR_Z)};
        DUP(5, pg8::gemm_phase(ring, 768, 1536u, 1536u, S, E)); } SEAM(5);
    if (IN(6)) { float gqm = 0.f, gkm = 0.f;
        for (int j = 0; j < QKH; ++j) { gqm = fmaxf(gqm, fabsf(P.q_qk[j])); gkm = fmaxf(gkm, fabsf(P.k_qk[j])); }
        const float sbound = 96.0f * gqm * gkm * (0.10206207261596577f * 1.4426950408889634f) * 1.02f;
        if (sbound < 90.0f) ph_attention<true>(C, P, vcu); else ph_attention<false>(C, P, vcu);
        EVT(106);
        SchedDense S{(const char*)(ws + AR_Z), (const char*)(ws + WS_WGLU), 1024u, 1024u, T / 256, 2, C.G, vcu}; EpiGlu E{(const bf16*)(ws + AR_Z), P.glu_b, (bf16*)(ws + AR_CAT)};
        DUP(26, pg8::gemm_phase(ring, 512, 1024u, 1024u, S, E)); } SEAM(6);
    if (IN(7)) { SchedDense S{(const char*)(ws + AR_CAT), (const char*)(ws + WS_WOUT), 2048u, 2048u, T / 256, 4, C.G, vcu}; EpiResid E{P.x, P.out, mod + 2048};
        pg8::gemm_phase(ring, 1024, 2048u, 2048u, S, E); } SEAM(7);
#define MOE_LAYER(li, pb) do { \
        if (IN(pb)) { ph_conv_moe(C, P, li); __syncthreads(); EVT(110 + li); ph_router(C, P, P.out, li, li); if ((DUP_MASK >> 27) & 1u) { __syncthreads(); ph_router(C, P, P.out, li, 2 + li); } } SEAM(pb); \
        if (IN(pb + 1)) { const int nblk = moe_tables(C, P, li); \
            SchedMoE1 S{(const char*)(ws + WS_H), (const char*)(ws + AR_W1), (const int*)(ws + WS_TOK), (const LAS int*)(C.lds + LC_BLKSTART), (const LAS unsigned short*)(C.lds + LC_BLK2HE), nblk, C.G, vcu}; \
            EpiMoE1 E{(bf16*)(ws + AR_HID), (bf16*)(ws + AR_HIDS)}; \
            DUP(pb + 1, pg8::gemm_phase(ring, 1024, 2048u, 2048u, S, E)); \
            if (TS_FROM == 210 && li == 0) { __syncthreads(); EVT(210); EpiNull EN{}; pg8::gemm_phase(ring, 1024, 2048u, 2048u, S, EN); EVT(211); } \
            if (TS_FROM == 212 && li == 0) { __syncthreads(); EVT(212); pg8::gemm_phase(ring, 1024, 2048u, 2048u, S, E); EVT(213); } \
            if (li == 0) {   \
                const int total = 2 * nblk + 256, rem = total % C.G, nshort = rem == 0 ? C.G : C.G - rem, r = rem == 0 ? vcu : vcu - rem; \
                if (r >= 0) { ph_shw(C, P, r, nshort); ph_hy_filter(C, P, r, nshort); ph_conv_l1(C, P, r * 8 + C.wave, nshort * 8); } } \
            } SEAM(pb + 1); \
        MOE_HALF(li, pb, 0); MOE_HALF(li, pb, 1); } while (0)
#define MOE_HALF(li, pb, hf) do { \
            if (IN(pb + 2 + 2 * hf)) { (void)moe_tables(C, P, li); const LAS int* bs = (const LAS int*)(C.lds + LC_BLKSTART); \
                SchedMoE2 S{(const char*)(ws + AR_HID), (const char*)(ws + AR_W2), (const LAS unsigned short*)(C.lds + LC_BLK2HE), bs[hf * 64], bs[hf * 64 + 64], C.G, vcu}; \
                EpiMoE2 E{(bf16*)(ws + AR_YBUF), (const int*)(ws + WS_TOK), bs, (const LAS int*)(C.lds + LC_CNT), hf}; \
                pg8::gemm_phase(ring, 256, 512u, 512u, S, E); } SEAM(pb + 2 + 2 * hf); \
            if (IN(pb + 3 + 2 * hf)) { SchedDense S{(const char*)(ws + AR_HIDS) + (size_t)hf * HALF_T * 512, (const char*)(ws + AR_W2) + (size_t)64 * 1024 * 512, 512u, 512u, HALF_T / 256, 4, C.G, vcu}; \
                EpiCombine<li == 0> E{(const bf16*)(ws + AR_YBUF), (const float*)(ws + WS_TOPW), P.out, mod + (size_t)li * 8 * 6144 + 5120, hf, (bf16*)(ws + WS_H), (float*)(ws + WS_SSP), (LAS float*)(C.lds + RING_OFF + pg8::STAGE_BYTES)}; \
                pg8::gemm_phase(ring, 256, 512u, 512u, S, E); \
                } SEAM(pb + 3 + 2 * hf); } while (0)
    MOE_LAYER(0, 8);
    if (IN(15)) { SchedDense S{(const char*)(ws + WS_H), (const char*)(ws + WS_WHIN), 2048u, 2048u, T / 256, 12, C.G, vcu}; EpiHyIn E{(bf16*)(ws + AR_P), (const float*)(ws + WS_SSP), (const float*)(ws + WS_SHW)};
        DUP(15, pg8::gemm_phase(ring, 1024, 2048u, 2048u, S, E)); } SEAM(15);
    if (IN(16)) { DUP(16, ph_hy_prep(C, P)); } SEAM(16);
    if (IN(17)) { DUP(17, ph_hy_fft(C, P)); } SEAM(17);
    if (IN(18)) { DUP(18, ph_hy_gate(C, P)); } SEAM(18);
    if (IN(19)) { SchedDense S{(const char*)(ws + WS_H), (const char*)(ws + WS_WHOUT), 2048u, 2048u, T / 256, 4, C.G, vcu}; EpiResid E{P.out, P.out, mod + (size_t)8 * 6144 + 2048};
        pg8::gemm_phase(ring, 1024, 2048u, 2048u, S, E); } SEAM(19);
    MOE_LAYER(1, 20);
    if ((TS_FROM >= 0 || TS_ACC >= 0) && C.bid == 0 && C.tid == 0) { const unsigned long long t0 = wall_clock64(), need = (TS_ACC >= 0 ? C.tacc : (tsB - tsA)) * TS_AMP; while (wall_clock64() - t0 < need) __builtin_amdgcn_s_sleep(8); }
#undef IN
#undef SEAM
}

extern "C" void kernel_launch(void* const* d_in, const int* in_sizes, int n_in, void* d_out, int out_size, void* d_ws, size_t ws_size, hipStream_t stream) {
    static int grid = 0;
    if (grid == 0) {
        if (n_in != 43 || out_size != T * DM || ws_size < WS_END) { fprintf(stderr, "kernel_launch: unexpected shapes (n_in %d, out %d, ws %zu, need %zu)\n", n_in, out_size, ws_size, (size_t)WS_END); grid = -1; return; }
        int dev = 0, cus = 0, per_cu = 0;
        if (hipGetDevice(&dev) != hipSuccess || hipDeviceGetAttribute(&cus, hipDeviceAttributeMultiprocessorCount, dev) != hipSuccess) { grid = -1; return; }
        if (hipFuncSetAttribute((const void*)fwd_kernel, hipFuncAttributeMaxDynamicSharedMemorySize, LDS_BYTES) != hipSuccess) { fprintf(stderr, "kernel_launch: hipFuncSetAttribute failed\n"); grid = -1; return; }
        if (hipOccupancyMaxActiveBlocksPerMultiprocessor(&per_cu, (const void*)fwd_kernel, 512, LDS_BYTES) != hipSuccess || per_cu < 1) fprintf(stderr, "kernel_launch: occupancy query says %d\n", per_cu);
        (void)hipGetLastError();
        grid = cus;
    }
    if (grid < 0) return;
    (void)hipMemsetAsync((char*)d_ws + WS_CTL, 0, CTL_ZERO_BYTES, stream);
    Params p{};
    const float** pp = (const float**)&p;
    for (int i = 0; i < 43; ++i) pp[i] = (const float*)d_in[i];
    p.out = (float*)d_out; p.ws = (unsigned char*)d_ws;
#if N_LAUNCH_MODE == 1
    p.ph_lo = 0; p.ph_hi = NPHASE;
    hipLaunchKernelGGL(fwd_kernel, dim3(grid), dim3(512), LDS_BYTES, stream, p);
#else
    static const int order[NPHASE] = {0, 1, 2, 3, 4, 5, 6, 7, 8, 9, 10, 11, 12, 13, 14, 15, 16, 17, 18, 19, 20, 21, 22, 23, 24, 25};
    for (int k = 0; k < NPHASE; ++k) { p.ph_lo = order[k]; p.ph_hi = order[k] + 1; hipLaunchKernelGGL(fwd_kernel, dim3(grid), dim3(512), LDS_BYTES, stream, p); }
#endif
}
```

```cpp
#include <hip/hip_runtime.h>
#include <cstdio>
#include <cstdint>
#include <cmath>

#define TS_FROM -1
#define TS_TO -1
#ifndef N_LAUNCH_MODE
#define N_LAUNCH_MODE 1
#endif

#define GAS __attribute__((address_space(1)))
#define LAS __attribute__((address_space(3)))
typedef unsigned short bf16;
typedef short bf16x8 __attribute__((ext_vector_type(8)));
typedef short s16x4 __attribute__((ext_vector_type(4)));
typedef float f32x4 __attribute__((ext_vector_type(4)));
typedef float f32x2 __attribute__((ext_vector_type(2)));
typedef float f32x16 __attribute__((ext_vector_type(16)));
typedef unsigned u32x4 __attribute__((ext_vector_type(4)));
typedef unsigned u32x2 __attribute__((ext_vector_type(2)));
typedef GAS unsigned gu32;
#define RLX_AGENT __ATOMIC_RELAXED, __HIP_MEMORY_SCOPE_AGENT
#define LDS_WAIT() asm volatile("s_waitcnt lgkmcnt(0)" ::: "memory")
#define VM_WAIT() asm volatile("s_waitcnt vmcnt(0)" ::: "memory")
#define LBAR() do { asm volatile("s_waitcnt lgkmcnt(0)" ::: "memory"); __builtin_amdgcn_s_barrier(); asm volatile("" ::: "memory"); } while (0)

constexpr int DM = 1024, NB = 8, SEQ = 4096, CTXL = 256, T = NB * SEQ  , TC = NB * CTXL  , TA = T + TC  ;
constexpr int NHEAD = 8, QKH = 96, VH = 64, QLORA = 256, KVLORA = 128, QKROPE = 32, QKNOPE = 64;
constexpr int S5W = 512, S5G = 32, S5H = 16, S5P = 64, S5TC = 32  , S5NCH = SEQ / S5TC  , S5NCC = CTXL / S5TC  ;
constexpr int S5ROWS = 1280  , S5K = 768  ;
constexpr int EVEN_IN = 928, UOFF = 416;
constexpr int NEXP = 64, TOPK = 6, EFF = 256;
constexpr float EPS = 1e-6f;
constexpr int HALF_T = T / 2;
constexpr int MOE_CAP = HALF_T;
constexpr int MAXBLK = 2 * ((HALF_T * TOPK) / 256 + NEXP);

__device__ __forceinline__ unsigned f2bf(float f) { unsigned u = __builtin_bit_cast(unsigned, f); return (u + 0x7fffu + ((u >> 16) & 1u)) >> 16; }
__device__ __forceinline__ unsigned pk2(float lo, float hi) { return f2bf(lo) | (f2bf(hi) << 16); }
__device__ __forceinline__ float bf2f(unsigned short b) { return __builtin_bit_cast(float, ((unsigned)b) << 16); }
__device__ __forceinline__ float bflo(unsigned w) { return __builtin_bit_cast(float, w << 16); }
__device__ __forceinline__ float bfhi(unsigned w) { return __builtin_bit_cast(float, w & 0xffff0000u); }
__device__ __forceinline__ float wave_sum(float v) {
#pragma unroll
    for (int o = 1; o < 64; o <<= 1) v += __shfl_xor(v, o);
    return v;
}
__device__ __forceinline__ float siluf(float x) { return x / (1.0f + __expf(-x)); }
__device__ __forceinline__ float sigmf(float x) { return 1.0f / (1.0f + __expf(-x)); }
__device__ __forceinline__ float siluf_e(float x) { return x * __builtin_amdgcn_rcpf(1.0f + __expf(-x)); }
__device__ __forceinline__ float sigmf_e(float x) { return __builtin_amdgcn_rcpf(1.0f + __expf(-x)); }
__device__ __forceinline__ float gelu_tanh(float x) { const float u = 0.7978845608028654f * (x + 0.044715f * x * x * x); const float e = __expf(2.0f * u); return x * (1.0f - __builtin_amdgcn_rcpf(e + 1.0f)); }

namespace pg8 {
constexpr int BM = 256, BK = 64, HALF = 128, HTB = HALF * BK * 2  , STAGE_BYTES = 8 * HTB;
__host__ __device__ __forceinline__ int lds_byte(int r, int c) { const int st = (r >> 4) * 2 + (c >> 5), rr = r & 15, cc = c & 31, ob = rr * 64 + cc * 2; return st * 1024 + (ob ^ (((ob >> 9) & 1) << 5)); }
__host__ __device__ __forceinline__ void stage_rc(int b, int& R, int& C) { const int st = b / 1024, sb = b % 1024, swz = sb ^ (((sb >> 9) & 1) << 5); R = (st >> 1) * 16 + swz / 64; C = (st & 1) * 32 + (swz % 64) / 2; }
__host__ __device__ __forceinline__ int perm32(int rho) { const int n = rho >> 4, i = rho & 15; return 8 * (i >> 2) + 4 * n + (i & 3); }

struct Unit { const char* A; const char* B; const int* rows; int pm, pn, z; };

__device__ __forceinline__ unsigned cvt_pk_bf16(float lo, float hi) { unsigned r; asm volatile("v_cvt_pk_bf16_f32 %0, %1, %2" : "=v"(r) : "v"(lo), "v"(hi)); return r; }

template <bool ALIGN_EPI = true, class Epi, class Sched>
__device__ __forceinline__ void gemm_phase(LAS unsigned char* lds, const int K, const unsigned lda, const unsigned ldb, const Sched& S, const Epi& E) {
    const int tid = threadIdx.x, wid = __builtin_amdgcn_readfirstlane(tid >> 6), lane = tid & 63, wr = wid >> 2, wc = wid & 3, fr = lane & 15, fq = lane >> 4;
    const int nt = K / BK;
    int Ri[2], Ci[2]; unsigned voffB[2][2];
#pragma unroll
    for (int i = 0; i < 2; ++i) { int R, C; stage_rc(tid * 16 + i * 8192, R, C); Ri[i] = R; Ci[i] = C;
        const int Rb0 = Epi::PERM ? (64 * (R >> 5) + perm32(R & 31)) : R, Rb1 = Epi::PERM ? (Rb0 + 32) : (R + HALF);
        voffB[0][i] = (unsigned)Rb0 * ldb + (unsigned)C * 2u; voffB[1][i] = (unsigned)Rb1 * ldb + (unsigned)C * 2u; }
    const size_t kstep = (size_t)(BK * 2);
    const unsigned ldsw = (unsigned)wid * 1024u;
    const int aoff = lds_byte(wr * 64 + fr, fq * 8), boff = lds_byte(wc * 32 + fr, fq * 8);
#define PG8_SA(b, h) (((b) * 2 + (h)) * HTB)
#define PG8_SB(b, h) ((4 + (b) * 2 + (h)) * HTB)
#define PG8_STAGE(bufoff, gbase, voff) do { _Pragma("unroll") for (int _i = 0; _i < 2; ++_i) \
        __builtin_amdgcn_global_load_lds((const unsigned*)((const char*)(gbase) + (voff)[_i]), (LAS unsigned*)(lds + (bufoff) + ldsw + _i * 8192), 16, 0, 0); } while (0)
#define PG8_LDA(dst, b, h) do { _Pragma("unroll") for (int m = 0; m < 4; ++m) _Pragma("unroll") for (int k = 0; k < 2; ++k) dst[m][k] = *(const LAS bf16x8*)(lds + PG8_SA(b, h) + aoff + m * 2048 + k * 1024); } while (0)
#define PG8_LDB(dst, b, h) do { _Pragma("unroll") for (int n = 0; n < 2; ++n) _Pragma("unroll") for (int k = 0; k < 2; ++k) dst[n][k] = *(const LAS bf16x8*)(lds + PG8_SB(b, h) + boff + n * 2048 + k * 1024); } while (0)
#define PG8_MMA(ai, bj, At, Bt) do { __builtin_amdgcn_s_setprio(1); _Pragma("unroll") for (int m = 0; m < 4; ++m) _Pragma("unroll") for (int n = 0; n < 2; ++n) _Pragma("unroll") for (int k = 0; k < 2; ++k) \
        acc[ai][bj][m][n] = __builtin_amdgcn_mfma_f32_16x16x32_bf16(Bt[n][k], At[m][k], acc[ai][bj][m][n], 0, 0, 0); __builtin_amdgcn_s_setprio(0); } while (0)
#define PG8_WAIT_V(n) asm volatile("s_waitcnt vmcnt(" #n ")" ::: "memory")
#define PG8_WAIT_L(n) asm volatile("s_waitcnt lgkmcnt(" #n ")" ::: "memory")
#define PG8_BAR __builtin_amdgcn_s_barrier()
#define PG8_SCHED __builtin_amdgcn_sched_barrier(0)
#define PG8_AOFF(dst, u) do { if ((u).rows) { _Pragma("unroll") for (int _h = 0; _h < 2; ++_h) _Pragma("unroll") for (int _i = 0; _i < 2; ++_i) \
            { unsigned _t = (unsigned)(u).rows[_h * HALF + Ri[_i]] >> 3; _t = _t < (unsigned)(T - 1) ? _t : (unsigned)(T - 1); dst[_h][_i] = _t * lda + (unsigned)Ci[_i] * 2u; } } \
        else { _Pragma("unroll") for (int _h = 0; _h < 2; ++_h) _Pragma("unroll") for (int _i = 0; _i < 2; ++_i) dst[_h][_i] = (unsigned)(_h * HALF + Ri[_i]) * lda + (unsigned)Ci[_i] * 2u; } } while (0)
    Unit cur, nxt; int ui = 0;
    if (!S.next(0, cur)) return;
    f32x4 acc[2][2][4][2];
#pragma unroll
    for (int a = 0; a < 2; ++a)
#pragma unroll
        for (int b = 0; b < 2; ++b)
#pragma unroll
            for (int m = 0; m < 4; ++m)
#pragma unroll
                for (int n = 0; n < 2; ++n) acc[a][b][m][n] = (f32x4){0.f, 0.f, 0.f, 0.f};
    bf16x8 At[4][2], B0[2][2], B1[2][2];
    unsigned vA[2][2], vN[2][2];
    PG8_AOFF(vA, cur);
    const char* cA = cur.A; const char* cB = cur.B;
    PG8_STAGE(PG8_SB(0, 0), cB, voffB[0]); PG8_STAGE(PG8_SB(0, 1), cB, voffB[1]); PG8_STAGE(PG8_SA(0, 0), cA, vA[0]); PG8_STAGE(PG8_SA(0, 1), cA, vA[1]);
    if (wr == 1) PG8_BAR;
    PG8_WAIT_V(2); PG8_BAR;
    PG8_STAGE(PG8_SB(1, 0), cB + kstep, voffB[0]); PG8_STAGE(PG8_SA(1, 0), cA + kstep, vA[0]); PG8_STAGE(PG8_SB(1, 1), cB + kstep, voffB[1]);
    PG8_WAIT_V(6); PG8_BAR;
    for (;;) {
        const bool has_next = S.next(ui + 1, nxt);
        if (has_next) { PG8_AOFF(vN, nxt); } else {
#pragma unroll
            for (int _h = 0; _h < 2; ++_h)
#pragma unroll
                for (int _i = 0; _i < 2; ++_i) vN[_h][_i] = vA[_h][_i]; }
        const char* nA = has_next ? nxt.A : cA; const char* nB = has_next ? nxt.B : cB;
#pragma nounroll
        for (int t = 0; t < nt; t += 2) {
            const bool last = (t == nt - 2);
            const char* a1 = cA + (size_t)(t + 1) * kstep;
            const char* a2 = last ? nA : cA + (size_t)(t + 2) * kstep; const char* b2 = last ? nB : cB + (size_t)(t + 2) * kstep;
            const char* a3 = a2 + kstep; const char* b3 = b2 + kstep;
            unsigned v2[2][2];
#pragma unroll
            for (int _h = 0; _h < 2; ++_h)
#pragma unroll
                for (int _i = 0; _i < 2; ++_i) v2[_h][_i] = last ? vN[_h][_i] : vA[_h][_i];
            PG8_LDB(B0, 0, 0); PG8_LDB(B1, 0, 1); PG8_SCHED; PG8_LDA(At, 0, 0); PG8_STAGE(PG8_SA(1, 1), a1, vA[1]);
            PG8_WAIT_V(8); PG8_WAIT_L(0); PG8_BAR; PG8_MMA(0, 0, At, B0); PG8_MMA(0, 1, At, B1); PG8_BAR; PG8_SCHED;
            PG8_LDA(At, 0, 1); PG8_STAGE(PG8_SB(0, 0), b2, voffB[0]); PG8_STAGE(PG8_SB(0, 1), b2, voffB[1]); PG8_STAGE(PG8_SA(0, 0), a2, v2[0]);
            PG8_WAIT_V(8); PG8_WAIT_L(0); PG8_BAR; PG8_MMA(1, 0, At, B0); PG8_MMA(1, 1, At, B1); PG8_BAR; PG8_SCHED;
            PG8_LDB(B0, 1, 0); PG8_LDB(B1, 1, 1); PG8_SCHED; PG8_LDA(At, 1, 0); PG8_STAGE(PG8_SA(0, 1), a2, v2[1]);
            PG8_WAIT_V(8); PG8_WAIT_L(0); PG8_BAR; PG8_MMA(0, 0, At, B0); PG8_MMA(0, 1, At, B1); PG8_BAR; PG8_SCHED;
            PG8_LDA(At, 1, 1); PG8_STAGE(PG8_SB(1, 0), b3, voffB[0]); PG8_STAGE(PG8_SB(1, 1), b3, voffB[1]); PG8_STAGE(PG8_SA(1, 0), a3, v2[0]);
            PG8_WAIT_V(8); PG8_WAIT_L(0); PG8_BAR; PG8_MMA(1, 0, At, B0); PG8_MMA(1, 1, At, B1); PG8_BAR; PG8_SCHED;
        }
        if constexpr (ALIGN_EPI) { if (wr == 0) PG8_BAR; }
        E(acc, cur, wr, wc, fr, fq);
        if (!has_next) break;
#pragma unroll
        for (int a = 0; a < 2; ++a)
#pragma unroll
            for (int b = 0; b < 2; ++b)
#pragma unroll
                for (int m = 0; m < 4; ++m)
#pragma unroll
                    for (int n = 0; n < 2; ++n) acc[a][b][m][n] = (f32x4){0.f, 0.f, 0.f, 0.f};
        cur = nxt; cA = nA; cB = nB; ++ui;
#pragma unroll
        for (int _h = 0; _h < 2; ++_h)
#pragma unroll
            for (int _i = 0; _i < 2; ++_i) vA[_h][_i] = vN[_h][_i];
        if constexpr (ALIGN_EPI) { if (wr == 1) PG8_BAR; }
    }
    PG8_WAIT_V(0);
    if constexpr (!ALIGN_EPI) { if (wr == 0) PG8_BAR; }
    PG8_BAR;
#undef PG8_SA
#undef PG8_SB
#undef PG8_STAGE
#undef PG8_LDA
#undef PG8_LDB
#undef PG8_MMA
#undef PG8_WAIT_V
#undef PG8_WAIT_L
#undef PG8_BAR
#undef PG8_SCHED
#undef PG8_AOFF
}
}

constexpr size_t MiB = 1u << 20;
constexpr size_t WS_CTL = 0, CTL_ZERO_BYTES = 1 * MiB;
constexpr size_t WS_MOD = 1 * MiB;
constexpr size_t WS_MODCTX = WS_MOD + 512 * 1024;
constexpr size_t WS_TOPW = 2 * MiB;
constexpr size_t WS_LAMT = 3 * MiB;
constexpr size_t WS_SSP = 12 * MiB;
constexpr size_t WS_SHW = 3 * MiB + 256 * 1024;
constexpr size_t WS_TOK = 4 * MiB;
constexpr size_t WS_H = 16 * MiB;
constexpr size_t WS_WS = 84 * MiB;
constexpr size_t WS_AR = 128 * MiB;
constexpr size_t WS_WIN = WS_WS, WS_WUQ = WS_WS + 2 * MiB, WS_WUKV = WS_WS + 2 * MiB + 512 * 1024, WS_WGLU = WS_WS + 3 * MiB, WS_WOUT = WS_WS + 4 * MiB;
constexpr size_t WS_SOUT = WS_WS + 6 * MiB;
constexpr size_t WS_WG = WS_WS + 14 * MiB;
constexpr size_t WS_WHIN = WS_WS, WS_WHOUT = WS_WS + 6 * MiB, WS_HFT = WS_WS + 8 * MiB;
constexpr size_t AR_PROJ = WS_AR, AR_U = WS_AR + 34 * MiB, AR_QN = WS_AR + 94 * MiB, AR_CKV = WS_AR + 110 * MiB, AR_QRAW = WS_AR + 127 * MiB,
                 AR_KVRAW = WS_AR + 175 * MiB, AR_KF = WS_AR + 243 * MiB, AR_SRAW = WS_AR + 294 * MiB, AR_Z = WS_AR + 334 * MiB, AR_CAT = WS_AR;
constexpr size_t AR_W1 = WS_AR, AR_W2 = WS_AR + 65 * MiB, AR_HID = WS_AR + 98 * MiB, AR_HIDS = WS_AR + 210 * MiB, AR_YBUF = WS_AR + 226 * MiB;
constexpr size_t AR_P = WS_AR, AR_X0 = WS_AR + 192 * MiB, AR_ZT = WS_AR + 256 * MiB, AR_YT = WS_AR + 320 * MiB;
constexpr size_t AR_HSP = WS_AR + 384 * MiB;
constexpr size_t WS_XB = WS_AR + 408 * MiB;
constexpr size_t WS_END = WS_AR + 472 * MiB;
static_assert(AR_U + (size_t)S5G * S5ROWS * S5K * 2 <= AR_QN && AR_QRAW + (size_t)T * 768 * 2 <= AR_KVRAW && AR_KVRAW + (size_t)TA * 1024 * 2 <= AR_KF && AR_KF + (size_t)TA * 768 * 2 <= AR_SRAW &&
              AR_SRAW + (size_t)S5G * S5ROWS * 256 * 4 <= AR_Z && AR_CAT + (size_t)T * 1024 * 2 <= WS_END && AR_CKV + (size_t)TA * 256 * 2 <= AR_QRAW && AR_PROJ + (size_t)TA * 512 * 2 <= AR_U, "arena L0");
static_assert(AR_W2 + (size_t)65 * 1024 * 256 * 2 <= AR_HID && AR_HID + (size_t)MAXBLK * 256 * 256 * 2 <= AR_HIDS && AR_HIDS + (size_t)T * 256 * 2 <= AR_YBUF && AR_YBUF + (size_t)(HALF_T * 6 + 256) * 1024 <= WS_END, "arena MoE");
static_assert(WS_END <= 600 * MiB && AR_HSP + (size_t)16 * MiB <= WS_XB && AR_YBUF + (size_t)(HALF_T * 6 + 256) * 1024 <= WS_XB && WS_XB + (size_t)T * 1024 * 2 <= WS_END && AR_Z + (size_t)T * 512 * 2 <= WS_XB, "workspace budget");
constexpr int CW_TMO = 0, CW_CODE = 1;
constexpr int CW_BAR = 4096;
constexpr int CW_CNT = 32768;
constexpr int LDS_CTL_BYTES = 4096, RING_OFF = LDS_CTL_BYTES, LDS_BYTES = 160 * 1024;
constexpr int NPHASE = 26;

struct Params {
    const float *x, *c, *ctx, *c_ctx, *ada_w, *ada_b, *ev_w_in, *q_norm, *w_uq, *kv_norm, *w_ukv, *q_qk, *k_qk,
        *lam_re, *lam_im, *log_step, *b_re, *b_im, *c_re, *c_im, *s5_d, *glu_w, *glu_b, *ev_w_out,
        *hy_w_in, *hy_conv_w, *hy_conv_b, *f_w1, *f_b1, *f_w2, *f_b2, *f_w3, *f_freq, *hy_bias, *hy_w_out,
        *router_w, *router_b, *w_gate, *w_up, *w_down, *sh_gate, *sh_up, *sh_down;
    float* out; unsigned char* ws; int ph_lo, ph_hi;
};

#define XB_TMO      128
#define XB_XCNT(j)  (256  + 64 * (j))
#define XB_XSUB(j)  (1280 + 64 * (j))
#define XB_XGEN(j)  (2304 + 64 * (j))
#define XB_TOP      3328
#define XB_TOPGEN   3392
#define XCD_BAR_WORDS 3456
#define XB_SPIN_CAP (1u << 18)

__device__ __forceinline__ unsigned xb_ld(unsigned* p)              { return __hip_atomic_load(p, __ATOMIC_RELAXED, __HIP_MEMORY_SCOPE_AGENT); }
__device__ __forceinline__ unsigned xb_add(unsigned* p, unsigned v) { return __hip_atomic_fetch_add(p, v, __ATOMIC_RELAXED, __HIP_MEMORY_SCOPE_AGENT); }
__device__ __forceinline__ unsigned xb_xcc_id() { return (unsigned)__builtin_amdgcn_s_getreg((3 << 11) | 20) & 0xFu; }
#define XB_SPIN(cond, bar) do { unsigned _sp = 0; while (cond) { __builtin_amdgcn_s_sleep(1); \
    if ((++_sp & 255u) == 0u) { if (xb_ld(&(bar)[XB_TMO])) break; if (_sp > XB_SPIN_CAP) { atomicAdd(&(bar)[XB_TMO], 1u); break; } } } } while (0)

struct XcdBarrier {
    unsigned* bar; unsigned x;
    volatile LAS unsigned* st;
};

__device__ __forceinline__ XcdBarrier xcd_barrier_post(unsigned* bar, volatile LAS unsigned* st) {
    XcdBarrier b; b.bar = bar; b.x = xb_xcc_id(); b.st = st;
    if (threadIdx.x == 0) (void)xb_add(&bar[XB_XCNT(b.x)], 1u);
    return b;
}
__device__ __forceinline__ void xcd_barrier_complete(unsigned* bar, unsigned x, unsigned& nloc, unsigned& nx) {
    const unsigned G = gridDim.x * gridDim.y * gridDim.z;
    unsigned sum, cnt, mine, sp = 0u;
    for (;;) {
        sum = 0u; cnt = 0u; mine = 0u;
#pragma unroll
        for (unsigned j = 0; j < 16; ++j) { const unsigned c = xb_ld(&bar[XB_XCNT(j)]); sum += c; cnt += (c > 0u) ? 1u : 0u; mine = (j == x) ? c : mine; }
        if (sum == G) break;
        __builtin_amdgcn_s_sleep(1);
        if ((++sp & 255u) == 0u) { if (xb_ld(&bar[XB_TMO])) break; if (sp > XB_SPIN_CAP) { atomicAdd(&bar[XB_TMO], 1u); break; } }
    }
    nloc = mine > 0u ? mine : 1u; nx = cnt > 0u ? cnt : 1u;
}

__device__ __forceinline__ void xcd_barrier(const XcdBarrier& b) {
    asm volatile("s_waitcnt vmcnt(0)" ::: "memory");
    __syncthreads();
    if (threadIdx.x == 0) {
        unsigned* bar = b.bar;
        __builtin_amdgcn_s_waitcnt(0);
        unsigned nloc = b.st[0], nx = b.st[1];
        if (nloc == 0u) { xcd_barrier_complete(bar, b.x, nloc, nx); b.st[0] = nloc; b.st[1] = nx; }
        const unsigned old = xb_add(&bar[XB_XSUB(b.x)], 1u);
        const unsigned gen = old / nloc;
        if (old + 1u == (gen + 1u) * nloc) {
            __builtin_amdgcn_fence(__ATOMIC_RELEASE, "agent");
            asm volatile("s_waitcnt vmcnt(0)" ::: "memory");
            const unsigned og = xb_add(&bar[XB_TOP], 1u);
            const unsigned tg = og / nx;
            if (og + 1u == (tg + 1u) * nx) xb_add(&bar[XB_TOPGEN], 1u);
            else XB_SPIN(xb_ld(&bar[XB_TOPGEN]) == tg, bar);
            __builtin_amdgcn_fence(__ATOMIC_ACQUIRE, "agent");
            xb_add(&bar[XB_XGEN(b.x)], 1u);
            asm volatile("s_waitcnt vmcnt(0)" ::: "memory");
        } else {
            XB_SPIN(xb_ld(&bar[XB_XGEN(b.x)]) == gen, bar);
            __builtin_amdgcn_fence(__ATOMIC_ACQUIRE, "agent");
            asm volatile("s_waitcnt vmcnt(0)" ::: "memory");
        }
    }
    __syncthreads();
}

struct Ctx { LAS unsigned char* lds; int tid, lane, wave, G, bid; mutable unsigned long long tacc, tbeg; };
#define TS_ACC -1
#define TACC_B(C, id) do { if (TS_ACC == (id)) (C).tbeg = wall_clock64(); } while (0)
#define TACC_E(C, id) do { if (TS_ACC == (id)) (C).tacc += wall_clock64() - (C).tbeg; } while (0)

__device__ __forceinline__ void ph_mod(const Ctx& C, const Params& P) {
    if (C.bid >= 192) return;
    LAS float* sc = (LAS float*)(C.lds + RING_OFF);
    LAS float* red = sc + 9 * 1024;
    float* mod = (float*)(P.ws + WS_MOD); float* modctx = (float*)(P.ws + WS_MODCTX);
    { float cv[18];
#pragma unroll
      for (int j = 0; j < 18; ++j) { const int i = C.tid + 512 * j; cv[j] = j < 16 ? P.c[i] : P.c_ctx[i - 8192]; }
      asm volatile("" ::: "memory");
#pragma unroll
      for (int j = 0; j < 18; ++j) sc[C.tid + 512 * j] = siluf(cv[j]); }
    __syncthreads();
    for (int item = C.bid; item < 192; item += C.G) {
        const int li = item / 96, j0 = (item % 96) * 64, c4 = C.tid & 15, kp = C.tid >> 4;
        f32x4 a[9];
#pragma unroll
        for (int r = 0; r < 9; ++r) a[r] = (f32x4){0.f, 0.f, 0.f, 0.f};
        const float* w = P.ada_w + (size_t)li * 1024 * 6144 + j0 + 4 * c4;
        { f32x4 wv[32];
#pragma unroll
          for (int kk = 0; kk < 32; ++kk) wv[kk] = __builtin_nontemporal_load((const f32x4*)(w + (size_t)(kp * 32 + kk) * 6144));
          asm volatile("" ::: "memory");
#pragma unroll
          for (int kk = 0; kk < 32; ++kk) {
#pragma unroll
              for (int r = 0; r < 9; ++r) a[r] += wv[kk] * sc[r * 1024 + kp * 32 + kk]; } }
#pragma unroll
        for (int r = 0; r < 9; ++r) *(LAS f32x4*)(red + (kp * 9 + r) * 64 + 4 * c4) = a[r];
        __syncthreads();
        for (int o = C.tid; o < 9 * 64; o += 512) { const int r = o >> 6, cc = o & 63; float s = P.ada_b[li * 6144 + j0 + cc];
#pragma unroll 8
            for (int q = 0; q < 32; ++q) s += red[(q * 9 + r) * 64 + cc];
            if (r < 8) mod[(size_t)(li * 8 + r) * 6144 + j0 + cc] = s; else if (li == 0 && j0 + cc < 2048) modctx[j0 + cc] = s; }
        __syncthreads();
    }
}

__device__ __forceinline__ void tr_item(const float* W, int ldw, bf16* WT, int ldt, int k0, int n0, int drow0, const float* gk, LAS float* scr, int lane) {
    f32x4 v[8]; const int c4 = (lane & 7) * 4;
#pragma unroll
    for (int j = 0; j < 8; ++j) v[j] = __builtin_nontemporal_load((const f32x4*)(W + (size_t)(k0 + 8 * j + (lane >> 3)) * ldw + n0 + c4));
#pragma unroll
    for (int j = 0; j < 8; ++j) { const int kk = 8 * j + (lane >> 3); const float g = gk ? gk[k0 + kk] : 1.0f; LAS float* d = scr + kk * 33 + c4; d[0] = v[j].x * g; d[1] = v[j].y * g; d[2] = v[j].z * g; d[3] = v[j].w * g; }
    LDS_WAIT(); asm volatile("" ::: "memory");
    const int c = lane & 7;
#pragma unroll
    for (int j = 0; j < 4; ++j) { const int n = (lane >> 3) + 8 * j; const LAS float* s = scr + (8 * c) * 33 + n;
        u32x4 o; o.x = pk2(s[0 * 33], s[1 * 33]); o.y = pk2(s[2 * 33], s[3 * 33]); o.z = pk2(s[4 * 33], s[5 * 33]); o.w = pk2(s[6 * 33], s[7 * 33]);
        *(u32x4*)(WT + (size_t)(drow0 + n) * ldt + k0 + 8 * c) = o; }
    LDS_WAIT(); asm volatile("" ::: "memory");
}
__device__ __forceinline__ void tr_matrix(const Ctx& C, const float* W, int K, int N, int ldw, bf16* WT, int ldt, int row_off, const float* gk, int gw, int NGW) {
    LAS float* scr = (LAS float*)(C.lds + RING_OFF + C.wave * 8448);
    const int nblk = N / 32, nit = (K / 64) * nblk;
    for (int it = gw; it < nit; it += NGW) { const int kb = it / nblk, nb = it % nblk; tr_item(W, ldw, WT, ldt, 64 * kb, 32 * nb, row_off + 32 * nb, gk, scr, C.lane); }
}
__device__ __forceinline__ void zero_bf16(bf16* p, size_t n, int gt, int NGT) { for (size_t i = (size_t)gt * 8; i < n; i += (size_t)NGT * 8) *(u32x4*)(p + i) = (u32x4){0u, 0u, 0u, 0u}; }

__device__ __forceinline__ void ph_conv_l0(const Ctx& C, const Params& P) {
    const int gw = C.bid * 8 + C.wave, NGW = C.G * 8, gt = C.bid * 512 + C.tid, NGT = C.G * 512;
    unsigned char* ws = P.ws;
    tr_matrix(C, P.ev_w_in, 1024, EVEN_IN, EVEN_IN, (bf16*)(ws + WS_WIN), 1024, 0, nullptr, gw, NGW);
    zero_bf16((bf16*)(ws + WS_WIN) + (size_t)EVEN_IN * 1024, (size_t)(1024 - EVEN_IN) * 1024, gt, NGT);
}
__device__ __forceinline__ void ph_conv_l0b(const Ctx& C, const Params& P, int gw, int NGW) {
    const int gt = gw * 64 + C.lane, NGT = NGW * 64; unsigned char* ws = P.ws;
    tr_matrix(C, P.w_uq, 256, 768, 768, (bf16*)(ws + WS_WUQ), 256, 0, P.q_norm, gw, NGW);
    tr_matrix(C, P.w_ukv, 128, 1024, 1024, (bf16*)(ws + WS_WUKV), 256, 0, P.kv_norm, gw, NGW);
    { bf16* w = (bf16*)(ws + WS_WUKV); for (int i = gt; i < 1024 * 16; i += NGT) { const int r = i >> 4, cq = i & 15; *(u32x4*)(w + (size_t)r * 256 + 128 + cq * 8) = (u32x4){0u, 0u, 0u, 0u}; } }
    tr_matrix(C, P.glu_w, 512, 512, 512, (bf16*)(ws + WS_WGLU), 512, 0, nullptr, gw, NGW);
    tr_matrix(C, P.ev_w_out, 1024, 1024, 1024, (bf16*)(ws + WS_WOUT), 1024, 0, nullptr, gw, NGW);
}
__device__ __forceinline__ void ph_conv_l1(const Ctx& C, const Params& P, int gw, int NGW) {
    tr_matrix(C, P.hy_w_in, 1024, 3072, 3072, (bf16*)(P.ws + WS_WHIN), 1024, 0, nullptr, gw, NGW);
    tr_matrix(C, P.hy_w_out, 1024, 1024, 1024, (bf16*)(P.ws + WS_WHOUT), 1024, 0, nullptr, gw, NGW);
}
__device__ __forceinline__ void ph_conv_moe(const Ctx& C, const Params& P, int li) {
    const int gw = C.bid * 8 + C.wave, NGW = C.G * 8;
    LAS float* scr = (LAS float*)(C.lds + RING_OFF + C.wave * 8448);
    bf16* W1 = (bf16*)(P.ws + AR_W1); bf16* W2 = (bf16*)(P.ws + AR_W2);
    for (int it = gw; it < 65 * 384; it += NGW) {
        const int e = it / 384, r = it % 384, kind = r >> 7, idx = r & 127;
        if (kind < 2) { const float* W = (e < 64) ? ((kind == 0 ? P.w_gate : P.w_up) + ((size_t)li * 64 + e) * 1024 * 256) : ((kind == 0 ? P.sh_gate : P.sh_up) + (size_t)li * 1024 * 256);
            const int kb = idx >> 3, nb = idx & 7, n0 = 32 * nb; const int drow0 = (n0 >> 7) * 256 + ((n0 >> 5) & 3) * 64 + kind * 32;
            tr_item(W, 256, W1 + (size_t)e * 512 * 1024, 1024, 64 * kb, n0, drow0, nullptr, scr, C.lane); }
        else { const float* W = (e < 64) ? (P.w_down + ((size_t)li * 64 + e) * 256 * 1024) : (P.sh_down + (size_t)li * 256 * 1024);
            const int kb = idx >> 5, nb = idx & 31;
            tr_item(W, 1024, W2 + (size_t)e * 1024 * 256, 256, 64 * kb, 32 * nb, 32 * nb, nullptr, scr, C.lane); }
    }
}

__device__ __forceinline__ void ph_s5_tables(const Ctx& C, const Params& P, int job0, int jstride) {
    LAS float* LST = (LAS float*)(C.lds + RING_OFF);
    LAS float* BB = LST + 256;
    LAS float* CC = BB + 4096;
    LAS float* LP = CC + 4096;
    LAS float* KT = LP + 8448;
    bf16* SOUT = (bf16*)(P.ws + WS_SOUT); bf16* WG = (bf16*)(P.ws + WS_WG); float* LAMT = (float*)(P.ws + WS_LAMT);
    for (int job = job0; job < S5G * 8; job += jstride) {
        const int g = job >> 3, part = job & 7;
        __syncthreads();
        if (C.tid < 128) { const int dir = C.tid >> 6, p = C.tid & 63, gi = dir * 32 + g;
            const float lr = fminf(P.lam_re[gi * 64 + p], -1e-4f), li = P.lam_im[gi * 64 + p], step = __expf(P.log_step[gi]);
            const float a = lr * step, b = li * step; LST[(dir * 64 + p) * 2] = a; LST[(dir * 64 + p) * 2 + 1] = b;
            const float ea = __expf(a), lbr = ea * __cosf(b), lbi = ea * __sinf(b);
            const float nr = lbr - 1.0f, ni = lbi, den = lr * lr + li * li;
            const float qr = (nr * lr + ni * li) / den, qi = (ni * lr - nr * li) / den;
#pragma unroll
            for (int h = 0; h < 16; ++h) { const float br = P.b_re[((size_t)gi * 64 + p) * 16 + h], bi = P.b_im[((size_t)gi * 64 + p) * 16 + h];
                BB[((dir * 64 + p) * 16 + h) * 2] = qr * br - qi * bi; BB[((dir * 64 + p) * 16 + h) * 2 + 1] = qr * bi + qi * br; } }
        for (int i = C.tid; i < 2048; i += 512) { const int dir = i >> 10, r = i & 1023; const size_t gi = (size_t)(dir * 32 + g) * 1024 + r; CC[i * 2] = P.c_re[gi]; CC[i * 2 + 1] = P.c_im[gi]; }
        __syncthreads();
        for (int i = C.tid; i < 2 * 33 * 64; i += 512) { const int dir = i / (33 * 64), r = i % (33 * 64), tau = r >> 6, p = r & 63;
            const float a = LST[(dir * 64 + p) * 2] * (float)tau, b = LST[(dir * 64 + p) * 2 + 1] * (float)tau; const float ea = __expf(a);
            LP[i * 2] = ea * __cosf(b); LP[i * 2 + 1] = ea * __sinf(b); }
        __syncthreads();
        for (int i2 = C.tid; i2 < 2 * 32 * 32; i2 += 512) { const int dir = i2 >> 10, tau = (i2 >> 5) & 31, hp = 2 * part + ((i2 >> 4) & 1), h = i2 & 15; const int i = ((dir * 32 + tau) * 16 + hp) * 16 + h;
            float s = 0.f;
#pragma unroll 8
            for (int p = 0; p < 64; ++p) { const f32x2 c2 = *(const LAS f32x2*)(CC + ((dir * 16 + hp) * 64 + p) * 2), l2 = *(const LAS f32x2*)(LP + ((dir * 33 + tau) * 64 + p) * 2), b2 = *(const LAS f32x2*)(BB + ((dir * 64 + p) * 16 + h) * 2);
                const float xr = c2.x * l2.x - c2.y * l2.y, xi = c2.x * l2.y + c2.y * l2.x;
                s += xr * b2.x - xi * b2.y; }
            KT[i] = s; }
        __syncthreads();
        const float sd0 = P.s5_d[g * 16 + 2 * part], sd1 = P.s5_d[g * 16 + 2 * part + 1];
        for (int i = C.tid; i < 64 * 64; i += 512) { const int nn = i >> 6, k0 = (i & 63) * 8, t = nn >> 1, hp = 2 * part + (nn & 1), n = t * 16 + hp, s = k0 >> 4, h0 = k0 & 15, d = t - s; const float sdd = (nn & 1) ? sd1 : sd0;
            const int dir = d < 0 ? 1 : 0, tau = d < 0 ? -d : d; const float zf = d == 0 ? 1.f : 0.f;
            const LAS float* kp = KT + ((dir * 32 + tau) * 16 + hp) * 16 + h0; const LAS float* k1 = KT + ((1 * 32) * 16 + hp) * 16 + h0;
            const f32x4 a0 = *(const LAS f32x4*)kp, a1 = *(const LAS f32x4*)(kp + 4), c0 = *(const LAS f32x4*)k1, c1 = *(const LAS f32x4*)(k1 + 4); float v[8];
#pragma unroll
            for (int j = 0; j < 8; ++j) { const float aa = j < 4 ? a0[j & 3] : a1[j & 3], cc = j < 4 ? c0[j & 3] : c1[j & 3]; v[j] = aa + zf * (cc + (hp == h0 + j ? sdd : 0.f)); }
            u32x4 o; o.x = pk2(v[0], v[1]); o.y = pk2(v[2], v[3]); o.z = pk2(v[4], v[5]); o.w = pk2(v[6], v[7]);
            *(u32x4*)(WG + ((size_t)g * 512 + n) * 768 + k0) = o; }
        for (int i = C.tid; i < 64 * 32; i += 512) { const int nn = i >> 5, q0 = (i & 31) * 8, t = nn >> 1, hp = 2 * part + (nn & 1), n = t * 16 + hp, dir = q0 >> 7, ri = (q0 >> 6) & 1, p0 = q0 & 63, tau = dir == 0 ? t + 1 : 32 - t;
            const LAS float* cp = CC + ((dir * 16 + hp) * 64 + p0) * 2; const LAS float* lp = LP + ((dir * 33 + tau) * 64 + p0) * 2; float v[8];
#pragma unroll
            for (int j2 = 0; j2 < 4; ++j2) { const f32x4 c4 = *(const LAS f32x4*)(cp + 4 * j2), l4 = *(const LAS f32x4*)(lp + 4 * j2);
                const float re0 = c4[0] * l4[0] - c4[1] * l4[1], im0 = c4[0] * l4[1] + c4[1] * l4[0], re1 = c4[2] * l4[2] - c4[3] * l4[3], im1 = c4[2] * l4[3] + c4[3] * l4[2];
                v[2 * j2] = ri == 0 ? re0 : -im0; v[2 * j2 + 1] = ri == 0 ? re1 : -im1; }
            u32x4 o; o.x = pk2(v[0], v[1]); o.y = pk2(v[2], v[3]); o.z = pk2(v[4], v[5]); o.w = pk2(v[6], v[7]);
            *(u32x4*)(WG + ((size_t)g * 512 + n) * 768 + 512 + q0) = o; }
        for (int i = C.tid; i < 32 * 64; i += 512) { const int q = 32 * part + (i >> 6), k0 = (i & 63) * 8, dir = q >> 7, ri = (q >> 6) & 1, p = q & 63; float v[8];
#pragma unroll
            for (int j = 0; j < 8; ++j) { const int k = k0 + j, s = k >> 4, h = k & 15, e = dir == 0 ? 31 - s : s;
                const float lr = LP[((dir * 33 + e) * 64 + p) * 2], li = LP[((dir * 33 + e) * 64 + p) * 2 + 1];
                const float br = BB[((dir * 64 + p) * 16 + h) * 2], bi = BB[((dir * 64 + p) * 16 + h) * 2 + 1];
                v[j] = ri == 0 ? (lr * br - li * bi) : (lr * bi + li * br); }
            u32x4 o; o.x = pk2(v[0], v[1]); o.y = pk2(v[2], v[3]); o.z = pk2(v[4], v[5]); o.w = pk2(v[6], v[7]);
            *(u32x4*)(SOUT + ((size_t)g * 256 + q) * 512 + k0) = o; }
        if (part == 0 && C.tid < 128) { const int dir = C.tid >> 6, p = C.tid & 63; LAMT[((g * 2 + dir) * 64 + p) * 2] = LP[((dir * 33 + 32) * 64 + p) * 2]; LAMT[((g * 2 + dir) * 64 + p) * 2 + 1] = LP[((dir * 33 + 32) * 64 + p) * 2 + 1]; }
    }
    __syncthreads();
}

__device__ __forceinline__ void ph_hy_filter(const Ctx& C, const Params& P, int item0, int istride) {
    LAS float* Z = (LAS float*)(C.lds + RING_OFF);
    LAS float* H1 = Z + 32 * 33 + 32;
    LAS float* H2 = H1 + 2048;
    float* HFT = (float*)(P.ws + WS_HFT);
    constexpr float PI2 = 6.283185307179586f;
    for (int item = item0; item < SEQ / 32; item += istride) {
        const int n0 = item * 32;
        __syncthreads();
        for (int i = C.tid; i < 32 * 33; i += 512) { const int p = i / 33, j = i % 33, n = n0 + p; const float tn = (float)n * (1.0f / 4095.0f), ang = PI2 * (float)n * (1.0f / 4096.0f); float v;
            if (j == 0) v = tn; else { const int bi = (j - 1) & 15; const float band = 1e-4f + (float)bi * ((15.0f - 1e-4f) / 15.0f); v = (j <= 16) ? __cosf(band * ang) : -__sinf(band * ang); }
            Z[p * 33 + j] = v; }
        __syncthreads();
        for (int i = C.tid; i < 2048; i += 512) { const int p = i >> 6, u = i & 63; float s = P.f_b1[u];
#pragma unroll
            for (int j = 0; j < 33; ++j) s += Z[p * 33 + j] * P.f_w1[j * 64 + u];
            H1[p * 64 + u] = __sinf(P.f_freq[u] * s); }
        __syncthreads();
        for (int i = C.tid; i < 2048; i += 512) { const int p = i >> 6, u = i & 63; float s = P.f_b2[u];
#pragma unroll 16
            for (int k = 0; k < 64; ++k) s += H1[p * 64 + k] * P.f_w2[k * 64 + u];
            H2[p * 65 + u] = __sinf(P.f_freq[u] * s); }
        __syncthreads();
        for (int ct = C.wave; ct < 64; ct += 8) { const int col = ct * 32 + (C.lane & 31), dir = col >> 10, d = col & 1023, kh = C.lane >> 5;
            f32x16 acc = {};
#pragma unroll 8
            for (int sk = 0; sk < 32; ++sk) { const float a = H2[(C.lane & 31) * 65 + 2 * sk + kh], b = P.f_w3[(size_t)(2 * sk + kh) * 2048 + col]; acc = __builtin_amdgcn_mfma_f32_32x32x2f32(a, b, acc, 0, 0, 0); }
            const float delta = 3.0701134573253945f + (float)d * ((15.350567286626972f - 3.0701134573253945f) / 1023.0f);
            float* o = HFT + ((size_t)d * 2 + dir) * 4096 + n0;
#pragma unroll
            for (int r4 = 0; r4 < 4; ++r4) { const int p0 = 8 * r4 + 4 * kh; f32x4 v;
                v.x = acc[4 * r4] * __expf(-((float)(n0 + p0) * (1.0f / 4095.0f)) * delta); v.y = acc[4 * r4 + 1] * __expf(-((float)(n0 + p0 + 1) * (1.0f / 4095.0f)) * delta);
                v.z = acc[4 * r4 + 2] * __expf(-((float)(n0 + p0 + 2) * (1.0f / 4095.0f)) * delta); v.w = acc[4 * r4 + 3] * __expf(-((float)(n0 + p0 + 3) * (1.0f / 4095.0f)) * delta);
                *(f32x4*)(o + p0) = v; } }
    }
    __syncthreads();
}

__device__ __forceinline__ void ph_norm(const Ctx& C, const Params& P, const float* xin, int li, int sh_idx, bool with_ctx) {
    const int gw = C.bid * 8 + C.wave, NGW = C.G * 8; bf16* H = (bf16*)(P.ws + WS_H);
    const float* mod = (const float*)(P.ws + WS_MOD); const float* modctx = (const float*)(P.ws + WS_MODCTX);
    const int ngrp = (with_ctx ? TA : T) >> 2;
    for (int g = gw; g < ngrp; g += NGW) { const int r0 = g * 4;
        f32x4 v[4][4], a[4], b[4]; const float* xr; const float* shp; const float* scp;
        if (r0 < T) { xr = xin + (size_t)r0 * 1024; const float* m = mod + (size_t)(li * 8 + (r0 >> 12)) * 6144; shp = m + sh_idx * 1024; scp = m + (sh_idx + 1) * 1024; }
        else { xr = P.ctx + (size_t)(r0 - T) * 1024; shp = modctx; scp = modctx + 1024; }
#pragma unroll
        for (int q = 0; q < 4; ++q)
#pragma unroll
            for (int j = 0; j < 4; ++j) v[q][j] = __builtin_nontemporal_load((const f32x4*)(xr + q * 1024 + 256 * j + 4 * C.lane));
#pragma unroll
        for (int j = 0; j < 4; ++j) { a[j] = *(const f32x4*)(scp + 256 * j + 4 * C.lane) + 1.0f; b[j] = *(const f32x4*)(shp + 256 * j + 4 * C.lane); }
#pragma unroll
        for (int q = 0; q < 4; ++q) { float s = 0.f;
#pragma unroll
            for (int j = 0; j < 4; ++j) s += (v[q][j].x * v[q][j].x + v[q][j].y * v[q][j].y) + (v[q][j].z * v[q][j].z + v[q][j].w * v[q][j].w);
            const float rstd = __builtin_amdgcn_rsqf(wave_sum(s) * (1.0f / 1024.0f) + EPS);
#pragma unroll
            for (int j = 0; j < 4; ++j) { const f32x4 y = v[q][j] * rstd * a[j] + b[j]; u32x2 o; o.x = pk2(y.x, y.y); o.y = pk2(y.z, y.w);
                *(u32x2*)(H + (size_t)(r0 + q) * 1024 + 256 * j + 4 * C.lane) = o; } }
    }
}

__device__ __forceinline__ void ph_rownorm1(const Ctx& C, const Params& P, int gw, int NGW) {
    const bf16* PROJ = (const bf16*)(P.ws + AR_PROJ); bf16* QN = (bf16*)(P.ws + AR_QN); bf16* CKV = (bf16*)(P.ws + AR_CKV);
    for (int row0 = gw; row0 < TA; row0 += 4 * NGW) {
        u32x2 q[4]; unsigned kv[4];
#pragma unroll
        for (int r = 0; r < 4; ++r) { const int row = (row0 + r * NGW < TA) ? row0 + r * NGW : row0; q[r] = *(const u32x2*)(PROJ + (size_t)row * 512 + 4 * C.lane); kv[r] = *(const unsigned*)(PROJ + (size_t)row * 512 + 256 + 2 * C.lane); }
        float sq[4], sk[4];
#pragma unroll
        for (int r = 0; r < 4; ++r) { const float q0 = bflo(q[r].x), q1 = bfhi(q[r].x), q2 = bflo(q[r].y), q3 = bfhi(q[r].y), k0 = bflo(kv[r]), k1 = bfhi(kv[r]); sq[r] = (q0 * q0 + q1 * q1) + (q2 * q2 + q3 * q3); sk[r] = k0 * k0 + k1 * k1; }
#pragma unroll
        for (int o = 1; o < 64; o <<= 1) {
#pragma unroll
            for (int r = 0; r < 4; ++r) { sq[r] += __shfl_xor(sq[r], o); sk[r] += __shfl_xor(sk[r], o); } }
#pragma unroll
        for (int r = 0; r < 4; ++r) { const int row = row0 + r * NGW; if (row < TA) {
            const float q0 = bflo(q[r].x), q1 = bfhi(q[r].x), q2 = bflo(q[r].y), q3 = bfhi(q[r].y), k0 = bflo(kv[r]), k1 = bfhi(kv[r]);
            const float rq = __builtin_amdgcn_rsqf(sq[r] * (1.0f / 256.0f) + EPS), rk = __builtin_amdgcn_rsqf(sk[r] * (1.0f / 128.0f) + EPS);
            if (row < T) { u32x2 o; o.x = pk2(q0 * rq, q1 * rq); o.y = pk2(q2 * rq, q3 * rq); *(u32x2*)(QN + (size_t)row * 256 + 4 * C.lane) = o; }
            *(unsigned*)(CKV + (size_t)row * 256 + 2 * C.lane) = pk2(k0 * rk, k1 * rk);
            *(unsigned*)(CKV + (size_t)row * 256 + 128 + 2 * C.lane) = 0u; } }
    }
}

__device__ __forceinline__ void ph_qkfinal(const Ctx& C, const Params& P) {
    const int gw = C.bid * 8 + C.wave, NGW = C.G * 8;
    const bf16* PROJ = (const bf16*)(P.ws + AR_PROJ); const bf16* KVRAW = (const bf16*)(P.ws + AR_KVRAW); bf16* KF = (bf16*)(P.ws + AR_KF); bf16* Q = (bf16*)(P.ws + AR_QRAW);
    const int hd = C.lane >> 3, sub = C.lane & 7, j0 = 12 * sub;
    constexpr float QSCALE = 0.10206207261596577f * 1.4426950408889634f;
    float gq[12], gk[12];
#pragma unroll
    for (int i = 0; i < 12; ++i) { gq[i] = P.q_qk[j0 + i]; gk[i] = P.k_qk[j0 + i]; }
    for (int row0 = gw; row0 < TA; row0 += 2 * NGW) {
        u32x2 kw[2][3];
#pragma unroll
        for (int rr = 0; rr < 2; ++rr) { const int row = (row0 + rr * NGW < TA) ? row0 + rr * NGW : row0;
#pragma unroll
            for (int i = 0; i < 3; ++i) { const int j = j0 + 4 * i; const bf16* src = (j < 64) ? (KVRAW + (size_t)row * 1024 + hd * 128 + j) : (PROJ + (size_t)row * 512 + 384 + (j - 64));
                kw[rr][i] = *(const u32x2*)src; } }
#pragma unroll
        for (int rr = 0; rr < 2; ++rr) { const int row = row0 + rr * NGW; if (row >= TA) continue;
        const bool lat = row < T; const int pos = row & 4095;
        float cs[6], sn[6];
#pragma unroll
        for (int i = 0; i < 6; ++i) { const int j = j0 + 2 * i; cs[i] = 1.f; sn[i] = 0.f;
            if (j >= 64 && lat) { const int pi = (j - 64) >> 1; const float inv = __builtin_amdgcn_exp2f(-(float)(pi & 7) * (13.287712379549449f / 8.0f)); const float ang = (float)(pi < 8 ? (pos >> 6) : (pos & 63)) * inv; cs[i] = __cosf(ang); sn[i] = __sinf(ang); } }
        { float x[12];
#pragma unroll
          for (int i = 0; i < 3; ++i) { const u32x2 w = kw[rr][i]; x[4 * i] = bflo(w.x); x[4 * i + 1] = bfhi(w.x); x[4 * i + 2] = bflo(w.y); x[4 * i + 3] = bfhi(w.y); }
          float s = 0.f;
#pragma unroll
          for (int i = 0; i < 12; ++i) s += x[i] * x[i];
          s += __shfl_xor(s, 1); s += __shfl_xor(s, 2); s += __shfl_xor(s, 4);
          const float r = __builtin_amdgcn_rsqf(s * (1.0f / 96.0f) + EPS);
#pragma unroll
          for (int i = 0; i < 12; ++i) x[i] = x[i] * r * gk[i];
#pragma unroll
          for (int i = 0; i < 6; ++i) { const float a = x[2 * i], b = x[2 * i + 1]; x[2 * i] = a * cs[i] - b * sn[i]; x[2 * i + 1] = a * sn[i] + b * cs[i]; }
#pragma unroll
          for (int i = 0; i < 3; ++i) { u32x2 o; o.x = pk2(x[4 * i], x[4 * i + 1]); o.y = pk2(x[4 * i + 2], x[4 * i + 3]); *(u32x2*)(KF + (size_t)row * 768 + hd * 96 + j0 + 4 * i) = o; } }
        if (lat) { float x[12];
#pragma unroll
          for (int i = 0; i < 3; ++i) { const u32x2 w = *(const u32x2*)(Q + (size_t)row * 768 + hd * 96 + j0 + 4 * i); x[4 * i] = bflo(w.x); x[4 * i + 1] = bfhi(w.x); x[4 * i + 2] = bflo(w.y); x[4 * i + 3] = bfhi(w.y); }
          float s = 0.f;
#pragma unroll
          for (int i = 0; i < 12; ++i) s += x[i] * x[i];
          s += __shfl_xor(s, 1); s += __shfl_xor(s, 2); s += __shfl_xor(s, 4);
          const float r = __builtin_amdgcn_rsqf(s * (1.0f / 96.0f) + EPS);
#pragma unroll
          for (int i = 0; i < 12; ++i) x[i] = x[i] * r * gq[i];
#pragma unroll
          for (int i = 0; i < 6; ++i) { const float a = x[2 * i], b = x[2 * i + 1]; x[2 * i] = (a * cs[i] - b * sn[i]) * QSCALE; x[2 * i + 1] = (a * sn[i] + b * cs[i]) * QSCALE; }
#pragma unroll
          for (int i = 0; i < 3; ++i) { u32x2 o; o.x = pk2(x[4 * i], x[4 * i + 1]); o.y = pk2(x[4 * i + 2], x[4 * i + 3]); *(u32x2*)(Q + (size_t)row * 768 + hd * 96 + j0 + 4 * i) = o; } }
        }
    }
}

using pg8::Unit;
#define EPI_ARGS const f32x4 (&acc)[2][2][4][2], const Unit& u, int wr, int wc, int fr, int fq
__device__ __forceinline__ u32x4 pack8(const f32x4 a, const f32x4 b) { u32x4 w; w.x = pg8::cvt_pk_bf16(a[0], a[1]); w.y = pg8::cvt_pk_bf16(a[2], a[3]); w.z = pg8::cvt_pk_bf16(b[0], b[1]); w.w = pg8::cvt_pk_bf16(b[2], b[3]); return w; }

__device__ __forceinline__ void widen_pair(const u32x4 d0, const u32x4 d1, bool odd, u32x4& A, u32x4& B) {
    u32x4 send, recv;
#pragma unroll
    for (int q = 0; q < 4; ++q) { send[q] = odd ? d0[q] : d1[q]; recv[q] = (unsigned)__builtin_amdgcn_update_dpp(0, (int)send[q], 0xB1, 0xf, 0xf, false); }
#pragma unroll
    for (int q = 0; q < 4; ++q) { A[q] = odd ? recv[q] : d0[q]; B[q] = odd ? d1[q] : recv[q]; }
}
struct SchedDense {
    const char* A; const char* B; unsigned lda, ldb; int nM, nN, G, c;
    __device__ __forceinline__ bool next(int i, Unit& u) const { int L = i * G + c; const int tot = nM * nN;
        if (G == 256 && (i + 1) * G > tot) L = i * G + (c & 31) * 8 + (c >> 5);
        if (L >= tot) return false; const int pm = L / nN, pn = L % nN;
        u.A = A + (size_t)pm * 256 * lda; u.B = B + (size_t)pn * 256 * ldb; u.rows = nullptr; u.pm = pm; u.pn = pn; u.z = 0; return true; }
};
struct SchedBatched {
    const char* A; const char* B; unsigned lda, ldb; size_t sA, sB; int nZ, nM, nN, G, c;
    __device__ __forceinline__ bool next(int i, Unit& u) const { int L = i * G + c; if (G == 256 && (i + 1) * G > nZ * nM * nN) L = i * G + (c & 31) * 8 + (c >> 5);
        if (L >= nZ * nM * nN) return false; const int z = L / (nM * nN), r = L % (nM * nN), pm = r / nN, pn = r % nN;
        u.A = A + (size_t)z * sA + (size_t)pm * 256 * lda; u.B = B + (size_t)z * sB + (size_t)pn * 256 * ldb; u.rows = nullptr; u.pm = pm; u.pn = pn; u.z = z; return true; }
};
struct SchedUp {
    const char *QN, *WUQ, *CKV, *WUKV; int G, c;
    __device__ __forceinline__ bool next(int i, Unit& u) const { int L = i * G + c; u.rows = nullptr;
        if (G == 256 && i == 3) { const int x = c >> 5, sl = c & 31; if (sl >= 20) return false; L = 768 + x * 20 + sl; }
        if (L < 384) { u.pm = L / 3; u.pn = L % 3; u.z = 0; u.A = QN + (size_t)u.pm * 256 * 512; u.B = WUQ + (size_t)u.pn * 256 * 512; return true; }
        L -= 384; if (L >= 544) return false; u.pm = L >> 2; u.pn = L & 3; u.z = 1; u.A = CKV + (size_t)u.pm * 256 * 512; u.B = WUKV + (size_t)u.pn * 256 * 512; return true; }
};

struct EpiInProj {
    static constexpr bool PERM = true; bf16* PROJ; bf16* U;
    __device__ __forceinline__ void operator()(EPI_ARGS) const {
#pragma unroll
        for (int ai = 0; ai < 2; ++ai)
#pragma unroll
            for (int m = 0; m < 4; ++m) { const int row = u.pm * 256 + ai * 128 + wr * 64 + m * 16 + fr; int urow, s;
                if (row < T) { const int b = row >> 12, pos = row & 4095; urow = (pos >> 5) * 8 + b; s = pos & 31; } else { const int rr = row - T, b = rr >> 8, pos = rr & 255; urow = 1024 + (pos >> 5) * 8 + b; s = pos & 31; }
#pragma unroll
                for (int bj = 0; bj < 2; ++bj) { const int col0 = u.pn * 256 + wc * 64 + bj * 32 + 8 * fq; const u32x4 w = pack8(acc[ai][bj][m][0], acc[ai][bj][m][1]);
                    if (col0 < UOFF) *(u32x4*)(PROJ + (size_t)row * 512 + col0) = w;
                    else if (col0 < EVEN_IN) { const int gc = col0 - UOFF, g = gc >> 4, h0 = gc & 15; *(u32x4*)(U + ((size_t)(g * S5ROWS + urow) * S5K + s * 16 + h0)) = w; } } }
    }
};
struct EpiUp {
    static constexpr bool PERM = true; bf16* QRAW; bf16* KVRAW;
    __device__ __forceinline__ void operator()(EPI_ARGS) const { bf16* O = u.z ? KVRAW : QRAW; const int ldc = u.z ? 1024 : 768; const bool odd = fr & 1;
#pragma unroll
        for (int ai = 0; ai < 2; ++ai)
#pragma unroll
            for (int m = 0; m < 4; ++m) { const int rowE = u.pm * 256 + ai * 128 + wr * 64 + m * 16 + (fr & ~1); u32x4 A, B; widen_pair(pack8(acc[ai][0][m][0], acc[ai][0][m][1]), pack8(acc[ai][1][m][0], acc[ai][1][m][1]), odd, A, B);
                bf16* op = O + (size_t)rowE * ldc + u.pn * 256 + wc * 64 + (odd ? 32 : 0) + 8 * fq; *(u32x4*)op = A; *(u32x4*)(op + ldc) = B; }
    }
};
struct EpiF32Batched {
    static constexpr bool PERM = false; float* O; int rows_per_z, ldc;
    __device__ __forceinline__ void operator()(EPI_ARGS) const {
#pragma unroll
        for (int ai = 0; ai < 2; ++ai)
#pragma unroll
            for (int m = 0; m < 4; ++m) { const int row = u.pm * 256 + ai * 128 + wr * 64 + m * 16 + fr; float* rp = O + ((size_t)u.z * rows_per_z + row) * ldc + u.pn * 256 + wc * 32 + 4 * fq;
#pragma unroll
                for (int bj = 0; bj < 2; ++bj)
#pragma unroll
                    for (int n = 0; n < 2; ++n) *(f32x4*)(rp + bj * 128 + n * 16) = acc[ai][bj][m][n]; }
    }
};
struct EpiS5C {
    static constexpr bool PERM = true; bf16* Z;
    __device__ __forceinline__ void operator()(EPI_ARGS) const {
#pragma unroll
        for (int ai = 0; ai < 2; ++ai)
#pragma unroll
            for (int m = 0; m < 4; ++m) { const int rr = u.pm * 256 + ai * 128 + wr * 64 + m * 16 + fr, c = rr >> 3, b = rr & 7;
#pragma unroll
                for (int bj = 0; bj < 2; ++bj) { const int cc = u.pn * 256 + wc * 64 + bj * 32 + 8 * fq, t = cc >> 4, h0 = cc & 15; f32x4 v0 = acc[ai][bj][m][0], v1 = acc[ai][bj][m][1];
#pragma unroll
                    for (int j = 0; j < 4; ++j) { v0[j] = gelu_tanh(v0[j]); v1[j] = gelu_tanh(v1[j]); }
                    *(u32x4*)(Z + ((size_t)(b * 4096 + c * 32 + t) * 512 + u.z * 16 + h0)) = pack8(v0, v1); } }
    }
};
struct EpiGlu {
    static constexpr bool PERM = true; const bf16* Z; const float* gb; bf16* CAT;
    __device__ __forceinline__ void operator()(EPI_ARGS) const {
#pragma unroll
        for (int ai = 0; ai < 2; ++ai)
#pragma unroll
            for (int m = 0; m < 4; ++m) { const int row = u.pm * 256 + ai * 128 + wr * 64 + m * 16 + fr;
#pragma unroll
                for (int bj = 0; bj < 2; ++bj) { const int col0 = u.pn * 256 + wc * 64 + bj * 32 + 8 * fq; const u32x4 zw = *(const u32x4*)(Z + (size_t)row * 512 + col0);
                    const f32x4 b0 = *(const f32x4*)(gb + col0), b1 = *(const f32x4*)(gb + col0 + 4); f32x4 v0 = acc[ai][bj][m][0] + b0, v1 = acc[ai][bj][m][1] + b1;
                    v0[0] = bflo(zw.x) * sigmf_e(v0[0]); v0[1] = bfhi(zw.x) * sigmf_e(v0[1]); v0[2] = bflo(zw.y) * sigmf_e(v0[2]); v0[3] = bfhi(zw.y) * sigmf_e(v0[3]);
                    v1[0] = bflo(zw.z) * sigmf_e(v1[0]); v1[1] = bfhi(zw.z) * sigmf_e(v1[1]); v1[2] = bflo(zw.w) * sigmf_e(v1[2]); v1[3] = bfhi(zw.w) * sigmf_e(v1[3]);
                    *(u32x4*)(CAT + (size_t)row * 1024 + 512 + col0) = pack8(v0, v1); } }
    }
};
struct EpiResid {
    static constexpr bool PERM = false; const float* xin; float* xout; const float* gate;
    __device__ __forceinline__ void operator()(EPI_ARGS) const { const int col0 = u.pn * 256 + wc * 32 + 4 * fq;
        f32x4 gv[2][2];
        { const float* gp = gate + (size_t)((u.pm * 256) >> 12) * 6144 + col0;
#pragma unroll
          for (int bj = 0; bj < 2; ++bj)
#pragma unroll
              for (int n = 0; n < 2; ++n) gv[bj][n] = *(const f32x4*)(gp + bj * 128 + n * 16); }
#pragma unroll
        for (int ai = 0; ai < 2; ++ai)
#pragma unroll
            for (int mp = 0; mp < 2; ++mp) { f32x4 xv[2][2][2];
#pragma unroll
                for (int mq = 0; mq < 2; ++mq) { const int row = u.pm * 256 + ai * 128 + wr * 64 + (2 * mp + mq) * 16 + fr;
#pragma unroll
                    for (int bj = 0; bj < 2; ++bj)
#pragma unroll
                        for (int n = 0; n < 2; ++n) xv[mq][bj][n] = *(const f32x4*)(xin + (size_t)row * 1024 + col0 + bj * 128 + n * 16); }
#pragma unroll
                for (int mq = 0; mq < 2; ++mq) { const int m = 2 * mp + mq, row = u.pm * 256 + ai * 128 + wr * 64 + m * 16 + fr;
#pragma unroll
                    for (int bj = 0; bj < 2; ++bj)
#pragma unroll
                        for (int n = 0; n < 2; ++n) *(f32x4*)(xout + (size_t)row * 1024 + col0 + bj * 128 + n * 16) = xv[mq][bj][n] + gv[bj][n] * acc[ai][bj][m][n]; } }
    }
};

template <bool INF32> struct EpiResidB {
    static constexpr bool PERM = true; static constexpr int MB = INF32 ? 2 : 4;
    const void* xin; bf16* xout; const float* gate;
    __device__ __forceinline__ void operator()(EPI_ARGS) const { const bool odd = fr & 1;
        int lr0 = wr * 64 + fr, cw = wc * 64 + 8 * fq; asm volatile("" : "+v"(lr0), "+v"(cw));
        f32x4 gv[2][2];
        { const float* gp = gate + (size_t)((u.pm * 256) >> 12) * 6144 + u.pn * 256 + cw;
#pragma unroll
          for (int bj = 0; bj < 2; ++bj) { gv[bj][0] = *(const f32x4*)(gp + bj * 32); gv[bj][1] = *(const f32x4*)(gp + bj * 32 + 4); } }
        const unsigned eo0 = (unsigned)(u.pm * 256 + lr0) * 1024u + (unsigned)(u.pn * 256 + cw);
        const unsigned so0 = ((unsigned)(u.pm * 256 + (lr0 & ~1)) * 1024u + (unsigned)(u.pn * 256 + wc * 64 + (odd ? 32 : 0) + 8 * fq)) * 2u;
#pragma unroll
        for (int ai = 0; ai < 2; ++ai)
#pragma unroll
            for (int mp = 0; mp < 4 / MB; ++mp) { f32x4 xv[MB][2][2];
#pragma unroll
                for (int mq = 0; mq < MB; ++mq) { const unsigned R = (unsigned)(ai * 128 + (MB * mp + mq) * 16);
#pragma unroll
                    for (int bj = 0; bj < 2; ++bj) {
                        if constexpr (INF32) { const char* xp = (const char*)xin + (size_t)((eo0 + R * 1024u) * 4u) + bj * 128; xv[mq][bj][0] = __builtin_nontemporal_load((const f32x4*)xp); xv[mq][bj][1] = __builtin_nontemporal_load((const f32x4*)(xp + 16)); }
                        else { const u32x4 t4 = *(const u32x4*)((const char*)xin + (size_t)((eo0 + R * 1024u) * 2u) + bj * 64); xv[mq][bj][0] = (f32x4){bflo(t4.x), bfhi(t4.x), bflo(t4.y), bfhi(t4.y)}; xv[mq][bj][1] = (f32x4){bflo(t4.z), bfhi(t4.z), bflo(t4.w), bfhi(t4.w)}; } } }
                asm volatile("" ::: "memory");
#pragma unroll
                for (int mq = 0; mq < MB; ++mq) { const int m = MB * mp + mq; const unsigned R = (unsigned)(ai * 128 + m * 16); u32x4 hd[2];
#pragma unroll
                    for (int bj = 0; bj < 2; ++bj) hd[bj] = pack8(xv[mq][bj][0] + gv[bj][0] * acc[ai][bj][m][0], xv[mq][bj][1] + gv[bj][1] * acc[ai][bj][m][1]);
                    u32x4 A, B; widen_pair(hd[0], hd[1], odd, A, B);
                    char* op = (char*)xout + (size_t)(so0 + R * 2048u); *(u32x4*)op = A; *(u32x4*)(op + 2048) = B; } }
    }
};

__device__ __forceinline__ void ph_s5_scan(const Ctx& C, const Params& P, int sidx) {
    if (sidx < 0) return;
    const int gt = sidx * 512 + C.tid; if (gt >= S5G * NB * 128) return;
    const int p = gt & 63, dir = (gt >> 6) & 1, b = (gt >> 7) & 7, g = gt >> 10;
    const float* LAMT = (const float*)(P.ws + WS_LAMT); const float lr = LAMT[((g * 2 + dir) * 64 + p) * 2], li = LAMT[((g * 2 + dir) * 64 + p) * 2 + 1];
    const float* S = (const float*)(P.ws + AR_SRAW) + (size_t)g * S5ROWS * 256 + dir * 128 + p;
    bf16* Ug = (bf16*)(P.ws + AR_U) + (size_t)g * S5ROWS * S5K + 512 + dir * 128 + p;
    float sr = 0.f, si = 0.f;
    if (dir == 0) {
#pragma unroll
        for (int j = 0; j < S5NCC; ++j) { const int row = 1024 + j * 8 + b; const float ar = S[(size_t)row * 256], ai = S[(size_t)row * 256 + 64]; const float nr = lr * sr - li * si + ar, ni = lr * si + li * sr + ai; sr = nr; si = ni; }
#pragma unroll 8
        for (int c = 0; c < S5NCH; ++c) { const int row = c * 8 + b; const float ar = S[(size_t)row * 256], ai = S[(size_t)row * 256 + 64];
            Ug[(size_t)row * S5K] = (bf16)f2bf(sr); Ug[(size_t)row * S5K + 64] = (bf16)f2bf(si);
            const float nr = lr * sr - li * si + ar, ni = lr * si + li * sr + ai; sr = nr; si = ni; }
    } else {
#pragma unroll
        for (int j = S5NCC - 1; j >= 0; --j) { const int row = 1024 + j * 8 + b; const float ar = S[(size_t)row * 256], ai = S[(size_t)row * 256 + 64]; const float nr = lr * sr - li * si + ar, ni = lr * si + li * sr + ai; sr = nr; si = ni; }
#pragma unroll 8
        for (int c = S5NCH - 1; c >= 0; --c) { const int row = c * 8 + b; const float ar = S[(size_t)row * 256], ai = S[(size_t)row * 256 + 64];
            Ug[(size_t)row * S5K] = (bf16)f2bf(sr); Ug[(size_t)row * S5K + 64] = (bf16)f2bf(si);
            const float nr = lr * sr - li * si + ar, ni = lr * si + li * sr + ai; sr = nr; si = ni; }
    }
}

constexpr int AT_KROW = 208, AT_KB = 64 * AT_KROW  , AT_VB = 8192;
constexpr int AT_K = RING_OFF, AT_V = AT_K + 2 * AT_KB, AT_WS = AT_V + 2 * AT_VB, AT_OST = AT_WS + 8 * 256, AT_END = AT_OST + 8 * 4096;
__device__ __forceinline__ int crow(int r, int hi) { return (r & 3) + 8 * (r >> 2) + 4 * hi; }
typedef short v4i16_t __attribute__((ext_vector_type(4)));
__device__ __forceinline__ s16x4 vtr(const LAS unsigned char* p) { return __builtin_bit_cast(s16x4, __builtin_amdgcn_ds_read_tr16_b64_v4i16((LAS v4i16_t*)p)); }
__device__ __forceinline__ float xhalf_max(float m) { auto rr = __builtin_amdgcn_permlane32_swap(__float_as_uint(m), __float_as_uint(m), false, false); return fmaxf(__uint_as_float(rr[0]), __uint_as_float(rr[1])); }
__device__ __forceinline__ float xhalf_sum(float m) { auto rr = __builtin_amdgcn_permlane32_swap(__float_as_uint(m), __float_as_uint(m), false, false); return __uint_as_float(rr[0]) + __uint_as_float(rr[1]); }

__device__ __forceinline__ float max3f(float a, float b, float c) { return fmaxf(fmaxf(a, b), c); }
constexpr int AT2_KB = 64 * 256, AT2_K = RING_OFF, AT2_V = AT2_K + 2 * AT2_KB, AT2_WS = AT2_V + 2 * AT_VB, AT2_OST = AT2_WS + 8 * 256, AT2_END = AT2_OST + 8 * 4096;
static_assert(AT2_END <= LDS_BYTES, "attention LDS");
template <bool NOMAX> __device__ __forceinline__ void ph_attention(const Ctx& C, const Params& P, int vcu) {
    const bf16* Q = (const bf16*)(P.ws + AR_QRAW); const bf16* KF = (const bf16*)(P.ws + AR_KF); const bf16* KV = (const bf16*)(P.ws + AR_KVRAW); bf16* CAT = (bf16*)(P.ws + AR_CAT);
    const int lane = C.lane, wid = C.wave, r32 = lane & 31, hi = lane >> 5;
    LAS unsigned char* lds = C.lds;
    LAS float* wsf = (LAS float*)(lds + AT2_WS) + wid * 64;
    const int vrd = ((lane >> 4) & 1) * 32 + (lane & 3) * 8 + (4 * hi + ((lane & 15) >> 2)) * 64;
    int kro[6];
#pragma unroll
    for (int d0 = 0; d0 < 6; ++d0) kro[d0] = r32 * 256 + (((2 * d0 + hi) ^ (r32 & 15)) << 4);
    constexpr int NTILE = (SEQ + CTXL) / 64;
    constexpr float THR = 8.0f;
#define SB() __builtin_amdgcn_sched_barrier(0)
#define AT_ROW0(j) (((j) < 64) ? ((size_t)b * SEQ + (size_t)(j) * 64) : ((size_t)T + (size_t)b * CTXL + (size_t)((j) - 64) * 64))
#define AT_DMAK(j, buf) do { const bf16* kb_ = KF + AT_ROW0(j) * 768 + hd * 96; _Pragma("unroll") for (int q_ = 0; q_ < 2; ++q_) { \
        const int row_ = 4 * (2 * wid + q_) + (lane >> 4); int c_ = (lane & 15) ^ (row_ & 15); c_ = c_ < 12 ? c_ : c_ - 12;     \
        __builtin_amdgcn_global_load_lds((const unsigned*)(kb_ + row_ * 768 + c_ * 8), (LAS unsigned*)(lds + AT2_K + (buf) * AT2_KB + (2 * wid + q_) * 1024), 16, 0, 0); } } while (0)
#define AT_DMAV(j, buf) do { const bf16* vb_ = KV + AT_ROW0(j) * 1024 + hd * 128; \
        __builtin_amdgcn_global_load_lds((const unsigned*)(vb_ + (16 * (wid & 3) + (lane >> 2)) * 1024 + 64 + ((wid >> 2) * 4 + (lane & 3)) * 8), (LAS unsigned*)(lds + AT2_V + (buf) * AT_VB + wid * 1024), 16, 0, 0); } while (0)
#define AT_KFRAG(Kb, d0, h) (*(const LAS bf16x8*)((Kb) + (h) * 32 * 256 + kro[d0]))
    for (int i = 0;; ++i) {
        const int un = i * C.G + vcu; if (un >= NB * NHEAD * 16) break;
        const int bh = un >> 4, qb = un & 15, b = bh >> 3, hd = bh & 7;
        const size_t qrow = (size_t)b * SEQ + qb * 256 + wid * 32 + r32;
        bf16x8 qr[6];
#pragma unroll
        for (int d0 = 0; d0 < 6; ++d0) qr[d0] = *(const bf16x8*)(Q + qrow * 768 + hd * 96 + d0 * 16 + hi * 8);
        f32x16 o0 = {}, o1 = {}; float m = NOMAX ? 0.f : -1e30f, l = 0.f;
        AT_DMAK(0, 0); AT_DMAV(0, 0); AT_DMAK(1, 1);
        __syncthreads();
        f32x16 pc0 = {}, pc1 = {};
        { const LAS unsigned char* Kb = lds + AT2_K;
#pragma unroll
          for (int d0 = 0; d0 < 6; ++d0) { pc0 = __builtin_amdgcn_mfma_f32_32x32x16_bf16(AT_KFRAG(Kb, d0, 0), qr[d0], pc0, 0, 0, 0); pc1 = __builtin_amdgcn_mfma_f32_32x32x16_bf16(AT_KFRAG(Kb, d0, 1), qr[d0], pc1, 0, 0, 0); } }
        for (int j = 0; j < NTILE; ++j) {
            const int buf = j & 1; const bool more = j + 1 < NTILE;
            if (j + 2 < NTILE) AT_DMAK(j + 2, buf);
            if (more) AT_DMAV(j + 1, buf ^ 1);
            const LAS unsigned char* Kn = lds + AT2_K + (buf ^ 1) * AT2_KB;
            f32x16 pn0 = {}, pn1 = {};
            bf16x8 ka = AT_KFRAG(Kn, 0, 0), kb = AT_KFRAG(Kn, 0, 1), kc = AT_KFRAG(Kn, 1, 0), kd = AT_KFRAG(Kn, 1, 1);
            if (more) { pn0 = __builtin_amdgcn_mfma_f32_32x32x16_bf16(ka, qr[0], pn0, 0, 0, 0); pn1 = __builtin_amdgcn_mfma_f32_32x32x16_bf16(kb, qr[0], pn1, 0, 0, 0); }
            float mt = 0.f, mu = 0.f;
            if constexpr (!NOMAX) { mt = max3f(pc0[0], pc0[1], pc1[0]); mu = max3f(pc0[2], pc0[3], pc1[1]);
            mt = max3f(mt, pc1[2], pc1[3]);
#pragma unroll
            for (int r = 4; r < 16; r += 4) { mt = max3f(mt, pc0[r], pc0[r + 1]); mu = max3f(mu, pc0[r + 2], pc0[r + 3]); mt = max3f(mt, pc1[r], pc1[r + 1]); mu = max3f(mu, pc1[r + 2], pc1[r + 3]); } }
            if (more) { pn0 = __builtin_amdgcn_mfma_f32_32x32x16_bf16(kc, qr[1], pn0, 0, 0, 0); pn1 = __builtin_amdgcn_mfma_f32_32x32x16_bf16(kd, qr[1], pn1, 0, 0, 0); }
            ka = AT_KFRAG(Kn, 2, 0); kb = AT_KFRAG(Kn, 2, 1); kc = AT_KFRAG(Kn, 3, 0); kd = AT_KFRAG(Kn, 3, 1);
            if constexpr (!NOMAX) mt = xhalf_max(fmaxf(mt, mu));
            if (!NOMAX && __any(mt > m + THR)) {
                const float mn = fmaxf(m, mt), alpha = __builtin_amdgcn_exp2f(m - mn); m = mn; l *= alpha;
                if (hi == 0) wsf[r32] = alpha;
                LDS_WAIT();
#pragma unroll
                for (int r = 0; r < 16; ++r) { const float a = wsf[crow(r, hi)]; o0[r] *= a; o1[r] *= a; }
            }
            SB();
            if (more) { pn0 = __builtin_amdgcn_mfma_f32_32x32x16_bf16(ka, qr[2], pn0, 0, 0, 0); pn1 = __builtin_amdgcn_mfma_f32_32x32x16_bf16(kb, qr[2], pn1, 0, 0, 0); }
            float ls = 0.f;
#pragma unroll
            for (int r = 0; r < 8; ++r) { pc0[r] = __builtin_amdgcn_exp2f(NOMAX ? pc0[r] : pc0[r] - m); ls += pc0[r]; }
            SB();
            if (more) { pn0 = __builtin_amdgcn_mfma_f32_32x32x16_bf16(kc, qr[3], pn0, 0, 0, 0); pn1 = __builtin_amdgcn_mfma_f32_32x32x16_bf16(kd, qr[3], pn1, 0, 0, 0); }
            ka = AT_KFRAG(Kn, 4, 0); kb = AT_KFRAG(Kn, 4, 1); kc = AT_KFRAG(Kn, 5, 0); kd = AT_KFRAG(Kn, 5, 1);
#pragma unroll
            for (int r = 8; r < 16; ++r) { pc0[r] = __builtin_amdgcn_exp2f(NOMAX ? pc0[r] : pc0[r] - m); ls += pc0[r]; }
            SB();
            if (more) { pn0 = __builtin_amdgcn_mfma_f32_32x32x16_bf16(ka, qr[4], pn0, 0, 0, 0); pn1 = __builtin_amdgcn_mfma_f32_32x32x16_bf16(kb, qr[4], pn1, 0, 0, 0); }
#pragma unroll
            for (int r = 0; r < 8; ++r) { pc1[r] = __builtin_amdgcn_exp2f(NOMAX ? pc1[r] : pc1[r] - m); ls += pc1[r]; }
            SB();
            if (more) { pn0 = __builtin_amdgcn_mfma_f32_32x32x16_bf16(kc, qr[5], pn0, 0, 0, 0); pn1 = __builtin_amdgcn_mfma_f32_32x32x16_bf16(kd, qr[5], pn1, 0, 0, 0); }
#pragma unroll
            for (int r = 8; r < 16; ++r) { pc1[r] = __builtin_amdgcn_exp2f(NOMAX ? pc1[r] : pc1[r] - m); ls += pc1[r]; }
            l += ls;
            SB();
            const LAS unsigned char* Vb = lds + AT2_V + buf * AT_VB + vrd;
            s16x4 l0 = vtr(Vb), h0 = vtr(Vb + 512), l1 = vtr(Vb + 4096), h1 = vtr(Vb + 4096 + 512);
#pragma unroll
            for (int ks = 0; ks < 4; ++ks) {
                u32x4 w;
#pragma unroll
                for (int q = 0; q < 4; ++q) { const int r = (ks & 1) * 8 + 2 * q; w[q] = (ks < 2) ? pg8::cvt_pk_bf16(pc0[r], pc0[r + 1]) : pg8::cvt_pk_bf16(pc1[r], pc1[r + 1]); }
                const bf16x8 pw = __builtin_bit_cast(bf16x8, w);
                const bf16x8 v0 = (bf16x8){l0[0], l0[1], l0[2], l0[3], h0[0], h0[1], h0[2], h0[3]}, v1 = (bf16x8){l1[0], l1[1], l1[2], l1[3], h1[0], h1[1], h1[2], h1[3]};
                if (ks < 3) { l0 = vtr(Vb + (ks + 1) * 1024); h0 = vtr(Vb + (ks + 1) * 1024 + 512); l1 = vtr(Vb + 4096 + (ks + 1) * 1024); h1 = vtr(Vb + 4096 + (ks + 1) * 1024 + 512); }
                o0 = __builtin_amdgcn_mfma_f32_32x32x16_bf16(pw, v0, o0, 0, 0, 0); o1 = __builtin_amdgcn_mfma_f32_32x32x16_bf16(pw, v1, o1, 0, 0, 0);
                SB();
            }
            pc0 = pn0; pc1 = pn1;
            __syncthreads();
        }
        l = xhalf_sum(l);
        if (hi == 0) wsf[32 + r32] = l;
        LDS_WAIT();
        LAS bf16* stl = (LAS bf16*)(lds + AT2_OST + wid * 4096);
#pragma unroll
        for (int r = 0; r < 16; ++r) { const int orow = crow(r, hi); const float rl = 1.0f / wsf[32 + orow];
            stl[orow * 64 + r32] = (bf16)f2bf(o0[r] * rl); stl[orow * 64 + 32 + r32] = (bf16)f2bf(o1[r] * rl); }
        LDS_WAIT();
        const size_t orow0 = (size_t)b * SEQ + qb * 256 + wid * 32;
#pragma unroll
        for (int q = 0; q < 4; ++q) { const int row = q * 8 + (lane >> 3), ch = lane & 7; const u32x4 v = *(const LAS u32x4*)(stl + row * 64 + ch * 8); *(u32x4*)(CAT + (orow0 + row) * 1024 + hd * 64 + ch * 8) = v; }
        __syncthreads();
    }
#undef SB
#undef AT_ROW0
#undef AT_DMAK
#undef AT_DMAV
#undef AT_KFRAG
}

constexpr int LC_BLKSTART = 128, LC_CNT = 704, LC_BLK2HE = 1216;
constexpr int RT_XH = RING_OFF, RT_XL = RT_XH + 16 * 1032 * 2, RT_LG = RT_XL + 16 * 1032 * 2, RT_MS = RT_LG + 2 * 16 * 64 * 4, RT_KEYS = RT_MS + 2 * 1024 * 4, RT_LCNT = RT_KEYS + 16 * 64 * 4, RT_GBASE = RT_LCNT + 64 * 4  , RT_ST = RT_GBASE + 512  , RT_END = RT_ST + 16 * 1024 * 4;
static_assert(RT_END <= LDS_BYTES && RT_ST % 16 == 0, "router LDS");

__device__ __forceinline__ void ph_router(const Ctx& C, const Params& P, const bf16* xin, int li, int cset) {
    LAS bf16* XH = (LAS bf16*)(C.lds + RT_XH); LAS bf16* XL = (LAS bf16*)(C.lds + RT_XL); LAS float* LG = (LAS float*)(C.lds + RT_LG);
    LAS float* MS = (LAS float*)(C.lds + RT_MS);
    LAS int* lcnt = (LAS int*)(C.lds + RT_LCNT); LAS int* gbase = (LAS int*)(C.lds + RT_GBASE);
    bf16* H = (bf16*)(P.ws + WS_H); const float* mod = (const float*)(P.ws + WS_MOD); float* TOPW = (float*)(P.ws + WS_TOPW); int* TOK = (int*)(P.ws + WS_TOK);
    unsigned* gcnt = (unsigned*)(P.ws + WS_CTL) + CW_CNT + (cset * 2) * 64 * 16;
    const float* RW = P.router_w + (size_t)li * 1024 * 64; const float* RB = P.router_b + li * 64;
    const int lane = C.lane, w = C.wave, eq = w & 3, kh = w >> 2, fi = lane & 15, fk = lane >> 4;
    constexpr int NT = T / 16;
    const int per = (NT + C.G - 1) / C.G, tbeg = C.bid * per, tend = (tbeg + per < NT) ? tbeg + per : NT;
    if (tbeg >= NT) return;
    bf16x8 bh[16], bl[16];
#pragma unroll
    for (int ks = 0; ks < 16; ++ks) { u32x4 wh, wl;
#pragma unroll
        for (int q = 0; q < 4; ++q) { const int k = kh * 512 + ks * 32 + 8 * fk + 2 * q; const float w0 = RW[(size_t)k * 64 + eq * 16 + fi], w1 = RW[(size_t)(k + 1) * 64 + eq * 16 + fi];
            const unsigned h0 = f2bf(w0), h1 = f2bf(w1); wh[q] = h0 | (h1 << 16); wl[q] = pk2(w0 - bf2f((unsigned short)h0), w1 - bf2f((unsigned short)h1)); }
        bh[ks] = __builtin_bit_cast(bf16x8, wh); bl[ks] = __builtin_bit_cast(bf16x8, wl);
        if ((ks & 3) == 3) asm volatile("" ::: "memory"); }
    const float rb = RB[lane];
    if (C.tid < 64) lcnt[C.tid] = 0;
    LAS bf16* ST = (LAS bf16*)(C.lds + RT_ST);
#define RT_LOADROWS(tile_) do { _Pragma("unroll") for (int rr = 0; rr < 2; ++rr) { const bf16* xr = xin + (size_t)((tile_) * 16 + 2 * w + rr) * 1024; \
        _Pragma("unroll") for (int j = 0; j < 2; ++j) __builtin_amdgcn_global_load_lds((const unsigned*)(xr + 512 * j + 8 * lane), (LAS unsigned*)(ST + (2 * w + rr) * 1024 + 512 * j), 16, 0, 2  ); } } while (0)
    RT_LOADROWS(tbeg);
    int plr[2] = {0, 0}, ptok[2] = {-1, -1}, phf = 0;
    int qlr[2] = {0, 0}, qtok[2] = {-1, -1}, qhf = 0;
    int gbv = 0, npend = 0, it = 0, bcur = -1;
    for (int tile = tbeg; tile < tend; ++tile) {
        const int t0 = tile * 16, hf = t0 >= HALF_T ? 1 : 0;
        if ((t0 >> 12) != bcur) { bcur = t0 >> 12; const float* m = mod + (size_t)(li * 8 + bcur) * 6144;
            __syncthreads();
            for (int i = C.tid; i < 1024; i += 512) { MS[i] = m[4096 + i] + 1.0f; MS[1024 + i] = m[3072 + i]; }
            __syncthreads(); }
        TACC_B(C, 1);
        f32x4 v[2][4];
        asm volatile("s_waitcnt vmcnt(0)" ::: "memory");
#pragma unroll
        for (int rr = 0; rr < 2; ++rr)
#pragma unroll
            for (int j = 0; j < 4; ++j) { const u32x2 t2 = *(const LAS u32x2*)(ST + (2 * w + rr) * 1024 + 256 * j + 4 * lane); v[rr][j] = (f32x4){bflo(t2.x), bfhi(t2.x), bflo(t2.y), bfhi(t2.y)}; }
        LDS_WAIT();
        if (tile + 1 < tend) RT_LOADROWS(tile + 1);
        float ss[2];
#pragma unroll
        for (int rr = 0; rr < 2; ++rr) { float s = 0.f;
#pragma unroll
            for (int j = 0; j < 4; ++j) s += (v[rr][j].x * v[rr][j].x + v[rr][j].y * v[rr][j].y) + (v[rr][j].z * v[rr][j].z + v[rr][j].w * v[rr][j].w);
            ss[rr] = s; }
#pragma unroll
        for (int o = 1; o < 64; o <<= 1) {
#pragma unroll
            for (int rr = 0; rr < 2; ++rr) ss[rr] += __shfl_xor(ss[rr], o); }
#pragma unroll
        for (int j = 0; j < 4; ++j) { const f32x4 a = *(const LAS f32x4*)(MS + 256 * j + 4 * lane), b = *(const LAS f32x4*)(MS + 1024 + 256 * j + 4 * lane);
#pragma unroll
            for (int rr = 0; rr < 2; ++rr) { const int i = 2 * w + rr; const float rstd = __builtin_amdgcn_rsqf(ss[rr] * (1.0f / 1024.0f) + EPS);
                const f32x4 y = v[rr][j] * rstd * a + b; u32x2 o; o.x = pk2(y.x, y.y); o.y = pk2(y.z, y.w);
                *(u32x2*)(H + (size_t)(t0 + i) * 1024 + 256 * j + 4 * lane) = o; *(LAS u32x2*)(XH + i * 1032 + 256 * j + 4 * lane) = o;
                u32x2 lo; lo.x = pk2(y.x - bflo(o.x), y.y - bfhi(o.x)); lo.y = pk2(y.z - bflo(o.y), y.w - bfhi(o.y)); *(LAS u32x2*)(XL + i * 1032 + 256 * j + 4 * lane) = lo; } }
        TACC_E(C, 1); TACC_B(C, 4);
        LBAR();
        TACC_E(C, 4); TACC_B(C, 2);
        if (npend == 2) {
#pragma unroll
            for (int rr = 0; rr < 2; ++rr) if (qtok[rr] >= 0) TOK[(size_t)(qhf * 64 + lane) * MOE_CAP + gbase[(it & 1) * 64 + lane] + qlr[rr]] = qtok[rr]; }
        { f32x4 acc0 = {0.f, 0.f, 0.f, 0.f}, acc1 = {0.f, 0.f, 0.f, 0.f}, acc2 = {0.f, 0.f, 0.f, 0.f};
#pragma unroll
          for (int ks = 0; ks < 16; ++ks) { const int ko = fi * 1032 + kh * 512 + ks * 32 + 8 * fk; const bf16x8 ah = *(const LAS bf16x8*)(XH + ko), al = *(const LAS bf16x8*)(XL + ko);
              acc0 = __builtin_amdgcn_mfma_f32_16x16x32_bf16(ah, bh[ks], acc0, 0, 0, 0); acc1 = __builtin_amdgcn_mfma_f32_16x16x32_bf16(ah, bl[ks], acc1, 0, 0, 0); acc2 = __builtin_amdgcn_mfma_f32_16x16x32_bf16(al, bh[ks], acc2, 0, 0, 0);
              if ((ks & 3) == 3) asm volatile("" ::: "memory"); }
          const f32x4 acc = acc0 + (acc1 + acc2);
#pragma unroll
          for (int r = 0; r < 4; ++r) LG[(kh * 16 + 4 * fk + r) * 64 + eq * 16 + fi] = acc[r]; }
        TACC_E(C, 2); TACC_B(C, 4);
        LBAR();
        TACC_E(C, 4); TACC_B(C, 3);
        if (npend >= 1) { if (C.tid < 64) gbase[((it - 1) & 1) * 64 + C.tid] = gbv;
#pragma unroll
            for (int rr = 0; rr < 2; ++rr) { qlr[rr] = plr[rr]; qtok[rr] = ptok[rr]; } qhf = phf; }
        float sc[2], wsum[2]; int rank[2];
#pragma unroll
        for (int rr = 0; rr < 2; ++rr) { const int i = 2 * w + rr; sc[rr] = sigmf(LG[i * 64 + lane] + LG[(16 + i) * 64 + lane]);
            const unsigned key = (__builtin_bit_cast(unsigned, sc[rr] + rb + 1.0f) & ~63u) | (unsigned)(63 - lane);
            unsigned thr = 0u;
#pragma unroll
            for (int bit = 31; bit >= 0; --bit) { const unsigned cand = thr | (1u << bit); if (__popcll(__ballot(key >= cand)) >= TOPK) thr = cand; }
            unsigned long long selm = __ballot(key >= thr); int rk = 0; float ws = 0.f;
#pragma unroll
            for (int k = 0; k < TOPK; ++k) { const int jl = __ffsll((long long)selm) - 1; selm &= selm - 1;
                const unsigned kj = (unsigned)__builtin_amdgcn_readlane((int)key, jl); ws += __builtin_bit_cast(float, __builtin_amdgcn_readlane(__builtin_bit_cast(int, sc[rr]), jl)); rk += (kj > key) ? 1 : 0; }
            rank[rr] = (key >= thr) ? rk : 64; wsum[rr] = ws; }
#pragma unroll
        for (int rr = 0; rr < 2; ++rr) { const int i = 2 * w + rr; ptok[rr] = -1;
            if (rank[rr] < TOPK) { ptok[rr] = (t0 + i) * 8 + rank[rr];
                plr[rr] = __hip_atomic_fetch_add(&lcnt[lane], 1, __ATOMIC_RELAXED, __HIP_MEMORY_SCOPE_WORKGROUP); } }
#pragma unroll
        for (int rr = 0; rr < 2; ++rr) { const int i = 2 * w + rr; if (rank[rr] < TOPK) TOPW[(size_t)(t0 + i) * 8 + rank[rr]] = sc[rr] / wsum[rr] * 2.5f; }
        phf = hf; npend = npend < 2 ? npend + 1 : 2;
        TACC_E(C, 3); TACC_B(C, 4);
        LBAR();
        TACC_E(C, 4);
        if (C.tid < 64) { const int n = lcnt[C.tid]; lcnt[C.tid] = 0; gbv = n > 0 ? (int)__hip_atomic_fetch_add(gcnt + (hf * 64 + C.tid) * 16, (unsigned)n, RLX_AGENT) : 0; }
        ++it;
    }
    __syncthreads();
    if (npend == 2) {
#pragma unroll
        for (int rr = 0; rr < 2; ++rr) if (qtok[rr] >= 0) TOK[(size_t)(qhf * 64 + lane) * MOE_CAP + gbase[(it & 1) * 64 + lane] + qlr[rr]] = qtok[rr]; }
    if (npend >= 1 && C.tid < 64) gbase[((it - 1) & 1) * 64 + C.tid] = gbv;
    __syncthreads();
    if (npend >= 1) {
#pragma unroll
        for (int rr = 0; rr < 2; ++rr) if (ptok[rr] >= 0) TOK[(size_t)(phf * 64 + lane) * MOE_CAP + gbase[((it - 1) & 1) * 64 + lane] + plr[rr]] = ptok[rr]; }
    __syncthreads();
#undef RT_LOADROWS
}

__device__ __forceinline__ int moe_tables(const Ctx& C, const Params& P, int li) {
    LAS int* blkstart = (LAS int*)(C.lds + LC_BLKSTART); LAS int* cnt = (LAS int*)(C.lds + LC_CNT); LAS unsigned short* blk2he = (LAS unsigned short*)(C.lds + LC_BLK2HE);
    const unsigned* gcnt = (const unsigned*)(P.ws + WS_CTL) + CW_CNT + (li * 2) * 64 * 16;
    __syncthreads();
    if (C.tid < 128) { int n = (int)__hip_atomic_load(gcnt + C.tid * 16, RLX_AGENT); n = n < 0 ? 0 : (n > MOE_CAP ? MOE_CAP : n); cnt[C.tid] = n; }
    __syncthreads();
    if (C.tid == 0) { int s = 0; for (int i = 0; i < 128; ++i) { blkstart[i] = s; s += (cnt[i] + 255) >> 8; } blkstart[128] = s; }
    __syncthreads();
    const int nblk = blkstart[128];
    if (C.tid < 128) { const int b0 = blkstart[C.tid], b1 = blkstart[C.tid + 1]; for (int b = b0; b < b1 && b < MAXBLK; ++b) blk2he[b] = (unsigned short)C.tid; }
    __syncthreads();
    return nblk < MAXBLK ? nblk : MAXBLK;
}
struct SchedMoE1 {
    const char* H; const char* W1; const int* TOK; const LAS int* blkstart; const LAS unsigned short* blk2he; int nblk, G, c;
    __device__ __forceinline__ bool next(int i, Unit& u) const { int L = i * G + c;
        if (L < 2 * nblk) { const int blk = L >> 1, pn = L & 1, he = blk2he[blk], bi = blk - blkstart[he], e = he & 63; u.A = H; u.rows = TOK + (size_t)he * MOE_CAP + bi * 256;
            u.B = W1 + ((size_t)e * 512 + pn * 256) * 2048; u.pm = blk; u.pn = pn; u.z = 0; return true; }
        L -= 2 * nblk; if (L >= 256) return false; u.pm = L >> 1; u.pn = L & 1; u.z = 1; u.A = H + (size_t)u.pm * 256 * 2048; u.rows = nullptr; u.B = W1 + ((size_t)64 * 512 + u.pn * 256) * 2048; return true; }
};
struct EpiMoE1 {
    static constexpr bool PERM = true; bf16* HID; bf16* HIDS;
    __device__ __forceinline__ void operator()(EPI_ARGS) const { bf16* O = u.z ? HIDS : HID;
#pragma unroll
        for (int ai = 0; ai < 2; ++ai)
#pragma unroll
            for (int m = 0; m < 4; ++m) { const size_t row = (size_t)u.pm * 256 + ai * 128 + wr * 64 + m * 16 + fr; f32x4 v0, v1;
#pragma unroll
                for (int j = 0; j < 4; ++j) { v0[j] = siluf_e(acc[ai][0][m][0][j]) * acc[ai][1][m][0][j]; v1[j] = siluf_e(acc[ai][0][m][1][j]) * acc[ai][1][m][1][j]; }
                *(u32x4*)(O + row * 256 + u.pn * 128 + wc * 32 + 8 * fq) = pack8(v0, v1); }
    }
};
struct SchedMoE2 {
    const char* HID; const char* W2; const LAS unsigned short* blk2he; int b0, b1, G, c;
    __device__ __forceinline__ bool next(int i, Unit& u) const { const int L = i * G + c; if (L >= (b1 - b0) * 4) return false; const int blk = b0 + (L >> 2), pn = L & 3, he = blk2he[blk], e = he & 63;
        u.A = HID + (size_t)blk * 256 * 512; u.rows = nullptr; u.B = W2 + ((size_t)e * 1024 + pn * 256) * 512; u.pm = blk; u.pn = pn; u.z = he; return true; }
};
constexpr unsigned YB_ROWS = HALF_T * 6 + 256, YB_R1 = 65 * 1024;
constexpr size_t AR_YBUF1B = AR_YBUF + (size_t)YB_ROWS * 1024;
static_assert(AR_YBUF1B + (size_t)(YB_ROWS - YB_R1) * 1024 <= WS_XB && AR_W1 == WS_AR && AR_W1 + (size_t)YB_R1 * 1024 <= AR_W2, "YBUF halves");
__device__ __forceinline__ unsigned ybuf_off(int hf, unsigned row) { return hf == 0 ? (unsigned)(AR_YBUF - WS_AR) + row * 1024u : (row < YB_R1 ? row * 1024u : (unsigned)(AR_YBUF1B - WS_AR) + (row - YB_R1) * 1024u); }
__device__ __forceinline__ unsigned pk4_fp8(const f32x4 a) { int w = __builtin_amdgcn_cvt_pk_fp8_f32(a[0], a[1], 0, false); w = __builtin_amdgcn_cvt_pk_fp8_f32(a[2], a[3], w, true); return (unsigned)w; }
__device__ __forceinline__ f32x4 up4_fp8(unsigned w) { const auto lo = __builtin_amdgcn_cvt_pk_f32_fp8((int)w, false), hi = __builtin_amdgcn_cvt_pk_f32_fp8((int)w, true); return (f32x4){lo[0], lo[1], hi[0], hi[1]}; }
struct EpiMoE2 {
    static constexpr bool PERM = true; unsigned char* AR; const int* TOK; const LAS int* blkstart; const LAS int* cnt;
    __device__ __forceinline__ void operator()(EPI_ARGS) const { const int he = u.z, hf = he >> 6, bi = u.pm - blkstart[he], n = cnt[he];
        int tv[2][4];
#pragma unroll
        for (int ai = 0; ai < 2; ++ai)
#pragma unroll
            for (int m = 0; m < 4; ++m) tv[ai][m] = TOK[(size_t)he * MOE_CAP + bi * 256 + ai * 128 + wr * 64 + m * 16 + fr];
#pragma unroll
        for (int ai = 0; ai < 2; ++ai)
#pragma unroll
            for (int m = 0; m < 4; ++m) { const int r0 = bi * 256 + ai * 128 + wr * 64 + m * 16 + fr, v = tv[ai][m];
                u32x4 w; w.x = pk4_fp8(acc[ai][0][m][0]); w.y = pk4_fp8(acc[ai][0][m][1]); w.z = pk4_fp8(acc[ai][1][m][0]); w.w = pk4_fp8(acc[ai][1][m][1]);
                const unsigned row = r0 < n ? (unsigned)(((v >> 3) - hf * HALF_T) * 6 + (v & 7)) : (unsigned)(HALF_T * 6 + (r0 & 255));
                *(u32x4*)(AR + (size_t)(ybuf_off(hf, row) + (unsigned)(u.pn * 256 + wc * 64 + fq * 16))) = w; }
    }
};
struct EpiNull {
    static constexpr bool PERM = true;
    __device__ __forceinline__ void operator()(EPI_ARGS) const {
#pragma unroll
        for (int ai = 0; ai < 2; ++ai)
#pragma unroll
            for (int m = 0; m < 4; ++m)
#pragma unroll
                for (int bj = 0; bj < 2; ++bj) { asm volatile("" :: "v"(acc[ai][bj][m][0]), "v"(acc[ai][bj][m][1])); }
    }
};
template <bool FUSE> struct EpiCombine {
    static constexpr bool PERM = true; const unsigned char* AR; const float* TOPW; float* X; bf16* XB; const float* gate;
    bf16* HS; float* SSP; LAS float* red;
    __device__ __forceinline__ void operator()(EPI_ARGS) const { const bool odd = fr & 1;
        LAS float* tw = red + 1024; LAS float* gs = tw + 2048;
        { const int t = threadIdx.x, token0 = u.pm * 256;
          *(LAS f32x4*)(tw + t * 4) = *(const f32x4*)(TOPW + (size_t)token0 * 8 + t * 4);
          if (t < (FUSE ? 128 : 64)) { const float* src = gate + (size_t)(token0 >> 12) * 6144 + u.pn * 256 + (t & 63) * 4 + (t >= 64 ? (8 * 6144 + 1024 - 5120) : 0);
              f32x4 v = *(const f32x4*)src; if (t >= 64) v = v + 1.0f; *(LAS f32x4*)(gs + t * 4) = v; }
          asm volatile("s_waitcnt vmcnt(0) lgkmcnt(0)" ::: "memory"); __builtin_amdgcn_s_barrier(); asm volatile("" ::: "memory"); }
        int lr0 = wr * 64 + fr, cw = wc * 64 + 8 * fq; asm volatile("" : "+v"(lr0), "+v"(cw));
        const unsigned tk0 = (unsigned)(u.pm * 256 + lr0); const int hf = u.pm >> 6;
        const unsigned yr0 = (unsigned)((u.pm & 63) * 256 + lr0) * 6u, yc0 = (unsigned)(u.pn * 256 + wc * 64 + fq * 16), xo0 = tk0 * 1024u + (unsigned)(u.pn * 256 + cw);
        const unsigned ho0 = ((tk0 & ~1u) * 1024u + (unsigned)(u.pn * 256 + wc * 64 + (odd ? 32 : 0) + 8 * fq)) * 2u; (void)ho0;
        u32x4 yq[2][6], xq[2][2];
#define CB_LOAD(it_, sl_) do { const int R_ = ((it_) >> 2) * 128 + ((it_) & 3) * 16; const unsigned yr_ = yr0 + (unsigned)R_ * 6u, xe_ = xo0 + (unsigned)R_ * 1024u; \
            _Pragma("unroll") for (int k = 0; k < 6; ++k) yq[sl_][k] = *(const u32x4*)(AR + (size_t)(ybuf_off(hf, yr_ + k) + yc0)); \
            _Pragma("unroll") for (int bj = 0; bj < 2; ++bj) xq[sl_][bj] = *(const u32x4*)((const char*)XB + (size_t)(xe_ * 2u) + bj * 64); } while (0)
        CB_LOAD(0, 0);
#pragma unroll
        for (int it = 0; it < 8; ++it) { const int ai = it >> 2, m = it & 3; { const int R = ai * 128 + m * 16, lr = R + lr0;
                if (it + 1 < 8) CB_LOAD(it + 1, (it + 1) & 1);
                const f32x4 w03 = *(const LAS f32x4*)(tw + lr * 8), w47 = *(const LAS f32x4*)(tw + lr * 8 + 4); const float wk[6] = {w03[0], w03[1], w03[2], w03[3], w47[0], w47[1]};
                const unsigned yr = yr0 + (unsigned)R * 6u; const unsigned xe = xo0 + (unsigned)R * 1024u;
                float ssq = 0.f; u32x4 hd[2], hx[2]; u32x4 y[6]; (void)yr;
#pragma unroll
                for (int k = 0; k < 6; ++k) y[k] = yq[it & 1][k];
#pragma unroll
                for (int bj = 0; bj < 2; ++bj) { f32x4 v0 = acc[ai][bj][m][0], v1 = acc[ai][bj][m][1];
#pragma unroll
                    for (int k = 0; k < 6; ++k) { v0 = v0 + up4_fp8(bj ? y[k].z : y[k].x) * wk[k]; v1 = v1 + up4_fp8(bj ? y[k].w : y[k].y) * wk[k]; }
                    const f32x4 g0 = *(const LAS f32x4*)(gs + cw + bj * 32), g1 = *(const LAS f32x4*)(gs + cw + bj * 32 + 4);
                    const u32x4 t4 = xq[it & 1][bj];
                    const f32x4 n0 = (f32x4){bflo(t4.x), bfhi(t4.x), bflo(t4.y), bfhi(t4.y)} + g0 * v0, n1 = (f32x4){bflo(t4.z), bfhi(t4.z), bflo(t4.w), bfhi(t4.w)} + g1 * v1;
                    if constexpr (!FUSE) { char* xo = (char*)X + (size_t)(xe * 4u) + bj * 128; *(f32x4*)xo = n0; *(f32x4*)(xo + 16) = n1; }
                    if constexpr (FUSE) { const f32x4 a0 = *(const LAS f32x4*)(gs + 256 + cw + bj * 32), a1 = *(const LAS f32x4*)(gs + 256 + cw + bj * 32 + 4);
                        ssq += (n0[0] * n0[0] + n0[1] * n0[1]) + (n0[2] * n0[2] + n0[3] * n0[3]) + (n1[0] * n1[0] + n1[1] * n1[1]) + (n1[2] * n1[2] + n1[3] * n1[3]);
                        hd[bj] = pack8(n0 * a0, n1 * a1); hx[bj] = pack8(n0, n1); } }
                if constexpr (FUSE) {
                    u32x4 A, B; widen_pair(hd[0], hd[1], odd, A, B);
                    char* hp = (char*)HS + (size_t)(ho0 + (unsigned)R * 2048u); *(u32x4*)hp = A; *(u32x4*)(hp + 2048) = B;
                    widen_pair(hx[0], hx[1], odd, A, B); char* xp = (char*)XB + (size_t)(ho0 + (unsigned)R * 2048u); *(u32x4*)xp = A; *(u32x4*)(xp + 2048) = B;
                    ssq += __shfl_xor(ssq, 16); ssq += __shfl_xor(ssq, 32); red[lr * 4 + wc] = ssq; } } }
#undef CB_LOAD
        if constexpr (FUSE) {
            asm volatile("s_waitcnt lgkmcnt(0)" ::: "memory"); __builtin_amdgcn_s_barrier(); asm volatile("" ::: "memory");
            if (threadIdx.x < 256) { const f32x4 r4 = *(const LAS f32x4*)(red + threadIdx.x * 4); SSP[(size_t)u.pn * T + u.pm * 256 + threadIdx.x] = (r4[0] + r4[1]) + (r4[2] + r4[3]); }
            asm volatile("s_waitcnt lgkmcnt(0)" ::: "memory"); __builtin_amdgcn_s_barrier(); asm volatile("" ::: "memory");
        }
    }
};
struct EpiHyIn {
    static constexpr bool PERM = true; bf16* O; const float* SSP; const float* SHW;
    __device__ __forceinline__ void operator()(EPI_ARGS) const { const bool odd = fr & 1;
        float rs[2][4]; f32x4 bw[2][2];
        { const float* bp = SHW + (size_t)((u.pm * 256) >> 12) * 3072 + u.pn * 256 + wc * 64 + 8 * fq;
#pragma unroll
          for (int bj = 0; bj < 2; ++bj) { bw[bj][0] = *(const f32x4*)(bp + bj * 32); bw[bj][1] = *(const f32x4*)(bp + bj * 32 + 4); } }
#pragma unroll
        for (int ai = 0; ai < 2; ++ai)
#pragma unroll
            for (int m = 0; m < 4; ++m) { const size_t row = (size_t)u.pm * 256 + ai * 128 + wr * 64 + m * 16 + fr;
                rs[ai][m] = (SSP[row] + SSP[T + row]) + (SSP[2 * (size_t)T + row] + SSP[3 * (size_t)T + row]); }
#pragma unroll
        for (int ai = 0; ai < 2; ++ai)
#pragma unroll
            for (int m = 0; m < 4; ++m) { const size_t row = (size_t)u.pm * 256 + ai * 128 + wr * 64 + m * 16 + fr; const float r = __builtin_amdgcn_rsqf(rs[ai][m] * (1.0f / 1024.0f) + EPS); u32x4 d[2];
#pragma unroll
                for (int bj = 0; bj < 2; ++bj) d[bj] = pack8(acc[ai][bj][m][0] * r + bw[bj][0], acc[ai][bj][m][1] * r + bw[bj][1]);
                u32x4 A, B; widen_pair(d[0], d[1], odd, A, B);
                bf16* op = O + (row & ~(size_t)1) * 3072 + u.pn * 256 + wc * 64 + (odd ? 32 : 0) + 8 * fq; *(u32x4*)op = A; *(u32x4*)(op + 3072) = B; }
    }
};
__device__ __forceinline__ void ph_shw(const Ctx& C, const Params& P, int item0, int istride) {
    LAS float* sc = (LAS float*)(C.lds + RING_OFF);
    LAS float* red = sc + 8 * 1024;
    const float* mod1 = (const float*)(P.ws + WS_MOD) + (size_t)8 * 6144; float* SHW = (float*)(P.ws + WS_SHW);
    if (item0 >= 48) return;
    __syncthreads();
    for (int i = C.tid; i < 8 * 1024; i += 512) sc[i] = mod1[(size_t)(i >> 10) * 6144 + (i & 1023)];
    __syncthreads();
    for (int item = item0; item < 48; item += istride) {
        const int j0 = item * 64, c4 = C.tid & 15, kp = C.tid >> 4;
        f32x4 a[8];
#pragma unroll
        for (int r = 0; r < 8; ++r) a[r] = (f32x4){0.f, 0.f, 0.f, 0.f};
        const float* w = P.hy_w_in + j0 + 4 * c4;
#pragma unroll 8
        for (int k = kp * 32; k < kp * 32 + 32; ++k) { const f32x4 wv = *(const f32x4*)(w + (size_t)k * 3072);
#pragma unroll
            for (int r = 0; r < 8; ++r) a[r] += wv * sc[r * 1024 + k]; }
#pragma unroll
        for (int r = 0; r < 8; ++r) *(LAS f32x4*)(red + (kp * 8 + r) * 64 + 4 * c4) = a[r];
        __syncthreads();
        { const int r = C.tid >> 6, cc = C.tid & 63; float s2 = 0.f;
#pragma unroll 8
          for (int q = 0; q < 32; ++q) s2 += red[(q * 8 + r) * 64 + cc];
          SHW[(size_t)r * 3072 + j0 + cc] = s2; }
        __syncthreads();
    }
}

__device__ __forceinline__ void ph_hy_prep(const Ctx& C, const Params& P) {
    const bf16* PP = (const bf16*)(P.ws + AR_P); bf16* X0 = (bf16*)(P.ws + AR_X0); bf16* ZT = (bf16*)(P.ws + AR_ZT);
    LAS bf16* ZS = (LAS bf16*)(C.lds + RING_OFF);
    const int tl = C.tid >> 3, d8 = (C.tid & 7) * 8;
    if (C.G % 16 != 0) return;
    const int dt = C.bid & 15, d0 = dt * 64, nwg = C.G >> 4;
    float cw[3][3][8], cb[3][8];
#pragma unroll
    for (int sec = 1; sec < 3; ++sec) {
#pragma unroll
        for (int e = 0; e < 8; ++e) { cb[sec][e] = P.hy_conv_b[sec * 1024 + d0 + d8 + e];
#pragma unroll
            for (int j = 0; j < 3; ++j) cw[sec][j][e] = P.hy_conv_w[j * 3072 + sec * 1024 + d0 + d8 + e]; } }
    u32x4 g[3][3];
#define HP_LOAD(step_) do { const int it_ = (step_) >> 1, b_ = 2 * (it_ >> 6) + ((step_) & 1), t_ = (it_ & 63) * 64 + tl; \
        _Pragma("unroll") for (int j = 0; j < 3; ++j) { const int tt = t_ - 1 + j; const bool ok = tt >= 0 && tt < SEQ; const size_t r_ = (size_t)b_ * SEQ + (ok ? tt : t_); \
            _Pragma("unroll") for (int sec = 1; sec < 3; ++sec) { g[sec][j] = *(const u32x4*)(PP + r_ * 3072 + sec * 1024 + d0 + d8); } } } while (0)
    constexpr int NSTEP = 2 * 4 * 64;
    int step = 2 * (C.bid >> 4), par = 0;
    if (step < NSTEP) HP_LOAD(step);
    for (; step < NSTEP; ) {
        const int it = step >> 1, q = step & 1, bp = it >> 6, b = 2 * bp + q, t0 = (it & 63) * 64, t = t0 + tl; const size_t row = (size_t)b * SEQ + t;
        float o[3][8];
#pragma unroll
        for (int sec = 1; sec < 3; ++sec) {
#pragma unroll
            for (int e = 0; e < 8; ++e) o[sec][e] = cb[sec][e];
#pragma unroll
            for (int j = 0; j < 3; ++j) { const int tt = t - 1 + j; const bool okt = tt >= 0 && tt < SEQ; u32x4 w = g[sec][j]; if (!okt) w = (u32x4){0u, 0u, 0u, 0u};
                o[sec][0] += bflo(w.x) * cw[sec][j][0]; o[sec][1] += bfhi(w.x) * cw[sec][j][1]; o[sec][2] += bflo(w.y) * cw[sec][j][2]; o[sec][3] += bfhi(w.y) * cw[sec][j][3];
                o[sec][4] += bflo(w.z) * cw[sec][j][4]; o[sec][5] += bfhi(w.z) * cw[sec][j][5]; o[sec][6] += bflo(w.w) * cw[sec][j][6]; o[sec][7] += bfhi(w.w) * cw[sec][j][7]; } }
        const int nstep = q == 0 ? step + 1 : step + 2 * nwg - 1;
        if (nstep < NSTEP) HP_LOAD(nstep);
        LAS bf16* zs = ZS + par * (64 * 136);
#pragma unroll
        for (int e = 0; e < 8; ++e) zs[(d8 + e) * 136 + tl * 2 + q] = (bf16)f2bf(o[2][e] * o[1][e]);
        if (q == 1) {
            LBAR();
            { const int dl = C.tid >> 3, tp = (C.tid & 7) * 8; const u32x4 w0 = *(const LAS u32x4*)(zs + dl * 136 + tp * 2), w1 = *(const LAS u32x4*)(zs + dl * 136 + tp * 2 + 8);
              bf16* zo = ZT + (((size_t)(d0 + dl) * 4 + bp) * SEQ + t0 + tp) * 2; *(u32x4*)zo = w0; *(u32x4*)(zo + 8) = w1; }
            par ^= 1;
        }
        step = nstep;
    }
#undef HP_LOAD
    __syncthreads();
}

__device__ __forceinline__ f32x2 cmul(f32x2 a, f32x2 b) { return (f32x2){a.x * b.x - a.y * b.y, a.x * b.y + a.y * b.x}; }
__device__ __forceinline__ f32x2 cmulc(f32x2 a, f32x2 b) { return (f32x2){a.x * b.x + a.y * b.y, a.y * b.x - a.x * b.y}; }
template <bool INV> __device__ __forceinline__ void dft16(f32x2 (&v)[16]) {
    constexpr float WC[10] = {1.f, 0.9238795325112867f, 0.7071067811865476f, 0.3826834323650898f, 0.f, 0.f, -0.7071067811865476f, 0.f, 0.f, -0.9238795325112867f};
    constexpr float WS_[10] = {0.f, 0.3826834323650898f, 0.7071067811865476f, 0.9238795325112867f, 1.f, 0.f, 0.7071067811865476f, 0.f, 0.f, -0.3826834323650898f};
    f32x2 t[16];
#pragma unroll
    for (int b = 0; b < 4; ++b) { const f32x2 x0 = v[b], x1 = v[4 + b], x2 = v[8 + b], x3 = v[12 + b];
        const f32x2 s0 = x0 + x2, s1 = x0 - x2, s2 = x1 + x3, s3 = x1 - x3; const f32x2 is3 = (f32x2){-s3.y, s3.x};
        t[0 * 4 + b] = s0 + s2; t[2 * 4 + b] = s0 - s2; t[1 * 4 + b] = INV ? s1 + is3 : s1 - is3; t[3 * 4 + b] = INV ? s1 - is3 : s1 + is3; }
#pragma unroll
    for (int c = 1; c < 4; ++c)
#pragma unroll
        for (int b = 1; b < 4; ++b) { const int mm = b * c; const f32x2 w = (f32x2){WC[mm], WS_[mm]}; t[c * 4 + b] = INV ? cmul(t[c * 4 + b], w) : cmulc(t[c * 4 + b], w); }
#pragma unroll
    for (int c = 0; c < 4; ++c) { const f32x2 x0 = t[c * 4], x1 = t[c * 4 + 1], x2 = t[c * 4 + 2], x3 = t[c * 4 + 3];
        const f32x2 s0 = x0 + x2, s1 = x0 - x2, s2 = x1 + x3, s3 = x1 - x3; const f32x2 is3 = (f32x2){-s3.y, s3.x};
        v[c] = s0 + s2; v[c + 8] = s0 - s2; v[c + 4] = INV ? s1 + is3 : s1 - is3; v[c + 12] = INV ? s1 - is3 : s1 + is3; }
}
constexpr int FF_TW = RING_OFF, FF_TW2 = FF_TW + 32768, FF_DE = FF_TW2 + 32768, FF_DO = FF_DE + 4352 * 8, FF_RED = FF_DO + 4352 * 8, FF_ZST = FF_RED + 64  , FF_END = FF_ZST + 16384;
static_assert(FF_END <= LDS_BYTES, "FFT LDS");
__device__ __forceinline__ int pidx(int i) { return i + (i >> 4); }
template <bool LOADH> __device__ __forceinline__ void fft_fwd(LAS f32x2* D, const LAS f32x2* TW, int t8, f32x2 (&v)[16], const char* hbase, unsigned hoff, f32x2 (&hs)[16]) {
#pragma unroll
    for (int a = 0; a < 16; ++a) v[a] = D[pidx(256 * a + t8)];
    dft16<false>(v);
    { const int n1 = t8 >> 4;
#pragma unroll
      for (int k0 = 0; k0 < 16; ++k0) D[pidx(256 * k0 + t8)] = cmul(v[k0], TW[(16 * n1 * k0) & 4095]); }
    LBAR();
    { const int k0 = t8 >> 4, n0 = t8 & 15;
#pragma unroll
      for (int a = 0; a < 16; ++a) v[a] = D[pidx(256 * k0 + 16 * a + n0)];
      dft16<false>(v);
#pragma unroll
      for (int k1 = 0; k1 < 16; ++k1) D[pidx(256 * k0 + 16 * k1 + n0)] = cmul(v[k1], TW[(n0 * (k0 + 16 * k1)) & 4095]); }
    LBAR();
    if constexpr (LOADH) {
#pragma unroll
        for (int a = 0; a < 16; ++a) hs[a] = *(const f32x2*)(hbase + a * 2048 + (size_t)hoff);
        asm volatile("" ::: "memory"); }
#pragma unroll
    for (int a = 0; a < 16; ++a) v[a] = D[pidx(16 * t8 + a)];
    dft16<false>(v);
}
__device__ __forceinline__ void fft_inv(LAS f32x2* D, const LAS f32x2* TW, int t8, f32x2 (&v)[16]) {
    dft16<true>(v);
    { const int kk = t8;
      const int kq = (kk >> 4) + 16 * (kk & 15);
#pragma unroll
      for (int n0 = 0; n0 < 16; ++n0) D[pidx(16 * t8 + n0)] = cmulc(v[n0], TW[(n0 * kq) & 4095]); }
    LBAR();
    { const int k0 = t8 >> 4, n0 = t8 & 15;
#pragma unroll
      for (int a = 0; a < 16; ++a) v[a] = D[pidx(256 * k0 + 16 * a + n0)];
      dft16<true>(v);
#pragma unroll
      for (int n1 = 0; n1 < 16; ++n1) D[pidx(256 * k0 + 16 * n1 + n0)] = cmulc(v[n1], TW[(16 * n1 * k0) & 4095]); }
    LBAR();
#pragma unroll
    for (int a = 0; a < 16; ++a) v[a] = D[pidx(256 * a + t8)];
    dft16<true>(v);
#pragma unroll
    for (int a = 0; a < 16; ++a) D[pidx(256 * a + t8)] = v[a];
    LBAR();
}
__device__ __forceinline__ void ph_hy_fft(const Ctx& C, const Params& P) {
    LAS f32x2* TW = (LAS f32x2*)(C.lds + FF_TW); LAS f32x2* TW2 = (LAS f32x2*)(C.lds + FF_TW2); LAS f32x2* DE = (LAS f32x2*)(C.lds + FF_DE); LAS f32x2* DO = (LAS f32x2*)(C.lds + FF_DO); LAS float* RED = (LAS float*)(C.lds + FF_RED);
    const float* HFT = (const float*)(P.ws + WS_HFT); const unsigned* ZT2 = (const unsigned*)(P.ws + AR_ZT); unsigned* YT2 = (unsigned*)(P.ws + AR_YT);
    const int br = C.tid >> 8, t8 = C.tid & 255; LAS f32x2* D = br ? DO : DE;
    LAS unsigned* ZST = (LAS unsigned*)(C.lds + FF_ZST);
#define FF_DMA(bp_) do { _Pragma("unroll") for (int q_ = 0; q_ < 2; ++q_) __builtin_amdgcn_global_load_lds(ZT2 + ((size_t)d * 4 + (bp_)) * SEQ + (C.wave * 2 + q_) * 256 + C.lane * 4, ZST + (C.wave * 2 + q_) * 256, 16, 0, 0); } while (0)
    for (int i = C.tid; i < 4096; i += 512) { float s, c; sincosf(6.283185307179586f * (float)i / 4096.0f, &s, &c); TW[i] = (f32x2){c, -s}; sincosf(6.283185307179586f * (float)i / 8192.0f, &s, &c); TW2[i] = (f32x2){c, -s}; }
    __syncthreads();
    for (int d = C.bid; d < 1024; d += C.G) {
        const float* hf = HFT + (size_t)d * 2 * 4096; const float* hb = hf + 4096;
        FF_DMA(0);
        float ss = 0.f; float fa[16], ga[16];
        { const unsigned fo = (unsigned)t8 * 4u, go0 = t8 == 0 ? 0u : (unsigned)(4096 - t8) * 4u, go = (unsigned)(4096 - t8) * 4u;
#pragma unroll
          for (int a = 0; a < 16; ++a) { fa[a] = *(const float*)((const char*)hf + a * 1024 + (size_t)fo); ga[a] = a == 0 ? *(const float*)((const char*)hb + (size_t)go0) : *(const float*)((const char*)hb - a * 1024 + (size_t)go); }
          asm volatile("" ::: "memory"); }
#pragma unroll
        for (int a = 0; a < 16; ++a) { const int n = 256 * a + t8; const float f = fa[a], g = ga[a]; ss += f * f + g * g;
            D[pidx(n)] = br == 0 ? (f32x2){f + g, 0.f} : (n == 0 ? (f32x2){f + g, 0.f} : (f32x2){(f - g) * TW2[n].x, (f - g) * TW2[n].y}); }
        ss = wave_sum(ss); if (C.lane == 0) RED[C.wave] = ss;
        __syncthreads();
        const float scale = 1.0f / sqrtf(RED[0] + RED[1] + RED[2] + RED[3] + EPS);
        f32x2 v[16], hs[16]; const float bias = P.hy_bias[d];
        fft_fwd<false>(D, TW, t8, v, nullptr, 0u, hs);
        char* hbase = (char*)(P.ws + AR_HSP) + (size_t)C.bid * 65536; const unsigned hoff = (unsigned)(br * 4096 + t8) * 8u;
#pragma unroll
        for (int a = 0; a < 16; ++a) { f32x2 hv = v[a] * scale; hv.x += bias; *(f32x2*)(hbase + a * 2048 + (size_t)hoff) = hv; }
        for (int bp = 0; bp < 4; ++bp) {
            __syncthreads();
#pragma unroll
            for (int a = 0; a < 16; ++a) { const int n = 256 * a + t8; const unsigned zw = ZST[n]; const f32x2 zc = (f32x2){bflo(zw), bfhi(zw)}; D[pidx(n)] = br == 0 ? zc : cmul(zc, TW2[n]); }
            LBAR();
            if (bp < 3) FF_DMA(bp + 1);
            fft_fwd<true>(D, TW, t8, v, hbase, hoff, hs);
#pragma unroll
            for (int a = 0; a < 16; ++a) v[a] = cmul(v[a], hs[a]);
            fft_inv(D, TW, t8, v);
            unsigned* yo = YT2 + ((size_t)d * 4 + bp) * SEQ;
#pragma unroll
            for (int j = 0; j < 8; ++j) { const int n = C.tid + 512 * j; const f32x2 ye = DE[pidx(n)], yo2 = DO[pidx(n)]; const f32x2 y = (ye + cmulc(yo2, TW2[n])) * (1.0f / 8192.0f);
                yo[n] = pk2(y.x, y.y); }
        }
        __syncthreads();
    }
#undef FF_DMA
}
__device__ __forceinline__ void ph_hy_gate(const Ctx& C, const Params& P) {
    const bf16* PP = (const bf16*)(P.ws + AR_P); const bf16* YT = (const bf16*)(P.ws + AR_YT); bf16* AO = (bf16*)(P.ws + WS_H);
    LAS float* CW0 = (LAS float*)(C.lds + RING_OFF + 2 * 2 * 64 * 72 * 2);
    for (int i = C.tid; i < 4096; i += 512) CW0[i] = i < 3072 ? P.hy_conv_w[(i >> 10) * 3072 + (i & 1023)] : P.hy_conv_b[i & 1023];
    __syncthreads();
    LAS bf16* TS = (LAS bf16*)(C.lds + RING_OFF);
    const int dl = C.tid >> 3, tp = (C.tid & 7) * 8;
    const int tl = C.tid >> 3, d8 = (C.tid & 7) * 8;
    constexpr int NIT = 4 * 64 * 16;
    u32x4 gy0, gy1, gx[2][3];
#define HG_LOAD(item_) do { const int dt_ = (item_) & 15, it_ = (item_) >> 4, bp_ = it_ >> 6, t0_ = (it_ & 63) * 64, d0_ = dt_ * 64; \
        const bf16* yp_ = YT + (((size_t)(d0_ + dl) * 4 + bp_) * SEQ + t0_ + tp) * 2; gy0 = *(const u32x4*)yp_; gy1 = *(const u32x4*)(yp_ + 8); \
        _Pragma("unroll") for (int q_ = 0; q_ < 2; ++q_) _Pragma("unroll") for (int j_ = 0; j_ < 3; ++j_) { const int tt_ = t0_ + tl - 1 + j_; const bool ok_ = tt_ >= 0 && tt_ < SEQ; \
            gx[q_][j_] = *(const u32x4*)(PP + ((size_t)(2 * bp_ + q_) * SEQ + (ok_ ? tt_ : t0_ + tl)) * 3072 + d0_ + d8); } } while (0)
    int item = C.bid, par = 0;
    if (item < NIT) HG_LOAD(item);
    for (; item < NIT; item += C.G) {
        const int dt = item & 15, it = item >> 4, bp = it >> 6, t0 = (it & 63) * 64, d0 = dt * 64;
        LAS bf16* ts = TS + par * (2 * 64 * 72);
        { const unsigned w[8] = {gy0.x, gy0.y, gy0.z, gy0.w, gy1.x, gy1.y, gy1.z, gy1.w};
#pragma unroll
          for (int e = 0; e < 8; ++e) { ts[(tp + e) * 72 + dl] = (bf16)(w[e] & 0xffff); ts[64 * 72 + (tp + e) * 72 + dl] = (bf16)(w[e] >> 16); } }
#pragma unroll
        for (int q = 0; q < 2; ++q)
#pragma unroll
            for (int jj = 0; jj < 3; ++jj) asm volatile("" : "+v"(gx[q][jj]));
        float xc[2][8];
        { f32x4 cwv[4][2];
#pragma unroll
          for (int r = 0; r < 4; ++r) { cwv[r][0] = *(const LAS f32x4*)(CW0 + r * 1024 + d0 + d8); cwv[r][1] = *(const LAS f32x4*)(CW0 + r * 1024 + d0 + d8 + 4); }
#pragma unroll
          for (int q = 0; q < 2; ++q) {
#pragma unroll
              for (int e = 0; e < 8; ++e) xc[q][e] = cwv[3][e >> 2][e & 3];
#pragma unroll
              for (int jj = 0; jj < 3; ++jj) { const int tt = t0 + tl - 1 + jj; const bool ok = tt >= 0 && tt < SEQ; const u32x4 w = gx[q][jj]; const unsigned ww[4] = {ok ? w.x : 0u, ok ? w.y : 0u, ok ? w.z : 0u, ok ? w.w : 0u};
#pragma unroll
                  for (int e = 0; e < 8; ++e) xc[q][e] += ((e & 1) ? bfhi(ww[e >> 1]) : bflo(ww[e >> 1])) * cwv[jj][e >> 2][e & 3]; } } }
        if (item + C.G < NIT) HG_LOAD(item + C.G);
        LBAR();
#pragma unroll
        for (int q = 0; q < 2; ++q) { const size_t o = ((size_t)(2 * bp + q) * SEQ + t0 + tl) * 1024 + d0 + d8; const u32x4 y = *(const LAS u32x4*)(ts + q * 64 * 72 + tl * 72 + d8);
          u32x4 w; w.x = pk2(xc[q][0] * bflo(y.x), xc[q][1] * bfhi(y.x)); w.y = pk2(xc[q][2] * bflo(y.y), xc[q][3] * bfhi(y.y)); w.z = pk2(xc[q][4] * bflo(y.z), xc[q][5] * bfhi(y.z)); w.w = pk2(xc[q][6] * bflo(y.w), xc[q][7] * bfhi(y.w));
          *(u32x4*)(AO + o) = w; }
        par ^= 1;
    }
#undef HG_LOAD
    __syncthreads();
}
struct EpiStoreBf16 {
    static constexpr bool PERM = true; bf16* O; int ldc;
    __device__ __forceinline__ void operator()(EPI_ARGS) const { const bool odd = fr & 1;
#pragma unroll
        for (int ai = 0; ai < 2; ++ai)
#pragma unroll
            for (int m = 0; m < 4; ++m) { const size_t rowE = (size_t)u.pm * 256 + ai * 128 + wr * 64 + m * 16 + (fr & ~1); u32x4 A, B; widen_pair(pack8(acc[ai][0][m][0], acc[ai][0][m][1]), pack8(acc[ai][1][m][0], acc[ai][1][m][1]), odd, A, B);
                bf16* op = O + rowE * ldc + u.pn * 256 + wc * 64 + (odd ? 32 : 0) + 8 * fq; *(u32x4*)op = A; *(u32x4*)(op + ldc) = B; }
    }
};

__global__ void __launch_bounds__(512, 2) fwd_kernel(Params P) {
    extern __shared__ __attribute__((aligned(16))) unsigned char lds_raw[];
    Ctx C; C.tacc = 0; C.tbeg = 0; C.lds = (LAS unsigned char*)lds_raw; C.tid = threadIdx.x; C.lane = C.tid & 63; C.wave = __builtin_amdgcn_readfirstlane(C.tid >> 6); C.G = gridDim.x; C.bid = blockIdx.x;
    const int vcu = (C.G % 8 == 0) ? (C.bid % 8) * (C.G / 8) + C.bid / 8 : C.bid;
    for (int i = C.tid; i < LDS_CTL_BYTES / 4; i += 512) ((LAS unsigned*)C.lds)[i] = 0u;
    __syncthreads();
    unsigned char* ws = P.ws;
#if N_LAUNCH_MODE == 1
    XcdBarrier bar = xcd_barrier_post((unsigned*)(ws + WS_CTL) + CW_BAR, (volatile LAS unsigned*)(C.lds + 32));
#define SEAM(k) do { if (IN(k) && IN((k) + 1)) xcd_barrier(bar); EVT((k) + 1); } while (0)
#else
#define SEAM(k) do { EVT((k) + 1); } while (0)
#endif
#ifndef DUP_ID
#define DUP_ID -1
#endif
#ifndef DUP_MASK
#define DUP_MASK 0u
#endif
#define DUP(id, ...) do { __VA_ARGS__; if (DUP_ID == (id) || ((DUP_MASK >> (id)) & 1u)) { __syncthreads(); __VA_ARGS__; } } while (0)
#define TS_AMP 8
    unsigned long long tsA = 0, tsB = 0;
#define EVT(id) do { if (TS_FROM == (id)) tsA = wall_clock64(); if (TS_TO == (id)) tsB = wall_clock64(); } while (0)
    EVT(0);
    const int lo = P.ph_lo, hi = P.ph_hi;
#ifndef PH_MASK
#define PH_MASK 0xffffffffu
#endif
#define IN(k) (((PH_MASK >> (k)) & 1u) && lo <= (k) && (k) < hi)
    LAS unsigned char* ring = C.lds + RING_OFF;
    const float* mod = (const float*)(ws + WS_MOD);

    if (IN(0)) { ph_mod(C, P); __syncthreads(); EVT(100); ph_conv_l0(C, P); __syncthreads(); EVT(101); ph_s5_tables(C, P, C.G - 1 - C.bid, C.G); EVT(102); } SEAM(0);
    if (IN(1)) { DUP(1, ph_norm(C, P, P.x, 0, 0, true)); } SEAM(1);
    if (IN(2)) { SchedDense S{(const char*)(ws + WS_H), (const char*)(ws + WS_WIN), 2048u, 2048u, TA / 256, 4, C.G, vcu}; EpiInProj E{(bf16*)(ws + AR_PROJ), (bf16*)(ws + AR_U)};
        pg8::gemm_phase(ring, 1024, 2048u, 2048u, S, E);
        const int nfree = C.G - (TA / 256 * 4 - 2 * C.G);
        const int jl = (vcu & 31) * 8 + (vcu >> 5);
        if (C.G == 256 && jl >= C.G - nfree) { const int r = jl - (C.G - nfree); ph_conv_l0b(C, P, r * 8 + C.wave, nfree * 8); }
        else if (C.G != 256) { ph_conv_l0b(C, P, C.bid * 8 + C.wave, C.G * 8); } } SEAM(2);
    if (IN(3)) { { const int jl = (vcu & 31) * 8 + (vcu >> 5); if (C.G != 256) ph_rownorm1(C, P, C.bid * 8 + C.wave, C.G * 8); else if (jl >= 160) ph_rownorm1(C, P, (jl - 160) * 8 + C.wave, 96 * 8); } EVT(103);
        SchedBatched S{(const char*)(ws + AR_U), (const char*)(ws + WS_SOUT), 1536u, 1024u, (size_t)S5ROWS * 1536, (size_t)256 * 1024, S5G, 5, 1, C.G, vcu}; EpiF32Batched E{(float*)(ws + AR_SRAW), S5ROWS, 256};
        DUP(3, pg8::gemm_phase(ring, 512, 1536u, 1024u, S, E)); } SEAM(3);
    if (IN(4)) { SchedUp S{(const char*)(ws + AR_QN), (const char*)(ws + WS_WUQ), (const char*)(ws + AR_CKV), (const char*)(ws + WS_WUKV), C.G, vcu}; EpiUp E{(bf16*)(ws + AR_QRAW), (bf16*)(ws + AR_KVRAW)};
        DUP(4, pg8::gemm_phase(ring, 256, 512u, 512u, S, E); ph_s5_scan(C, P, (C.G == 256) ? (((vcu & 31) >= 20 && (vcu & 31) < 28) ? ((vcu & 31) - 20) * 8 + (vcu >> 5) : -1) : C.bid)); } SEAM(4);
    if (IN(5)) { ph_qkfinal(C, P); EVT(105);
        SchedBatched S{(const char*)(ws + AR_U), (const char*)(ws + WS_WG), 1536u, 1536u, (size_t)S5ROWS * 1536, (size_t)512 * 1536, S5G, 4, 2, C.G, vcu}; EpiS5C E{(bf16*)(ws + AR_Z)};
        DUP(5, pg8::gemm_phase(ring, 768, 1536u, 1536u, S, E)); } SEAM(5);
    if (IN(6)) { float gqm = 0.f, gkm = 0.f;
        for (int j = 0; j < QKH; ++j) { gqm = fmaxf(gqm, fabsf(P.q_qk[j])); gkm = fmaxf(gkm, fabsf(P.k_qk[j])); }
        const float sbound = 96.0f * gqm * gkm * (0.10206207261596577f * 1.4426950408889634f) * 1.02f;
        if (sbound < 90.0f) ph_attention<true>(C, P, vcu); else ph_attention<false>(C, P, vcu);
        EVT(106);
        SchedDense S{(const char*)(ws + AR_Z), (const char*)(ws + WS_WGLU), 1024u, 1024u, T / 256, 2, C.G, vcu}; EpiGlu E{(const bf16*)(ws + AR_Z), P.glu_b, (bf16*)(ws + AR_CAT)};
        DUP(26, pg8::gemm_phase(ring, 512, 1024u, 1024u, S, E)); } SEAM(6);
    if (IN(7)) { SchedDense S{(const char*)(ws + AR_CAT), (const char*)(ws + WS_WOUT), 2048u, 2048u, T / 256, 4, C.G, vcu}; EpiResidB<true> E{(const void*)P.x, (bf16*)(ws + WS_XB), mod + 2048};
        pg8::gemm_phase(ring, 1024, 2048u, 2048u, S, E); } SEAM(7);
#define MOE_LAYER(li, pb) do { \
        if (IN(pb)) { ph_conv_moe(C, P, li); __syncthreads(); EVT(110 + li); ph_router(C, P, (const bf16*)(ws + WS_XB), li, li); } SEAM(pb); \
        if (IN(pb + 1)) { const int nblk = moe_tables(C, P, li); \
            SchedMoE1 S{(const char*)(ws + WS_H), (const char*)(ws + AR_W1), (const int*)(ws + WS_TOK), (const LAS int*)(C.lds + LC_BLKSTART), (const LAS unsigned short*)(C.lds + LC_BLK2HE), nblk, C.G, vcu}; \
            EpiMoE1 E{(bf16*)(ws + AR_HID), (bf16*)(ws + AR_HIDS)}; \
            DUP(pb + 1, pg8::gemm_phase(ring, 1024, 2048u, 2048u, S, E)); \
            if (TS_FROM == 210 && li == 0) { __syncthreads(); EVT(210); EpiNull EN{}; pg8::gemm_phase(ring, 1024, 2048u, 2048u, S, EN); EVT(211); } \
            if (TS_FROM == 212 && li == 0) { __syncthreads(); EVT(212); pg8::gemm_phase(ring, 1024, 2048u, 2048u, S, E); EVT(213); } \
            if (li == 0) {   \
                const int total = 2 * nblk + 256, rem = total % C.G, nshort = rem == 0 ? C.G : C.G - rem, r = rem == 0 ? vcu : vcu - rem; \
                if (r >= 0) { ph_shw(C, P, r, nshort); ph_hy_filter(C, P, r, nshort); ph_conv_l1(C, P, r * 8 + C.wave, nshort * 8); } } \
            } SEAM(pb + 1); \
        if (IN(pb + 2)) { (void)moe_tables(C, P, li); const LAS int* bs = (const LAS int*)(C.lds + LC_BLKSTART);        \
            SchedMoE2 S{(const char*)(ws + AR_HID), (const char*)(ws + AR_W2), (const LAS unsigned short*)(C.lds + LC_BLK2HE), bs[0], bs[128], C.G, vcu}; \
            EpiMoE2 E{(unsigned char*)(ws + WS_AR), (const int*)(ws + WS_TOK), bs, (const LAS int*)(C.lds + LC_CNT)}; \
            pg8::gemm_phase(ring, 256, 512u, 512u, S, E); } SEAM(pb + 2); \
        if (IN(pb + 3)) { SchedDense S{(const char*)(ws + AR_HIDS), (const char*)(ws + AR_W2) + (size_t)64 * 1024 * 512, 512u, 512u, T / 256, 4, C.G, vcu};        \
            EpiCombine<li == 0> E{(const unsigned char*)(ws + WS_AR), (const float*)(ws + WS_TOPW), P.out, (bf16*)(ws + WS_XB), mod + (size_t)li * 8 * 6144 + 5120, (bf16*)(ws + WS_H), (float*)(ws + WS_SSP), (LAS float*)(C.lds + RING_OFF + pg8::STAGE_BYTES)}; \
            pg8::gemm_phase(ring, 256, 512u, 512u, S, E); } \
        if (li == 0) SEAM(pb + 3); else EVT(26); } while (0)
    MOE_LAYER(0, 8);
    if (IN(15)) { SchedDense S{(const char*)(ws + WS_H), (const char*)(ws + WS_WHIN), 2048u, 2048u, T / 256, 12, C.G, vcu}; EpiHyIn E{(bf16*)(ws + AR_P), (const float*)(ws + WS_SSP), (const float*)(ws + WS_SHW)};
        DUP(15, pg8::gemm_phase(ring, 1024, 2048u, 2048u, S, E)); } SEAM(15);
    if (IN(16)) { DUP(16, ph_hy_prep(C, P)); } SEAM(16);
    if (IN(17)) { DUP(17, ph_hy_fft(C, P)); } SEAM(17);
    if (IN(18)) { DUP(18, ph_hy_gate(C, P)); } SEAM(18);
    if (IN(19)) { SchedDense S{(const char*)(ws + WS_H), (const char*)(ws + WS_WHOUT), 2048u, 2048u, T / 256, 4, C.G, vcu}; EpiResidB<false> E{(const void*)(ws + WS_XB), (bf16*)(ws + WS_XB), mod + (size_t)8 * 6144 + 2048};
        pg8::gemm_phase(ring, 1024, 2048u, 2048u, S, E); } SEAM(19);
    MOE_LAYER(1, 20);
    if ((TS_FROM >= 0 || TS_ACC >= 0) && C.bid == 0 && C.tid == 0) { const unsigned long long t0 = wall_clock64(), need = (TS_ACC >= 0 ? C.tacc : (tsB - tsA)) * TS_AMP; while (wall_clock64() - t0 < need) __builtin_amdgcn_s_sleep(8); }
#undef IN
#undef SEAM
}

extern "C" void kernel_launch(void* const* d_in, const int* in_sizes, int n_in, void* d_out, int out_size, void* d_ws, size_t ws_size, hipStream_t stream) {
    static int grid = 0;
    if (grid == 0) {
        if (n_in != 43 || out_size != T * DM || ws_size < WS_END) { fprintf(stderr, "kernel_launch: unexpected shapes (n_in %d, out %d, ws %zu, need %zu)\n", n_in, out_size, ws_size, (size_t)WS_END); grid = -1; return; }
        int dev = 0, cus = 0, per_cu = 0;
        if (hipGetDevice(&dev) != hipSuccess || hipDeviceGetAttribute(&cus, hipDeviceAttributeMultiprocessorCount, dev) != hipSuccess) { grid = -1; return; }
        if (hipFuncSetAttribute((const void*)fwd_kernel, hipFuncAttributeMaxDynamicSharedMemorySize, LDS_BYTES) != hipSuccess) { fprintf(stderr, "kernel_launch: hipFuncSetAttribute failed\n"); grid = -1; return; }
        if (hipOccupancyMaxActiveBlocksPerMultiprocessor(&per_cu, (const void*)fwd_kernel, 512, LDS_BYTES) != hipSuccess || per_cu < 1) fprintf(stderr, "kernel_launch: occupancy query says %d\n", per_cu);
        (void)hipGetLastError();
        grid = cus;
    }
    if (grid < 0) return;
    (void)hipMemsetAsync((char*)d_ws + WS_CTL, 0, CTL_ZERO_BYTES, stream);
    Params p{};
    const float** pp = (const float**)&p;
    for (int i = 0; i < 43; ++i) pp[i] = (const float*)d_in[i];
    p.out = (float*)d_out; p.ws = (unsigned char*)d_ws;
#if N_LAUNCH_MODE == 1
    p.ph_lo = 0; p.ph_hi = NPHASE;
    hipLaunchKernelGGL(fwd_kernel, dim3(grid), dim3(512), LDS_BYTES, stream, p);
#else
    static const int order[NPHASE] = {0, 1, 2, 3, 4, 5, 6, 7, 8, 9, 10, 11, 12, 13, 14, 15, 16, 17, 18, 19, 20, 21, 22, 23, 24, 25};
    for (int k = 0; k < NPHASE; ++k) { p.ph_lo = order[k]; p.ph_hi = order[k] + 1; hipLaunchKernelGGL(fwd_kernel, dim3(grid), dim3(512), LDS_BYTES, stream, p); }
#endif
}
```
